# Optimizing an MI355X kernel written in HIP

```python
import jax, jax.numpy as jnp
from jax import lax
import numpy as np

D_MODEL = 1024
BATCH = 8
SEQ = 4096
DEPTH = 2

GRID_W = 64
CTX_LEN = 256
EPS = 1e-6
CONV_CH = 512
CONV_WIDTH = 31
N_HEADS = 8
QK_NOPE = 64
QK_ROPE = 32
V_HEAD = 64
Q_LORA = 256
KV_LORA = 128
ROPE_BASE = 10000.0
Q_BLOCK = 128
SC_CH = D_MODEL
SC_WIDTH = 3
N_EXPERTS = 64
TOP_K = 6
N_GROUPS = 8
TOPK_GROUPS = 4
D_EXPERT = 256
D_SHARED = 256
ROUTED_SCALE = 2.5
ROUTE_BLOCK = 128
N_EVEN = (DEPTH + 1) // 2
N_ODD = DEPTH // 2
IN_A = 2 * CONV_CH
IN_EVEN = IN_A + Q_LORA + KV_LORA + QK_ROPE
OUT_EVEN = CONV_CH + N_HEADS * V_HEAD

kernel_name = "hybrid_convmla_shortconv_moe_dit"


def rmsnorm(x, w):
    xf = x.astype(jnp.float32)
    y = xf * lax.rsqrt(jnp.mean(xf * xf, axis=-1, keepdims=True) + EPS)
    return (y * w.astype(jnp.float32)).astype(x.dtype)


def layernorm(x, w, b):
    xf = x.astype(jnp.float32)
    mu = jnp.mean(xf, axis=-1, keepdims=True)
    var = jnp.mean(jnp.square(xf - mu), axis=-1, keepdims=True)
    y = (xf - mu) * lax.rsqrt(var + EPS)
    return (y * w.astype(jnp.float32) + b.astype(jnp.float32)).astype(x.dtype)


def modulate(h, shift, scale):
    return h * (1 + scale) + shift


def axial_rope_tables(n):
    rows = n // GRID_W
    row = jnp.repeat(jnp.arange(rows), GRID_W).astype(jnp.float32)
    col = jnp.tile(jnp.arange(GRID_W), rows).astype(jnp.float32)
    half = QK_ROPE // 2
    inv = 1.0 / (ROPE_BASE ** (jnp.arange(0, half, 2, dtype=jnp.float32) / half))
    ang = jnp.stack([row[:, None] * inv, col[:, None] * inv], axis=1)
    return jnp.cos(ang), jnp.sin(ang)


def apply_rope(x, cos, sin):
    xr = x.reshape(x.shape[:-1] + (2, 2, QK_ROPE // 4))
    x1, x2 = xr[..., 0, :], xr[..., 1, :]
    out = jnp.stack([x1 * cos - x2 * sin, x2 * cos + x1 * sin], axis=-2)
    return out.reshape(x.shape).astype(x.dtype)


def dwconv(v, w):
    pad = w.shape[0] // 2
    return lax.conv_general_dilated(v, w.astype(v.dtype), (1,), [(pad, pad)],
                                    dimension_numbers=('NWC', 'WIO', 'NWC'),
                                    feature_group_count=v.shape[-1])


def conformer_conv(u, conv_w, conv_b, ln_w, ln_b):
    a, g = jnp.split(u, 2, axis=-1)
    y = dwconv(a * jax.nn.sigmoid(g), conv_w) + conv_b
    return jax.nn.silu(layernorm(y, ln_w, ln_b))


def mla_kv(ckv, k_rope, kv_norm_w, w_ukv, rope):
    kv = jnp.einsum('bnc,chd->bnhd', rmsnorm(ckv, kv_norm_w), w_ukv)
    k_nope, v = kv[..., :QK_NOPE], kv[..., QK_NOPE:]
    if rope is not None:
        k_rope = apply_rope(k_rope, rope[0], rope[1])
    k_rope = jnp.broadcast_to(k_rope[:, :, None, :], k_nope.shape[:-1] + (QK_ROPE,))
    return jnp.concatenate([k_nope, k_rope.astype(k_nope.dtype)], axis=-1), v


def mla_q(cq, q_norm_w, w_uq, rope):
    q = jnp.einsum('bnc,chd->bnhd', rmsnorm(cq, q_norm_w), w_uq)
    if rope is not None:
        q_rope = apply_rope(q[..., QK_NOPE:], rope[0][:, None], rope[1][:, None])
        q = jnp.concatenate([q[..., :QK_NOPE], q_rope], axis=-1)
    return q


def attend(q, k, v):
    scale = (QK_NOPE + QK_ROPE) ** -0.5
    s = jnp.einsum('bqhd,bkhd->bhqk', q, k).astype(jnp.float32) * scale
    p = jax.nn.softmax(s, axis=-1)
    return jnp.einsum('bhqk,bkhd->bqhd', p.astype(v.dtype), v)


def blocked_attention(q, k, v):
    B, n, H, dq = q.shape
    nb = n // Q_BLOCK
    qb = q.reshape(B, nb, Q_BLOCK, H, dq).transpose(1, 0, 2, 3, 4)
    out = lax.map(lambda qi: attend(qi, k, v), qb)
    return out.transpose(1, 0, 2, 3, 4).reshape(B, n, H, v.shape[-1])


def split_even(u):
    o1, o2, o3 = IN_A, IN_A + Q_LORA, IN_A + Q_LORA + KV_LORA
    return u[..., :o1], u[..., o1:o2], u[..., o2:o3], u[..., o3:]


def even_mixer(a, ac, w_in, conv_w, conv_b, ln_w, ln_b, q_norm_w, kv_norm_w, w_uq, w_ukv, w_out, rope, ctx_out):
    B, n, _ = a.shape
    u_a, cq, ckv, kr = split_even(a @ w_in)
    if ctx_out:
        uc_a, cq_c, ckv_c, kr_c = split_even(ac @ w_in)
    else:
        uc_kv = ac @ w_in[:, IN_A + Q_LORA:]
        ckv_c, kr_c = uc_kv[..., :KV_LORA], uc_kv[..., KV_LORA:]
    k_c, v_c = mla_kv(ckv_c, kr_c, kv_norm_w, w_ukv, None)
    k_l, v_l = mla_kv(ckv, kr, kv_norm_w, w_ukv, rope)
    q_l = mla_q(cq, q_norm_w, w_uq, rope)
    o_b = blocked_attention(q_l, jnp.concatenate([k_c, k_l], axis=1), jnp.concatenate([v_c, v_l], axis=1))
    o_a = conformer_conv(u_a, conv_w, conv_b, ln_w, ln_b)
    y = jnp.concatenate([o_a, o_b.reshape(B, n, N_HEADS * V_HEAD)], axis=-1) @ w_out
    if not ctx_out:
        return y, None
    o_bc = attend(mla_q(cq_c, q_norm_w, w_uq, None), k_c, v_c)
    o_ac = conformer_conv(uc_a, conv_w, conv_b, ln_w, ln_b)
    yc = jnp.concatenate([o_ac, o_bc.reshape(B, ac.shape[1], N_HEADS * V_HEAD)], axis=-1) @ w_out
    return y, yc


def short_conv_mixer(h, w_in, conv_w, w_out):
    b, cg, xt = jnp.split(h @ w_in, 3, axis=-1)
    return (b * dwconv(cg * xt, conv_w)) @ w_out


def moe_ffn(h, router_w, router_bias, w_gate, w_up, w_down, sw_gate, sw_up, sw_down):
    T, D = h.shape
    scores = jax.nn.sigmoid((h @ router_w).astype(jnp.float32))
    sel = scores + router_bias.astype(jnp.float32)
    gscore = lax.top_k(sel.reshape(T, N_GROUPS, N_EXPERTS // N_GROUPS), 2)[0].sum(-1)
    _, gidx = lax.top_k(gscore, TOPK_GROUPS)
    gmask = jnp.any(gidx[..., None] == jnp.arange(N_GROUPS), axis=1)
    emask = jnp.repeat(gmask, N_EXPERTS // N_GROUPS, axis=1)
    _, eidx = lax.top_k(jnp.where(emask, sel, -jnp.inf), TOP_K)
    wts = jnp.take_along_axis(scores, eidx, axis=1)
    wts = wts / jnp.sum(wts, axis=-1, keepdims=True) * ROUTED_SCALE
    TK = T * TOP_K
    flat_e = eidx.reshape(-1)
    flat_tok = jnp.arange(TK, dtype=jnp.int32) // TOP_K
    order = jnp.argsort(flat_e)
    se, stok, sw = flat_e[order], flat_tok[order], wts.reshape(-1)[order]
    counts = jnp.bincount(flat_e, length=N_EXPERTS)
    starts = jnp.cumsum(counts) - counts
    pcounts = ((counts + ROUTE_BLOCK - 1) // ROUTE_BLOCK) * ROUTE_BLOCK
    pends = jnp.cumsum(pcounts)
    pstarts = pends - pcounts
    dest = pstarts[se] + (jnp.arange(TK) - starts[se])
    NB = -(-TK // ROUTE_BLOCK) + N_EXPERTS
    P = NB * ROUTE_BLOCK
    row_tok = jnp.full((P,), T, dtype=jnp.int32).at[dest].set(stok)
    row_w = jnp.zeros((P,), dtype=h.dtype).at[dest].set(sw.astype(h.dtype))
    block_e = jnp.minimum(jnp.searchsorted(pends, jnp.arange(NB) * ROUTE_BLOCK, side='right'), N_EXPERTS - 1)
    h_pad = jnp.concatenate([h, jnp.zeros((1, D), h.dtype)], axis=0)

    def run_block(args):
        toks, bw, e = args
        xb = h_pad[toks]
        act = jax.nn.silu(xb @ w_gate[e]) * (xb @ w_up[e])
        return (act @ w_down[e]) * bw[:, None]

    yb = lax.map(run_block, (row_tok.reshape(NB, ROUTE_BLOCK), row_w.reshape(NB, ROUTE_BLOCK), block_e))
    routed = jax.ops.segment_sum(yb.reshape(P, D), row_tok, num_segments=T + 1)[:T]
    shared = (jax.nn.silu(h @ sw_gate) * (h @ sw_up)) @ sw_down
    return (routed + shared).astype(h.dtype)


def setup_inputs(seed: int = 0) -> dict:
    key = jax.random.key(seed)
    ks = iter(jax.random.split(key, 40))

    def nrm(shape, scale):
        return jax.random.normal(next(ks), shape, jnp.float32) * scale

    def gain(shape):
        return 1.0 + nrm(shape, 0.05)

    D = D_MODEL
    return {
        "x": nrm((BATCH, SEQ, D), 1.0),
        "c": nrm((BATCH, D), 1.0),
        "ctx": nrm((BATCH, CTX_LEN, D), 1.0),
        "c_ctx": nrm((D,), 1.0),
        "ada_w": nrm((DEPTH, D, 6 * D), 0.5 * D ** -0.5),
        "ada_b": nrm((DEPTH, 6 * D), 0.02),
        "norm_mix_w": gain((DEPTH, D)),
        "norm_ffn_w": gain((DEPTH, D)),
        "ev_w_in": nrm((N_EVEN, D, IN_EVEN), D ** -0.5),
        "ev_conv_w": nrm((N_EVEN, CONV_WIDTH, 1, CONV_CH), CONV_WIDTH ** -0.5),
        "ev_conv_b": nrm((N_EVEN, CONV_CH), 0.02),
        "ev_ln_w": gain((N_EVEN, CONV_CH)),
        "ev_ln_b": nrm((N_EVEN, CONV_CH), 0.02),
        "ev_q_norm_w": gain((N_EVEN, Q_LORA)),
        "ev_kv_norm_w": gain((N_EVEN, KV_LORA)),
        "ev_w_uq": nrm((N_EVEN, Q_LORA, N_HEADS, QK_NOPE + QK_ROPE), Q_LORA ** -0.5),
        "ev_w_ukv": nrm((N_EVEN, KV_LORA, N_HEADS, QK_NOPE + V_HEAD), KV_LORA ** -0.5),
        "ev_w_out": nrm((N_EVEN, OUT_EVEN, D), OUT_EVEN ** -0.5),
        "od_w_in": nrm((N_ODD, D, 3 * SC_CH), D ** -0.5),
        "od_conv_w": nrm((N_ODD, SC_WIDTH, 1, SC_CH), SC_WIDTH ** -0.5),
        "od_w_out": nrm((N_ODD, SC_CH, D), SC_CH ** -0.5),
        "router_w": nrm((DEPTH, D, N_EXPERTS), D ** -0.5),
        "router_bias": nrm((DEPTH, N_EXPERTS), 0.01),
        "exp_w_gate": nrm((DEPTH, N_EXPERTS, D, D_EXPERT), D ** -0.5),
        "exp_w_up": nrm((DEPTH, N_EXPERTS, D, D_EXPERT), D ** -0.5),
        "exp_w_down": nrm((DEPTH, N_EXPERTS, D_EXPERT, D), D_EXPERT ** -0.5),
        "sh_w_gate": nrm((DEPTH, D, D_SHARED), D ** -0.5),
        "sh_w_up": nrm((DEPTH, D, D_SHARED), D ** -0.5),
        "sh_w_down": nrm((DEPTH, D_SHARED, D), D_SHARED ** -0.5),
        "final_norm_w": gain((D,)),
    }


def reference(x, c, ctx, c_ctx, ada_w, ada_b, norm_mix_w, norm_ffn_w, ev_w_in, ev_conv_w, ev_conv_b, ev_ln_w,
              ev_ln_b, ev_q_norm_w, ev_kv_norm_w, ev_w_uq, ev_w_ukv, ev_w_out, od_w_in, od_conv_w, od_w_out,
              router_w, router_bias, exp_w_gate, exp_w_up, exp_w_down, sh_w_gate, sh_w_up, sh_w_down,
              final_norm_w):
    B, N, D = x.shape
    rope = axial_rope_tables(N)
    h, hc = x, ctx
    for i in range(DEPTH):
        reads_ctx = i % 2 == 0
        ctx_out = any(j % 2 == 0 for j in range(i + 1, DEPTH))
        m = jax.nn.silu(c) @ ada_w[i] + ada_b[i]
        sh1, sc1, g1, sh2, sc2, g2 = jnp.split(m[:, None, :], 6, axis=-1)
        a = modulate(rmsnorm(h, norm_mix_w[i]), sh1, sc1)
        if reads_ctx or ctx_out:
            mc = jax.nn.silu(c_ctx) @ ada_w[i] + ada_b[i]
            csh1, csc1, cg1, csh2, csc2, cg2 = jnp.split(mc, 6)
            ac = modulate(rmsnorm(hc, norm_mix_w[i]), csh1, csc1)
        if i % 2 == 0:
            e = i // 2
            y, yc = even_mixer(a, ac, ev_w_in[e], ev_conv_w[e], ev_conv_b[e], ev_ln_w[e], ev_ln_b[e],
                               ev_q_norm_w[e], ev_kv_norm_w[e], ev_w_uq[e], ev_w_ukv[e], ev_w_out[e], rope, ctx_out)
        else:
            o = i // 2
            y = short_conv_mixer(a, od_w_in[o], od_conv_w[o], od_w_out[o])
            yc = short_conv_mixer(ac, od_w_in[o], od_conv_w[o], od_w_out[o]) if ctx_out else None
        h = h + g1 * y
        f = modulate(rmsnorm(h, norm_ffn_w[i]), sh2, sc2)
        moe_args = (router_w[i], router_bias[i], exp_w_gate[i], exp_w_up[i], exp_w_down[i],
                    sh_w_gate[i], sh_w_up[i], sh_w_down[i])
        if ctx_out:
            hc = hc + cg1 * yc
            fc = modulate(rmsnorm(hc, norm_ffn_w[i]), csh2, csc2)
            nc = fc.shape[0] * fc.shape[1]
            out = moe_ffn(jnp.concatenate([fc.reshape(-1, D), f.reshape(-1, D)], axis=0), *moe_args)
            hc = hc + cg2 * out[:nc].reshape(hc.shape)
            h = h + g2 * out[nc:].reshape(h.shape)
        else:
            h = h + g2 * moe_ffn(f.reshape(-1, D), *moe_args).reshape(h.shape)
    return rmsnorm(h, final_norm_w)
```

```cpp
#include <hip/hip_runtime.h>
#include <hip/hip_cooperative_groups.h>
#include <cstdio>
#include <cstdint>
namespace cg = cooperative_groups;

#ifndef MK_MULTI
#define MK_MULTI 0
#endif

#define LAS __attribute__((address_space(3)))
typedef unsigned short bf16_t;
typedef short bf16x8 __attribute__((ext_vector_type(8)));
typedef float f32x4 __attribute__((ext_vector_type(4)));
typedef LAS unsigned char* lptr;
typedef unsigned u32x4 __attribute__((ext_vector_type(4)));
typedef float f32x2 __attribute__((ext_vector_type(2)));
typedef int i32x4 __attribute__((ext_vector_type(4)));
typedef int i32x8 __attribute__((ext_vector_type(8)));
constexpr float F8_SA = 4.0f, F8_SW1 = 256.0f, F8_SACT = 8.0f, F8_SW2 = 128.0f, F8_INV = 1.0f / 1024.0f;

constexpr int D = 1024, NB = 8, SEQ = 4096, T = NB * SEQ, CL = 256, TC = NB * CL, TT = T + TC, NKEY = SEQ + CL;
constexpr int NH = 8, DQK = 96, DV = 64;
constexpr int NE = 64, TOPK = 6;
constexpr float EPS = 1e-6f;
constexpr int NPHASE = 9;
constexpr int NTHREADS = 512, NWAVES = 8;
constexpr int RING_BYTES = 147456;
constexpr int XLDS = RING_BYTES;
constexpr int LDS_BYTES = RING_BYTES + 2048;

enum { I_X = 0, I_C, I_CTX, I_CCTX, I_ADAW, I_ADAB, I_NMIX, I_NFFN, I_EVWIN, I_EVCW, I_EVCB, I_EVLNW, I_EVLNB, I_QNW, I_KVNW,
       I_WUQ, I_WUKV, I_EVWOUT, I_ODWIN, I_ODCW, I_ODWOUT, I_RW, I_RB, I_EG, I_EU, I_ED, I_SG, I_SU, I_SD, I_FNW, N_IN };

struct Params {
  const float* in[N_IN];
  float* out;
  unsigned char* ws;
  int ph_lo, ph_hi;
};

constexpr size_t MiB = 1u << 20;
constexpr size_t WS_CNT = 0;
constexpr size_t WS_BAR = 16 * 1024;
constexpr size_t WS_MOD = 64 * 1024;
constexpr size_t WS_ROPE = WS_MOD + 512 * 1024;
constexpr size_t WS_CW1 = WS_ROPE + 8 * 1024;
constexpr size_t WS_WTS = 1 * MiB;
constexpr size_t WS_LISTS = 2 * MiB;
constexpr size_t WS_ACT = 10 * MiB;
constexpr size_t WS_WIN0 = 26 * MiB;
constexpr size_t WS_WUQ = 29 * MiB;
constexpr size_t WS_WUKV = WS_WUQ + 512 * 1024;
constexpr size_t WS_WOUT0 = 30 * MiB;
constexpr size_t WS_WIN1 = 32 * MiB;
constexpr size_t WS_WOUT1 = 38 * MiB;
constexpr size_t WS_WR = 40 * MiB;
constexpr size_t WS_WSGU = 42 * MiB;
constexpr size_t WS_WSD = 44 * MiB;
constexpr size_t WS_WEGU = 46 * MiB;
constexpr size_t WS_AF8 = 78 * MiB;
constexpr size_t WS_WED = 110 * MiB;
constexpr size_t WS_AF = 142 * MiB;
constexpr size_t WS_BIG = 210 * MiB;
constexpr size_t WS_END = 594 * MiB;
constexpr size_t B_GLU = WS_BIG + 0 * MiB;
constexpr size_t B_CQ = WS_BIG + 32 * MiB;
constexpr size_t B_CKV = WS_BIG + 48 * MiB;
constexpr size_t B_KR = WS_BIG + 57 * MiB;
constexpr size_t B_Q = WS_BIG + 60 * MiB;
constexpr size_t B_K = WS_BIG + 108 * MiB;
constexpr size_t B_VT = WS_BIG + 159 * MiB;
constexpr size_t B_OCAT = WS_BIG + 193 * MiB;
constexpr size_t B_FLO = WS_BIG + 64 * MiB;
constexpr size_t B_CONTRIB = WS_BIG;
constexpr size_t B_P = WS_BIG + 192 * MiB;
constexpr size_t B_B = WS_BIG + 256 * MiB;
constexpr size_t B_SHC = WS_BIG + 320 * MiB;
constexpr size_t B_S = WS_BIG;

typedef __bf16 bf16v2_t __attribute__((ext_vector_type(2)));
__device__ __forceinline__ unsigned pk2(float lo, float hi) {
  bf16v2_t v; v[0] = (__bf16)lo; v[1] = (__bf16)hi; return __builtin_bit_cast(unsigned, v);
}
__device__ __forceinline__ float bflo(unsigned u) { return __uint_as_float(u << 16); }
__device__ __forceinline__ float bfhi(unsigned u) { return __uint_as_float(u & 0xffff0000u); }
__device__ __forceinline__ unsigned pack4_fp8(f32x4 v) {
  int u = __builtin_amdgcn_cvt_pk_fp8_f32(v[0], v[1], 0, false);
  u = __builtin_amdgcn_cvt_pk_fp8_f32(v[2], v[3], u, true);
  return (unsigned)u;
}
__device__ __forceinline__ unsigned pack4_fp8c(f32x4 v) {
#pragma unroll
  for (int r = 0; r < 4; ++r) v[r] = fminf(fmaxf(v[r], -448.0f), 448.0f);
  return pack4_fp8(v);
}
__device__ __forceinline__ uint2 pack4(f32x4 v) { uint2 r; r.x = pk2(v[0], v[1]); r.y = pk2(v[2], v[3]); return r; }
__device__ __forceinline__ f32x4 unpack4(uint2 u) { return (f32x4){bflo(u.x), bfhi(u.x), bflo(u.y), bfhi(u.y)}; }
#define HROW(r) ((bf16_t*)(p.out + (size_t)(r) * D))
__device__ __forceinline__ void tr4x4(unsigned& x0, unsigned& x1, unsigned& x2, unsigned& x3) {
  { auto r = __builtin_amdgcn_permlane32_swap(x0, x2, false, false); x0 = r[0]; x2 = r[1]; }
  { auto r = __builtin_amdgcn_permlane32_swap(x1, x3, false, false); x1 = r[0]; x3 = r[1]; }
  { auto r = __builtin_amdgcn_permlane16_swap(x0, x1, false, false); x0 = r[0]; x1 = r[1]; }
  { auto r = __builtin_amdgcn_permlane16_swap(x2, x3, false, false); x2 = r[0]; x3 = r[1]; }
}
__device__ __forceinline__ void store_row4(bf16_t* rowp, f32x4 v0, f32x4 v1, f32x4 v2, f32x4 v3, int q4) {
  uint2 a = pack4(v0), b = pack4(v1), c = pack4(v2), d = pack4(v3);
  tr4x4(a.x, b.x, c.x, d.x); tr4x4(a.y, b.y, c.y, d.y);
  u32x4* o = (u32x4*)(rowp + q4 * 16);
  o[0] = (u32x4){a.x, a.y, b.x, b.y}; o[1] = (u32x4){c.x, c.y, d.x, d.y};
}
__device__ __forceinline__ void store_row2(bf16_t* rowp, f32x4 v0, f32x4 v1, int q4) {
  uint2 a = pack4(v0), b = pack4(v1);
  { auto r = __builtin_amdgcn_permlane16_swap(a.x, b.x, false, false); a.x = r[0]; b.x = r[1]; }
  { auto r = __builtin_amdgcn_permlane16_swap(a.y, b.y, false, false); a.y = r[0]; b.y = r[1]; }
  *(u32x4*)(rowp + (q4 & 1) * 16 + (q4 >> 1) * 8) = (u32x4){a.x, a.y, b.x, b.y};
}
__device__ __forceinline__ float wave_sum(float v) {
#pragma unroll
  for (int o = 1; o < 64; o <<= 1) v += __shfl_xor(v, o);
  return v;
}
__device__ __forceinline__ void lds_w16(lptr p, uint4 v) { *(LAS u32x4*)p = (u32x4){v.x, v.y, v.z, v.w}; }
__device__ __forceinline__ bf16x8 lds_r16(lptr p) { return *(LAS bf16x8*)p; }
__device__ __forceinline__ i32x4 lds_r16i(lptr p) { return *(LAS i32x4*)p; }
__device__ __forceinline__ float sigmoidf_(float x) { return 1.0f / (1.0f + __expf(-x)); }
__device__ __forceinline__ float sigmoid_fast(float x) { return __builtin_amdgcn_rcpf(1.0f + __expf(-x)); }


#define GAS __attribute__((address_space(1)))
__device__ __forceinline__ void glds16(const bf16_t* g, lptr l) {
  __builtin_amdgcn_global_load_lds((const GAS unsigned*)g, (LAS unsigned*)l, 16, 0, 0);
}
__device__ __forceinline__ int opaque(int x) { asm volatile("" : "+v"(x)); return x; }
template <class TP> __device__ __forceinline__ TP* opq(TP* x) { asm volatile("" : "+s"(x)); return x; }
#define CO8 ((((tid_ & 7) ^ ((tid_ >> 3) & 7))) << 3)
#define ROW8(i) ((i) * 64 + (tid_ >> 6) * 8 + ((tid_ & 63) >> 3))
#define WAIT_VM(n) asm volatile("s_waitcnt vmcnt(" #n ")" ::: "memory")
struct StrideLoader {
  static constexpr bool DIRECT = true;
  typedef uint4 Raw;
  const bf16_t* p0; int ld64;
  __device__ __forceinline__ const bf16_t* gp(int i, int kt) const { return p0 + (size_t)i * ld64 + kt * 64; }
  __device__ __forceinline__ void pre(int) {}
  __device__ __forceinline__ Raw ld(int, int) const { return make_uint4(0, 0, 0, 0); }
  __device__ __forceinline__ uint4 cvt(const Raw& r, int) const { return r; }
};
struct RowLoader2 {
  static constexpr bool DIRECT = true;
  typedef uint4 Raw;
  const bf16_t* p[2];
  __device__ __forceinline__ const bf16_t* gp(int i, int kt) const { return p[i] + kt * 64; }
  __device__ __forceinline__ void pre(int) {}
  __device__ __forceinline__ Raw ld(int, int) const { return make_uint4(0, 0, 0, 0); }
  __device__ __forceinline__ uint4 cvt(const Raw& r, int) const { return r; }
};

template <int NW, class AL, class BL>
__device__ __forceinline__ void gemm_pre(AL& al, BL& bl, int nk, lptr lds) {
  static_assert(AL::DIRECT && BL::DIRECT, "gemm_pre: LDS-DMA loaders only");
  const int wbase = __builtin_amdgcn_readfirstlane(opaque((int)threadIdx.x) >> 6) * 1024;
#pragma unroll
  for (int t = 0; t < 2; ++t) {
    if (t < nk) {
#pragma unroll
      for (int i = 0; i < 2; ++i) glds16(al.gp(i, t), lds + t * 49152 + i * 8192 + wbase);
#pragma unroll
      for (int i = 0; i < NW; ++i) glds16(bl.gp(i, t), lds + t * 49152 + 16384 + i * 8192 + wbase);
    }
  }
}
template <bool SWAP, int NW, bool PRE = false, class AL, class BL>
__device__ __forceinline__ void gemm_core(f32x4 (&acc)[4][NW], AL& al, BL& bl, int nk, lptr lds) {
  static_assert(BL::DIRECT, "B operand is always staged by LDS-DMA");
  static_assert(NW == 4 || NW == 1, "NW");
  constexpr int BS = NW;
  constexpr int STAGE = 49152, B_OFF = 16384;
  const int tid = opaque((int)threadIdx.x), lane = tid & 63, wave = __builtin_amdgcn_readfirstlane(tid >> 6), wm = wave >> 2, wn = wave & 3;
  int aoff[2], boff[2];
#pragma unroll
  for (int ks = 0; ks < 2; ++ks) {
    const int sw = (((ks * 4 + (lane >> 4)) ^ (lane & 7)) << 4);
    aoff[ks] = (wm * 64 + (lane & 15)) * 128 + sw;
    boff[ks] = B_OFF + (wn * 16 * NW + (lane & 15)) * 128 + sw;
  }
  const int wbase = wave * 1024;
  const int woff = (wave * 8 + (lane >> 3)) * 128 + (((lane & 7) ^ ((lane >> 3) & 7)) << 4);
  typename AL::Raw ra[2];
#pragma unroll
  for (int t = 0; t < 2; ++t) {
    if (!PRE && t < nk) {
      if constexpr (AL::DIRECT) {
#pragma unroll
        for (int i = 0; i < 2; ++i) glds16(al.gp(i, t), lds + t * STAGE + i * 8192 + wbase);
      } else {
        al.pre(t);
#pragma unroll
        for (int i = 0; i < 2; ++i) ra[i] = al.ld(i, t);
#pragma unroll
        for (int i = 0; i < 2; ++i) lds_w16(lds + t * STAGE + woff + i * 8192, al.cvt(ra[i], i));
      }
#pragma unroll
      for (int i = 0; i < BS; ++i) glds16(bl.gp(i, t), lds + t * STAGE + B_OFF + i * 8192 + wbase);
    }
  }
  int st = 0;
  for (int kt = 0; kt < nk; ++kt) {
    if constexpr (AL::DIRECT) {
      if (kt > 0 && kt + 1 < nk) { if constexpr (NW == 4) WAIT_VM(6); else WAIT_VM(3); } else WAIT_VM(0);
    } else WAIT_VM(0);
    asm volatile("s_waitcnt lgkmcnt(0)" ::: "memory");
    __builtin_amdgcn_s_barrier();
    asm volatile("" ::: "memory");
    const int s2 = (st == 0) ? 2 : st - 1;
    const bool more = (kt + 2 < nk);
    if (more) {
      if constexpr (AL::DIRECT) {
#pragma unroll
        for (int i = 0; i < 2; ++i) glds16(al.gp(i, kt + 2), lds + s2 * STAGE + i * 8192 + wbase);
      } else {
        al.pre(kt + 2);
#pragma unroll
        for (int i = 0; i < 2; ++i) ra[i] = al.ld(i, kt + 2);
      }
#pragma unroll
      for (int i = 0; i < BS; ++i) glds16(bl.gp(i, kt + 2), lds + s2 * STAGE + B_OFF + i * 8192 + wbase);
    }
    const lptr base = lds + st * STAGE;
#pragma unroll
    for (int ks = 0; ks < 2; ++ks) {
      bf16x8 af[4], bfr[NW];
#pragma unroll
      for (int i = 0; i < 4; ++i) af[i] = lds_r16(base + aoff[ks] + i * 2048);
#pragma unroll
      for (int j = 0; j < NW; ++j) bfr[j] = lds_r16(base + boff[ks] + j * 2048);
      __builtin_amdgcn_s_setprio(1);
#pragma unroll
      for (int i = 0; i < 4; ++i)
#pragma unroll
        for (int j = 0; j < NW; ++j)
          acc[i][j] = SWAP ? __builtin_amdgcn_mfma_f32_16x16x32_bf16(bfr[j], af[i], acc[i][j], 0, 0, 0)
                           : __builtin_amdgcn_mfma_f32_16x16x32_bf16(af[i], bfr[j], acc[i][j], 0, 0, 0);
      __builtin_amdgcn_s_setprio(0);
    }
    if constexpr (!AL::DIRECT) {
      if (more) {
#pragma unroll
        for (int i = 0; i < 2; ++i) lds_w16(lds + s2 * STAGE + woff + i * 8192, al.cvt(ra[i], i));
      }
    }
    st = (st == 2) ? 0 : st + 1;
  }
  __syncthreads();
}

template <int NW>
__device__ __forceinline__ void zero_acc(f32x4 (&acc)[4][NW]) {
#pragma unroll
  for (int i = 0; i < 4; ++i)
#pragma unroll
    for (int j = 0; j < NW; ++j) acc[i][j] = (f32x4){0.f, 0.f, 0.f, 0.f};
}


template <int NW, class AL, class BL>
__device__ __forceinline__ void gemm_pre_at(AL& al, BL& bl, int st, lptr lds) {
  const int wbase = __builtin_amdgcn_readfirstlane(opaque((int)threadIdx.x) >> 6) * 1024;
#pragma unroll
  for (int t = 0; t < 2; ++t) {
    const int sg = (st + t) % 3;
#pragma unroll
    for (int i = 0; i < 2; ++i) glds16(al.gp(i, t), lds + sg * 49152 + i * 8192 + wbase);
#pragma unroll
    for (int i = 0; i < NW; ++i) glds16(bl.gp(i, t), lds + sg * 49152 + 16384 + i * 8192 + wbase);
  }
}
template <bool SWAP, int NW, class AL, class BL, class ALN, class BLN>
__device__ __forceinline__ void gemm_chain(f32x4 (&acc)[4][NW], AL& al, BL& bl, int nk, lptr lds, int& st_io, bool has_next, ALN& aln, BLN& bln) {
  constexpr int STAGE = 49152, B_OFF = 16384;
  const int tid = opaque((int)threadIdx.x), lane = tid & 63, wave = __builtin_amdgcn_readfirstlane(tid >> 6), wm = wave >> 2, wn = wave & 3;
  int aoff[2], boff[2];
#pragma unroll
  for (int ks = 0; ks < 2; ++ks) {
    const int sw = (((ks * 4 + (lane >> 4)) ^ (lane & 7)) << 4);
    aoff[ks] = (wm * 64 + (lane & 15)) * 128 + sw;
    boff[ks] = B_OFF + (wn * 16 * NW + (lane & 15)) * 128 + sw;
  }
  const int wbase = wave * 1024;
  int st = st_io;
  for (int kt = 0; kt < nk; ++kt) {
    if (kt > 0 && (kt + 1 < nk || has_next)) { if constexpr (NW == 4) WAIT_VM(6); else WAIT_VM(3); } else WAIT_VM(0);
    asm volatile("s_waitcnt lgkmcnt(0)" ::: "memory");
    __builtin_amdgcn_s_barrier();
    asm volatile("" ::: "memory");
    const lptr base = lds + st * STAGE;
#pragma unroll
    for (int ks = 0; ks < 2; ++ks) {
      bf16x8 af[4], bfr[NW];
#pragma unroll
      for (int i = 0; i < 4; ++i) af[i] = lds_r16(base + aoff[ks] + i * 2048);
#pragma unroll
      for (int j = 0; j < NW; ++j) bfr[j] = lds_r16(base + boff[ks] + j * 2048);
      if (ks == 1) {
      const int s2 = (st == 0) ? 2 : st - 1;
      const int t2 = kt + 2;
      if (t2 < nk) {
  #pragma unroll
        for (int i = 0; i < 2; ++i) glds16(al.gp(i, t2), lds + s2 * STAGE + i * 8192 + wbase);
  #pragma unroll
        for (int i = 0; i < NW; ++i) glds16(bl.gp(i, t2), lds + s2 * STAGE + B_OFF + i * 8192 + wbase);
      } else if (has_next) {
  #pragma unroll
        for (int i = 0; i < 2; ++i) glds16(aln.gp(i, t2 - nk), lds + s2 * STAGE + i * 8192 + wbase);
  #pragma unroll
        for (int i = 0; i < NW; ++i) glds16(bln.gp(i, t2 - nk), lds + s2 * STAGE + B_OFF + i * 8192 + wbase);
      }
      }
      __builtin_amdgcn_s_setprio(1);
#pragma unroll
      for (int i = 0; i < 4; ++i)
#pragma unroll
        for (int j = 0; j < NW; ++j)
          acc[i][j] = SWAP ? __builtin_amdgcn_mfma_f32_16x16x32_bf16(bfr[j], af[i], acc[i][j], 0, 0, 0)
                           : __builtin_amdgcn_mfma_f32_16x16x32_bf16(af[i], bfr[j], acc[i][j], 0, 0, 0);
      __builtin_amdgcn_s_setprio(0);
    }
    st = (st == 2) ? 0 : st + 1;
  }
  st_io = st;
}
template <int NW, class AL, class BL, class ALN, class BLN>
__device__ __forceinline__ void gemm_chain8(f32x4 (&acc)[4][NW], AL& al, BL& bl, int nk, lptr lds, int& st_io, bool has_next, ALN& aln, BLN& bln) {
  constexpr int STAGE = 49152, B_OFF = 16384;
  const int tid = opaque((int)threadIdx.x), lane = tid & 63, wave = __builtin_amdgcn_readfirstlane(tid >> 6), wm = wave >> 2, wn = wave & 3;
  int aoff[2], boff[2];
#pragma unroll
  for (int ks = 0; ks < 2; ++ks) {
    const int sw = (((ks * 4 + (lane >> 4)) ^ (lane & 7)) << 4);
    aoff[ks] = (wm * 64 + (lane & 15)) * 128 + sw;
    boff[ks] = B_OFF + (wn * 16 * NW + (lane & 15)) * 128 + sw;
  }
  const int wbase = wave * 1024;
  int st = st_io;
  asm volatile("" : "+s"(nk));
#pragma unroll 1
  for (int kt = 0; kt < nk; ++kt) {
    if (kt > 0 && (kt + 1 < nk || has_next)) { if constexpr (NW == 4) WAIT_VM(6); else WAIT_VM(3); } else WAIT_VM(0);
    asm volatile("s_waitcnt lgkmcnt(0)" ::: "memory");
    __builtin_amdgcn_s_barrier();
    asm volatile("" ::: "memory");
    const lptr base = lds + st * STAGE;
    i32x8 af[4], bfr[NW];
#pragma unroll
    for (int j = 0; j < NW; ++j) bfr[j] = __builtin_shufflevector(lds_r16i(base + boff[0] + j * 2048), lds_r16i(base + boff[1] + j * 2048), 0, 1, 2, 3, 4, 5, 6, 7);
#pragma unroll
    for (int i = 0; i < 4; ++i) af[i] = __builtin_shufflevector(lds_r16i(base + aoff[0] + i * 2048), lds_r16i(base + aoff[1] + i * 2048), 0, 1, 2, 3, 4, 5, 6, 7);
    {
      const int s2 = (st == 0) ? 2 : st - 1;
      const int t2 = kt + 2;
      if (t2 < nk) {
  #pragma unroll
        for (int i = 0; i < 2; ++i) glds16(al.gp(i, t2), lds + s2 * STAGE + i * 8192 + wbase);
  #pragma unroll
        for (int i = 0; i < NW; ++i) glds16(bl.gp(i, t2), lds + s2 * STAGE + B_OFF + i * 8192 + wbase);
      } else if (has_next) {
  #pragma unroll
        for (int i = 0; i < 2; ++i) glds16(aln.gp(i, t2 - nk), lds + s2 * STAGE + i * 8192 + wbase);
  #pragma unroll
        for (int i = 0; i < NW; ++i) glds16(bln.gp(i, t2 - nk), lds + s2 * STAGE + B_OFF + i * 8192 + wbase);
      }
    }
    __builtin_amdgcn_s_setprio(1);
#pragma unroll
    for (int i = 0; i < 4; ++i)
#pragma unroll
      for (int j = 0; j < NW; ++j)
        acc[i][j] = __builtin_amdgcn_mfma_scale_f32_16x16x128_f8f6f4(bfr[j], af[i], acc[i][j], 0, 0, 0, 0x7f7f7f7f, 0, 0x7f7f7f7f);
    __builtin_amdgcn_s_setprio(0);
    st = (st == 2) ? 0 : st + 1;
  }
  st_io = st;
}

constexpr int EP_PITCH = 1040;
constexpr int EP_BASE = 98304;
constexpr int EPT_PITCH = 528;
template <int NW>
struct PutPlain {
  const f32x4 (&acc)[4][NW];
  template <class W> __device__ __forceinline__ void operator()(int band, int tid, W w) const {
    const int lane = tid & 63, wave = tid >> 6, wm = wave >> 2, wn = wave & 3;
    if (wm != (band >> 1)) return;
#pragma unroll
    for (int m2 = 0; m2 < 2; ++m2)
#pragma unroll
      for (int nj = 0; nj < NW; ++nj) w(m2 * 16 + (lane & 15), wn * 16 * NW + nj * 16 + (lane >> 4) * 4, acc[2 * (band & 1) + m2][nj]);
  }
};
template <class OP>
struct PutPair {
  const f32x4 (&acc)[4][4]; OP op;
  template <class W> __device__ __forceinline__ void operator()(int band, int tid, W w) const {
    const int lane = tid & 63, wave = tid >> 6, wm = wave >> 2, wn = wave & 3;
    if (wm != (band >> 1)) return;
#pragma unroll
    for (int m2 = 0; m2 < 2; ++m2)
#pragma unroll
      for (int j2 = 0; j2 < 2; ++j2) {
        const f32x4 x = acc[2 * (band & 1) + m2][2 * j2], y = acc[2 * (band & 1) + m2][2 * j2 + 1]; f32x4 v;
#pragma unroll
        for (int r = 0; r < 4; ++r) v[r] = op(x[r], y[r]);
        w(m2 * 16 + (lane & 15), wn * 32 + j2 * 16 + (lane >> 4) * 4, v);
      }
  }
};
template <int NC, int UNR = 4, class PUT, class F>
__device__ __forceinline__ void ep_banded(lptr lds, const PUT& put, F f) {
  constexpr int CPR = NC / 4;
  const int tid = opaque((int)threadIdx.x);
#pragma unroll
  for (int band = 0; band < 4; ++band) {
    put(band, tid, [&](int rb, int col, f32x4 v) { *(LAS f32x4*)(lds + EP_BASE + rb * EP_PITCH + col * 4) = v; });
    __syncthreads();
    static_assert((32 * CPR) % NTHREADS == 0, "ep_banded: whole passes");
#pragma unroll
    for (int it = 0; it < (32 * CPR) / NTHREADS; ++it) {
      const int idx = tid + it * NTHREADS;
      const int rb = idx / CPR, c4 = idx - rb * CPR;
      const f32x4 v = *(const LAS f32x4*)(lds + EP_BASE + rb * EP_PITCH + c4 * 16);
      f(band * 32 + rb, c4 * 4, v);
    }
    __syncthreads();
    __builtin_amdgcn_sched_barrier(0);
  }
}

enum { M_ID = 0, M_WIN0, M_WUQ, M_WUKV, M_WIN1, M_GATE, M_UP };
__device__ __forceinline__ int map_col(int mode, int n) {
  switch (mode) {
    case M_WIN0:
      if (n < 512) return ((n >> 4) << 5) + (n & 15);
      if (n < 1024) { const int c = n - 512; return ((c >> 4) << 5) + 16 + (c & 15); }
      if (n < 1408) return n;
      { const int i = n - 1408; return 1408 + (i & 16) + ((i & 7) << 1) + ((i >> 3) & 1); }
    case M_WUQ: { const int h = n / 96, d = n - h * 96; if (d < 64) return n; const int i = d - 64; return h * 96 + 64 + (i & 16) + ((i & 7) << 1) + ((i >> 3) & 1); }
    case M_WUKV: { const int h = n >> 7, d = n & 127; return d < 64 ? h * 64 + d : 512 + h * 64 + (d - 64); }
    case M_WIN1:
      if (n < 1024) return 2048 + n;
      if (n < 2048) { const int c = n - 1024; return ((c >> 4) << 5) + (c & 15); }
      { const int c = n - 2048; return ((c >> 4) << 5) + 16 + (c & 15); }
    case M_GATE: return ((n >> 4) << 5) + (n & 15);
    case M_UP: return ((n >> 4) << 5) + 16 + (n & 15);
    default: return n;
  }
}
#define WAVE_LDS_SYNC() do { asm volatile("s_waitcnt lgkmcnt(0)" ::: "memory"); __builtin_amdgcn_wave_barrier(); asm volatile("" ::: "memory"); } while (0)
__device__ __forceinline__ void transpose_item(const float* W, int K, int N, bf16_t* dst, int ldd, int mode, const float* kscale, int item, LAS float* scr, int lane) {
  const int nblk = N >> 5, kb = item / nblk, nb = item - kb * nblk, k0 = kb * 64, n0 = nb * 32;
  float4 tv[8];
#pragma unroll
  for (int i = 0; i < 8; ++i) tv[i] = *(const float4*)(W + (size_t)(k0 + 8 * i + (lane >> 3)) * N + n0 + (lane & 7) * 4);
#pragma unroll
  for (int i = 0; i < 8; ++i) {
    const int kk = 8 * i + (lane >> 3);
    const float ks = kscale ? kscale[k0 + kk] : 1.0f;
    LAS float* d = scr + kk * 33 + (lane & 7) * 4;
    d[0] = tv[i].x * ks; d[1] = tv[i].y * ks; d[2] = tv[i].z * ks; d[3] = tv[i].w * ks;
  }
  WAVE_LDS_SYNC();
  const int c = lane & 7;
#pragma unroll
  for (int j = 0; j < 4; ++j) {
    const int n = (lane >> 3) + 8 * j; const LAS float* s = scr + (8 * c) * 33 + n;
    uint4 o; o.x = pk2(s[0], s[33]); o.y = pk2(s[66], s[99]); o.z = pk2(s[132], s[165]); o.w = pk2(s[198], s[231]);
    *(uint4*)(dst + (size_t)map_col(mode, n0 + n) * ldd + k0 + 8 * c) = o;
  }
  WAVE_LDS_SYNC();
}
__device__ __forceinline__ void transpose_item8(const float* W, int K, int N, unsigned char* dst, int ldd, int mode, float scale, int item, LAS float* scr, int lane) {
  const int nblk = N >> 5, kb = item / nblk, nb = item - kb * nblk, k0 = kb * 64, n0 = nb * 32;
  float4 tv[8];
#pragma unroll
  for (int i = 0; i < 8; ++i) tv[i] = *(const float4*)(W + (size_t)(k0 + 8 * i + (lane >> 3)) * N + n0 + (lane & 7) * 4);
#pragma unroll
  for (int i = 0; i < 8; ++i) {
    LAS float* d = scr + (8 * i + (lane >> 3)) * 33 + (lane & 7) * 4;
    d[0] = tv[i].x * scale; d[1] = tv[i].y * scale; d[2] = tv[i].z * scale; d[3] = tv[i].w * scale;
  }
  WAVE_LDS_SYNC();
  const int c = lane & 7;
#pragma unroll
  for (int j = 0; j < 4; ++j) {
    const int n = (lane >> 3) + 8 * j; const LAS float* s = scr + (8 * c) * 33 + n;
    uint2 o;
    o.x = pack4_fp8c((f32x4){s[0], s[33], s[66], s[99]}); o.y = pack4_fp8c((f32x4){s[132], s[165], s[198], s[231]});
    *(uint2*)(dst + (size_t)map_col(mode, n0 + n) * ldd + k0 + 8 * c) = o;
  }
  WAVE_LDS_SYNC();
}
__device__ __forceinline__ void router_item(const float* W, bf16_t* dst, int item, LAS float* scr, int lane) {
  const int kb = item >> 1, nb = item & 1, k0 = kb * 64, n0 = nb * 32;
#pragma unroll 8
  for (int i = 0; i < 32; ++i) { const int kk = 2 * i + (lane >> 5); scr[kk * 33 + (lane & 31)] = W[(size_t)(k0 + kk) * 64 + n0 + (lane & 31)]; }
  WAVE_LDS_SYNC();
  const int c = lane & 7;
#pragma unroll
  for (int j = 0; j < 4; ++j) {
    const int n = (lane >> 3) + 8 * j; const LAS float* s = scr + (8 * c) * 33 + n;
    float v[8]; unsigned hb[4], lb[4];
#pragma unroll
    for (int q = 0; q < 8; ++q) v[q] = s[q * 33];
#pragma unroll
    for (int q = 0; q < 4; ++q) { hb[q] = pk2(v[2 * q], v[2 * q + 1]); lb[q] = pk2(v[2 * q] - bflo(hb[q]), v[2 * q + 1] - bfhi(hb[q])); }
    bf16_t* dr = dst + (size_t)(n0 + n) * 3072 + k0 + 8 * c;
    *(uint4*)(dr) = make_uint4(hb[0], hb[1], hb[2], hb[3]);
    *(uint4*)(dr + 1024) = make_uint4(hb[0], hb[1], hb[2], hb[3]);
    *(uint4*)(dr + 2048) = make_uint4(lb[0], lb[1], lb[2], lb[3]);
  }
  WAVE_LDS_SYNC();
}
__device__ __forceinline__ void expert_item(const Params& p, int L, int item, LAS float* scr, int lane) {
  const int e = item / 384, r = item - e * 384;
  const size_t eo = (size_t)(L * NE + e);
  unsigned char* gu = p.ws + WS_WEGU + (size_t)e * 512 * 1024;
  unsigned char* dn = p.ws + WS_WED + (size_t)e * 1024 * 256;
  if (r < 128) transpose_item8(p.in[I_EG] + eo * 1024 * 256, 1024, 256, gu, 1024, M_GATE, F8_SW1, r, scr, lane);
  else if (r < 256) transpose_item8(p.in[I_EU] + eo * 1024 * 256, 1024, 256, gu, 1024, M_UP, F8_SW1, r - 128, scr, lane);
  else transpose_item8(p.in[I_ED] + eo * 256 * 1024, 256, 1024, dn, 256, M_ID, F8_SW2, r - 256, scr, lane);
}

__device__ __forceinline__ void phase0(const Params& p, lptr lds, int vb, int nblocks) {
  const int tid = threadIdx.x, lane = tid & 63, wave = tid >> 6;
  unsigned char* ws = p.ws;
  if (vb == 0) {
    if (tid < 128) ((int*)(ws + WS_CNT))[tid] = 0;
    for (int i = tid; i < 2 * 64 * 3072 / 8; i += NTHREADS) {
      const int L = i / (64 * 3072 / 8), r = i - L * (64 * 3072 / 8);
      *(uint4*)((bf16_t*)(ws + WS_WR) + (size_t)L * 128 * 3072 + 64 * 3072 + (size_t)r * 8) = make_uint4(0, 0, 0, 0);
    }
  }
  if (vb == 2 || nblocks == 1) {
    for (int i = tid; i < 3 * 512; i += NTHREADS) { const float2 v = *(const float2*)(p.in[I_ODCW] + 2 * i); ((unsigned*)(ws + WS_CW1))[i] = pk2(v.x, v.y); }
  }
  if (vb == 1 || nblocks == 1) {
    for (int t = tid; t < 512; t += NTHREADS) {
      const int pos = t >> 3, j = t & 7;
      const float inv = 1.0f / powf(10000.0f, (float)(2 * j) / 16.0f);
      const float ang = (float)pos * inv;
      ((float2*)(ws + WS_ROPE))[t] = make_float2(cosf(ang), sinf(ang));
    }
  }
  {
    LAS float* sc = (LAS float*)lds;
    LAS float* red = (LAS float*)(lds + 36864);
    bool have = false;
    for (int it = vb; it < 384; it += nblocks) {
      if (!have) {
        float cv[18];
#pragma unroll
        for (int q = 0; q < 18; ++q) { const int i = tid + q * NTHREADS, r = i >> 10, k = i & 1023; cv[q] = (r < 8) ? p.in[I_C][r * 1024 + k] : p.in[I_CCTX][k]; }
#pragma unroll
        for (int q = 0; q < 18; ++q) sc[tid + q * NTHREADS] = cv[q] / (1.0f + __expf(-cv[q]));
        have = true;
      }
      __syncthreads();
      const int L = it / 192, n0 = (it - L * 192) * 32;
      const int col = n0 + (tid & 31), kp = tid >> 5;
      const float* w = p.in[I_ADAW] + (size_t)L * 1024 * 6144 + (size_t)(kp * 64) * 6144 + col;
      float a[9];
#pragma unroll
      for (int r = 0; r < 9; ++r) a[r] = 0.f;
      float wv[64];
#pragma unroll
      for (int k = 0; k < 64; ++k) wv[k] = w[(size_t)k * 6144];
#pragma unroll
      for (int k = 0; k < 64; ++k) {
#pragma unroll
        for (int r = 0; r < 9; ++r) a[r] += sc[r * 1024 + kp * 64 + k] * wv[k];
      }
#pragma unroll
      for (int r = 0; r < 9; ++r) red[(kp * 9 + r) * 32 + (tid & 31)] = a[r];
      __syncthreads();
      for (int o = tid; o < 288; o += NTHREADS) {
        const int r = o >> 5, cc = o & 31;
        float s = 0.f;
#pragma unroll
        for (int q = 0; q < 16; ++q) s += red[(q * 9 + r) * 32 + cc];
        ((float*)(ws + WS_MOD))[(size_t)(L * 9 + r) * 6144 + n0 + cc] = s + p.in[I_ADAB][L * 6144 + n0 + cc];
      }
    }
    __syncthreads();
  }
  LAS float* scr = (LAS float*)(lds + wave * 8448);
  const int gw = (nblocks - 1 - vb) * NWAVES + wave, NGW = nblocks * NWAVES;
  constexpr int J0 = 720, J1 = 96, J2 = 64, J3 = 512, J4 = 1536, J5 = 512, JS = 384, JR = 32, JE = NE * 384;
  constexpr int NIT = J0 + J1 + J2 + J3 + J4 + J5 + 2 * JS + 2 * JR;
  for (int it0 = gw; it0 < NIT; it0 += NGW) {
    int it = it0;
    if (it < J0) { transpose_item(p.in[I_EVWIN], 1024, 1440, (bf16_t*)(ws + WS_WIN0), 1024, M_WIN0, nullptr, it, scr, lane); continue; } it -= J0;
    if (it < J1) { transpose_item(p.in[I_WUQ], 256, 768, (bf16_t*)(ws + WS_WUQ), 256, M_WUQ, p.in[I_QNW], it, scr, lane); continue; } it -= J1;
    if (it < J2) { transpose_item(p.in[I_WUKV], 128, 1024, (bf16_t*)(ws + WS_WUKV), 128, M_WUKV, p.in[I_KVNW], it, scr, lane); continue; } it -= J2;
    if (it < J3) { transpose_item(p.in[I_EVWOUT], 1024, 1024, (bf16_t*)(ws + WS_WOUT0), 1024, M_ID, nullptr, it, scr, lane); continue; } it -= J3;
    if (it < J4) { transpose_item8(p.in[I_ODWIN], 1024, 3072, ws + WS_WIN1, 1024, M_WIN1, F8_SW1, it, scr, lane); continue; } it -= J4;
    if (it < J5) { transpose_item(p.in[I_ODWOUT], 1024, 1024, (bf16_t*)(ws + WS_WOUT1), 1024, M_ID, nullptr, it, scr, lane); continue; } it -= J5;
    if (it < 2 * JS) {
      const int L = it / JS, r = it - L * JS;
      unsigned char* gu = ws + WS_WSGU + (size_t)L * 512 * 1024; unsigned char* dn = ws + WS_WSD + (size_t)L * 1024 * 256;
      if (r < 128) transpose_item8(p.in[I_SG] + (size_t)L * 1024 * 256, 1024, 256, gu, 1024, M_GATE, F8_SW1, r, scr, lane);
      else if (r < 256) transpose_item8(p.in[I_SU] + (size_t)L * 1024 * 256, 1024, 256, gu, 1024, M_UP, F8_SW1, r - 128, scr, lane);
      else transpose_item8(p.in[I_SD] + (size_t)L * 256 * 1024, 256, 1024, dn, 256, M_ID, F8_SW2, r - 256, scr, lane);
      continue;
    }
    it -= 2 * JS;
    if (it < 2 * JR) { const int L = it / JR, r = it - L * JR; router_item(p.in[I_RW] + (size_t)L * 1024 * 64, (bf16_t*)(ws + WS_WR) + (size_t)L * 128 * 3072, r, scr, lane); continue; }
  }
}

__device__ __forceinline__ void norm_mod_row(const float4 (&v)[4], const float* nw, const float* sc, const float* sh, bf16_t* dhi, bf16_t* dlo, int lane, unsigned char* d8 = nullptr) {
  float ss = 0.f;
#pragma unroll
  for (int j = 0; j < 4; ++j) ss += (v[j].x * v[j].x + v[j].y * v[j].y) + (v[j].z * v[j].z + v[j].w * v[j].w);
  ss = wave_sum(ss);
  const float rstd = 1.0f / sqrtf(ss * (1.0f / 1024.0f) + EPS);
#pragma unroll
  for (int j = 0; j < 4; ++j) {
    const int c = lane + 64 * j;
    const float4 w = ((const float4*)nw)[c], s = ((const float4*)sc)[c], h = ((const float4*)sh)[c];
    const float y0 = v[j].x * rstd * w.x * (1.f + s.x) + h.x, y1 = v[j].y * rstd * w.y * (1.f + s.y) + h.y;
    const float y2 = v[j].z * rstd * w.z * (1.f + s.z) + h.z, y3 = v[j].w * rstd * w.w * (1.f + s.w) + h.w;
    uint2 hi; hi.x = pk2(y0, y1); hi.y = pk2(y2, y3);
    if (dhi) ((uint2*)dhi)[c] = hi;
    if (d8) ((unsigned*)d8)[c] = pack4_fp8c((f32x4){y0, y1, y2, y3} * F8_SA);
    if (dlo) { uint2 lo; lo.x = pk2(y0 - bflo(hi.x), y1 - bfhi(hi.x)); lo.y = pk2(y2 - bflo(hi.y), y3 - bfhi(hi.y)); ((uint2*)dlo)[c] = lo; }
  }
}

__device__ __forceinline__ void a0_panel(const Params& p, int pan) {
  const int lane = threadIdx.x & 63, wave = threadIdx.x >> 6;
  const float* mod = opq((const float*)(p.ws + WS_MOD)); const float* nmix = opq(p.in[I_NMIX]);
  bf16_t* AF = (bf16_t*)(p.ws + WS_AF);
#pragma unroll 1
  for (int i0 = 0; i0 < 16; i0 += 4) {
    float4 v[4][4];
#pragma unroll
    for (int u = 0; u < 4; ++u) {
      const int r = pan * 128 + wave + 8 * (i0 + u);
      const float* src = (r < T) ? p.in[I_X] + (size_t)r * D : p.in[I_CTX] + (size_t)(r - T) * D;
#pragma unroll
      for (int j = 0; j < 4; ++j) v[u][j] = ((const float4*)src)[lane + 64 * j];
    }
#pragma unroll
    for (int u = 0; u < 4; ++u) {
      const int r = pan * 128 + wave + 8 * (i0 + u);
      const int b = (r < T) ? (r >> 12) : 8;
      norm_mod_row(v[u], nmix, mod + (size_t)b * 6144 + 1024, mod + (size_t)b * 6144, AF + (size_t)r * D, nullptr, lane);
    }
  }
}

__device__ __forceinline__ void ffnprep_panel(const Params& p, int L, int mt) {
  const int lane = threadIdx.x & 63, wave = threadIdx.x >> 6;
  const float* mod = opq((const float*)(p.ws + WS_MOD) + (size_t)L * 9 * 6144); const float* nffn = opq(p.in[I_NFFN] + L * D);
  bf16_t* AF = (bf16_t*)(p.ws + WS_AF); bf16_t* FLO = (bf16_t*)(p.ws + B_FLO);
  asm volatile("s_waitcnt vmcnt(0)" ::: "memory");
  __syncthreads();
#pragma unroll 1
  for (int i0 = 0; i0 < 16; i0 += 4) {
    float4 v[4][4];
#pragma unroll
    for (int u = 0; u < 4; ++u) {
      const int r = mt * 128 + wave + 8 * (i0 + u);
#pragma unroll
      for (int j = 0; j < 4; ++j) { const f32x4 t = unpack4(((const uint2*)HROW(r))[lane + 64 * j]); v[u][j] = make_float4(t[0], t[1], t[2], t[3]); }
    }
#pragma unroll
    for (int u = 0; u < 4; ++u) {
      const int r = mt * 128 + wave + 8 * (i0 + u), b = r >> 12;
      norm_mod_row(v[u], nffn, mod + (size_t)b * 6144 + 4096, mod + (size_t)b * 6144 + 3072, AF + (size_t)r * D, FLO + (size_t)r * D, lane, p.ws + WS_AF8 + (size_t)r * D);
    }
  }
}

__device__ __forceinline__ void inproj0_panel(const Params& p, lptr lds, int pan) {
  const int tid_ = opaque((int)threadIdx.x);
  const bf16_t* AF = (const bf16_t*)(p.ws + WS_AF); const bf16_t* W = (const bf16_t*)(p.ws + WS_WIN0);
  bf16_t* GLU = (bf16_t*)(p.ws + B_GLU); bf16_t* CQ = (bf16_t*)(p.ws + B_CQ); bf16_t* CKV = (bf16_t*)(p.ws + B_CKV); bf16_t* KR = (bf16_t*)(p.ws + B_KR);
  const int mt = pan, nj = (pan < 256) ? 6 : 1, nt0 = (pan < 256) ? 0 : 5;
  StrideLoader al, bl;
  al.p0 = AF + (size_t)(mt * 128 + ROW8(0)) * D + CO8; al.ld64 = 64 * D;
  bl.p0 = W + (size_t)(nt0 * 256 + ROW8(0)) * D + CO8; bl.ld64 = 64 * D;
  int st = 0;
  gemm_pre_at<4>(al, bl, st, lds);
#pragma unroll 1
  for (int j = 0; j < nj; ++j) {
    const int nt = nt0 + j;
    f32x4 acc[4][4]; zero_acc(acc);
    StrideLoader bln = bl; bln.p0 += (size_t)256 * D;
    gemm_chain<true, 4>(acc, al, bl, 16, lds, st, j + 1 < nj, al, bln);
    bl = bln;
    const int te = opaque(tid_), le = te & 63, we = te >> 6, wm = we >> 2, wn = we & 3, q4 = le >> 4;
    const size_t row0 = (size_t)mt * 128 + wm * 64 + (le & 15);
    if (nt < 4) {
#pragma unroll
      for (int mi = 0; mi < 4; ++mi) {
        f32x4 v[2];
#pragma unroll
        for (int j2 = 0; j2 < 2; ++j2) {
          const f32x4 a = acc[mi][2 * j2], g = acc[mi][2 * j2 + 1];
#pragma unroll
          for (int r = 0; r < 4; ++r) v[j2][r] = a[r] * sigmoid_fast(g[r]);
        }
        store_row2(GLU + (row0 + mi * 16) * 512 + nt * 128 + wn * 32, v[0], v[1], q4);
      }
    } else if (nt == 4) {
#pragma unroll
      for (int mi = 0; mi < 4; ++mi) store_row4(CQ + (row0 + mi * 16) * 256 + wn * 64, acc[mi][0], acc[mi][1], acc[mi][2], acc[mi][3], q4);
    } else if (wn < 2) {
#pragma unroll
      for (int mi = 0; mi < 4; ++mi) store_row4(CKV + (row0 + mi * 16) * 128 + wn * 64, acc[mi][0], acc[mi][1], acc[mi][2], acc[mi][3], q4);
    } else if (wn == 2) {
#pragma unroll
      for (int mi = 0; mi < 4; ++mi) store_row2(KR + (row0 + mi * 16) * 32, acc[mi][0], acc[mi][1], q4);
    }
  }
  __syncthreads();
}

constexpr float QSCALE = 0.14724445f;

__device__ __forceinline__ void rstd_rows(const bf16_t* A, int lda, int klen, float extra, lptr lds) {
  const int tid = threadIdx.x, r = tid >> 2, qd = tid & 3;
  const bf16_t* ptr = A + (size_t)r * lda + qd * (klen >> 2);
  float ss = 0.f;
  for (int c = 0; c < (klen >> 5); ++c) {
    const uint4 u = *(const uint4*)(ptr + c * 8);
    const unsigned w[4] = {u.x, u.y, u.z, u.w};
#pragma unroll
    for (int q = 0; q < 4; ++q) { const float a = bflo(w[q]), b = bfhi(w[q]); ss += a * a + b * b; }
  }
  ss += __shfl_xor(ss, 1); ss += __shfl_xor(ss, 2);
  __syncthreads();
  if (qd == 0) ((LAS float*)(lds + XLDS))[r] = extra / sqrtf(ss / (float)klen + EPS);
}

__device__ __forceinline__ void upproj_panel(const Params& p, lptr lds, int pan) {
  const int tid_ = opaque((int)threadIdx.x);
  const int tid = tid_, lane = tid & 63, wave = tid >> 6, wm = wave >> 2, wn = wave & 3, q4 = lane >> 4;
  unsigned char* ws = p.ws;
  const float2* rope = opq((const float2*)(ws + WS_ROPE));
  const LAS float* rs = (const LAS float*)(lds + XLDS);
  bf16_t* Q = (bf16_t*)(ws + B_Q); bf16_t* KB = (bf16_t*)(ws + B_K); bf16_t* VT = (bf16_t*)(ws + B_VT);
  const int mt = pan;
  if (pan < 256) {
    const bf16_t* CQ = (const bf16_t*)(ws + B_CQ); const bf16_t* W = (const bf16_t*)(ws + WS_WUQ);
    rstd_rows(CQ + (size_t)mt * 128 * 256, 256, 256, QSCALE, lds);
#pragma unroll 1
    for (int nt = 0; nt < 3; ++nt) {
      StrideLoader al, bl;
      al.p0 = CQ + (size_t)(mt * 128 + ROW8(0)) * 256 + CO8; al.ld64 = 64 * 256;
      bl.p0 = W + (size_t)(nt * 256 + ROW8(0)) * 256 + CO8; bl.ld64 = 64 * 256;
      f32x4 acc[4][4]; zero_acc(acc);
      gemm_core<true, 4>(acc, al, bl, 4, lds);
      ep_banded<256>(lds, PutPlain<4>{acc}, [&](int rl, int col, f32x4 v) {
        const int row = mt * 128 + rl, b = row >> 12, tokb = row & 4095;
        const int fc = nt * 256 + (col & ~15), head = fc / 96, d0 = fc - head * 96, ci = col & 15;
        v = v * rs[rl];
        if (d0 >= 64) {
          const int pos = (d0 >= 80) ? (tokb & 63) : (tokb >> 6);
          const float2 c0 = rope[pos * 8 + (ci >> 1)], c1 = rope[pos * 8 + (ci >> 1) + 1];
          f32x4 o;
          o[0] = v[0] * c0.x - v[1] * c0.y; o[1] = v[1] * c0.x + v[0] * c0.y;
          o[2] = v[2] * c1.x - v[3] * c1.y; o[3] = v[3] * c1.x + v[2] * c1.y;
          v = o;
        }
        *(uint2*)(Q + ((size_t)(b * NH + head) * SEQ + tokb) * DQK + d0 + ci) = pack4(v);
      });
    }
  }
  {
    const bf16_t* CKV = (const bf16_t*)(ws + B_CKV); const bf16_t* W = (const bf16_t*)(ws + WS_WUKV);
    rstd_rows(CKV + (size_t)mt * 128 * 128, 128, 128, 1.0f, lds);
#pragma unroll 1
    for (int nt = 0; nt < 4; ++nt) {
      StrideLoader al, bl;
      al.p0 = CKV + (size_t)(mt * 128 + ROW8(0)) * 128 + CO8; al.ld64 = 64 * 128;
      bl.p0 = W + (size_t)(nt * 256 + ROW8(0)) * 128 + CO8; bl.ld64 = 64 * 128;
      f32x4 acc[4][4]; zero_acc(acc);
      if (nt < 2) {
        gemm_core<true, 4>(acc, al, bl, 2, lds);
        ep_banded<256>(lds, PutPlain<4>{acc}, [&](int rl, int colt, f32x4 v) {
          const int r = mt * 128 + rl;
          int b, key; if (r < T) { b = r >> 12; key = CL + (r & 4095); } else { const int rc = r - T; b = rc >> 8; key = rc & 255; }
          const int col = nt * 256 + colt, h = col >> 6, d = col & 63;
          *(uint2*)(KB + ((size_t)(b * NH + h) * NKEY + key) * DQK + d) = pack4(v * rs[rl]);
        });
      } else {
        gemm_core<false, 4>(acc, al, bl, 2, lds);
#pragma unroll
        for (int mi = 0; mi < 4; ++mi)
#pragma unroll
          for (int nj = 0; nj < 4; ++nj)
            *(LAS f32x4*)(lds + (wn * 64 + nj * 16 + (lane & 15)) * EPT_PITCH + (wm * 64 + mi * 16 + q4 * 4) * 4) = acc[mi][nj];
        __syncthreads();
#pragma unroll 4
        for (int idx = tid; idx < 256 * 32; idx += NTHREADS) {
          const int cr = idx >> 5, t4 = (idx & 31) * 4;
          f32x4 v = *(const LAS f32x4*)(lds + cr * EPT_PITCH + t4 * 4);
          v[0] *= rs[t4]; v[1] *= rs[t4 + 1]; v[2] *= rs[t4 + 2]; v[3] *= rs[t4 + 3];
          const int r = mt * 128 + t4;
          int b, key; if (r < T) { b = r >> 12; key = CL + (r & 4095); } else { const int rc = r - T; b = rc >> 8; key = rc & 255; }
          const int n = (nt - 2) * 256 + cr, h = n >> 6, dv = n & 63;
          *(uint2*)(VT + ((size_t)(b * NH + h) * DV + dv) * NKEY + key) = pack4(v);
        }
        __syncthreads();
      }
    }
  }
  {
    const bf16_t* KR = (const bf16_t*)(ws + B_KR);
#pragma unroll
    for (int i = 0; i < 2; ++i) {
      const int idx = pan * 1024 + tid + NTHREADS * i;
      const int r = idx >> 3, pc = idx & 7;
      const uint2 u = *(const uint2*)(KR + (size_t)r * 32 + pc * 4);
      float v0 = bflo(u.x), v1 = bfhi(u.x), v2 = bflo(u.y), v3 = bfhi(u.y);
      int b, key;
      if (r < T) {
        b = r >> 12; const int tokb = r & 4095; key = CL + tokb;
        const int pos = (pc >= 4) ? (tokb & 63) : (tokb >> 6), jb = (pc & 3) * 2;
        const float2 c0 = rope[pos * 8 + jb], c1 = rope[pos * 8 + jb + 1];
        const float o0 = v0 * c0.x - v1 * c0.y, o1 = v1 * c0.x + v0 * c0.y, o2 = v2 * c1.x - v3 * c1.y, o3 = v3 * c1.x + v2 * c1.y;
        v0 = o0; v1 = o1; v2 = o2; v3 = o3;
      } else { const int rc = r - T; b = rc >> 8; key = rc & 255; }
      uint2 o; o.x = pk2(v0, v1); o.y = pk2(v2, v3);
#pragma unroll
      for (int h = 0; h < NH; ++h) *(uint2*)(KB + ((size_t)(b * NH + h) * NKEY + key) * DQK + 64 + pc * 4) = o;
    }
  }
}

__device__ __forceinline__ void conv_units(const Params& p, lptr lds, int vb, int nblocks) {
  const int tid = threadIdx.x, lane = tid & 63, wave = tid >> 6;
  unsigned char* ws = p.ws;
  {
    const bf16_t* GLU = (const bf16_t*)(ws + B_GLU); bf16_t* OCAT = (bf16_t*)(ws + B_OCAT);
    const float* cw = p.in[I_EVCW]; const float* cb = p.in[I_EVCB]; const float* lw = p.in[I_EVLNW]; const float* lb = p.in[I_EVLNB];
    const int cp = tid & 255, th = tid >> 8;
    const lptr outl = lds + 65536;
    for (int u = vb; u < NB * 128; u += nblocks) {
      const int b = u >> 7, t0 = (u & 127) * 32;
      __syncthreads();
      for (int c = tid; c < 62 * 64; c += NTHREADS) {
        const int ti = c >> 6, ch = c & 63, tok = t0 - 15 + ti;
        uint4 v = make_uint4(0, 0, 0, 0);
        if (tok >= 0 && tok < SEQ) v = *(const uint4*)(GLU + ((size_t)(b * SEQ + tok)) * 512 + ch * 8);
        lds_w16(lds + ti * 1024 + ch * 16, v);
      }
      __syncthreads();
      float a0[16], a1[16];
#pragma unroll
      for (int k = 0; k < 16; ++k) { a0[k] = 0.f; a1[k] = 0.f; }
      for (int tap = 0; tap < 31; ++tap) {
        const float2 w = *(const float2*)(cw + tap * 512 + 2 * cp);
#pragma unroll
        for (int k = 0; k < 16; ++k) {
          const unsigned x = *(const LAS unsigned*)(lds + (th * 16 + k + tap) * 1024 + cp * 4);
          a0[k] += w.x * bflo(x); a1[k] += w.y * bfhi(x);
        }
      }
      const float2 bias = *(const float2*)(cb + 2 * cp);
#pragma unroll
      for (int k = 0; k < 16; ++k) *(LAS f32x2*)(outl + ((th * 16 + k) * 512 + 2 * cp) * 4) = (f32x2){a0[k] + bias.x, a1[k] + bias.y};
      __syncthreads();
#pragma unroll 1
      for (int q = 0; q < 4; ++q) {
        const int tk = wave * 4 + q;
        const f32x4 x0 = *(const LAS f32x4*)(outl + (tk * 512 + lane * 8) * 4), x1 = *(const LAS f32x4*)(outl + (tk * 512 + lane * 8 + 4) * 4);
        float s = (x0.x + x0.y) + (x0.z + x0.w) + (x1.x + x1.y) + (x1.z + x1.w);
        s = wave_sum(s);
        const float mean = s * (1.0f / 512.0f);
        const float d[8] = {x0.x - mean, x0.y - mean, x0.z - mean, x0.w - mean, x1.x - mean, x1.y - mean, x1.z - mean, x1.w - mean};
        float ss = 0.f;
#pragma unroll
        for (int e = 0; e < 8; ++e) ss += d[e] * d[e];
        ss = wave_sum(ss);
        const float rstd = 1.0f / sqrtf(ss * (1.0f / 512.0f) + EPS);
        const float4 w0 = *(const float4*)(lw + lane * 8), w1 = *(const float4*)(lw + lane * 8 + 4), b0 = *(const float4*)(lb + lane * 8), b1 = *(const float4*)(lb + lane * 8 + 4);
        const float wv[8] = {w0.x, w0.y, w0.z, w0.w, w1.x, w1.y, w1.z, w1.w}, bv[8] = {b0.x, b0.y, b0.z, b0.w, b1.x, b1.y, b1.z, b1.w};
        float y[8];
#pragma unroll
        for (int e = 0; e < 8; ++e) { const float z = d[e] * rstd * wv[e] + bv[e]; y[e] = z * sigmoid_fast(z); }
        uint4 o; o.x = pk2(y[0], y[1]); o.y = pk2(y[2], y[3]); o.z = pk2(y[4], y[5]); o.w = pk2(y[6], y[7]);
        *(uint4*)(OCAT + ((size_t)(b * SEQ + t0 + tk)) * D + lane * 8) = o;
      }
    }
    __syncthreads();
  }
}

__device__ __forceinline__ void phase4(const Params& p, lptr lds, int vb, int nblocks) {
  const int tid = threadIdx.x, lane = tid & 63, wave = __builtin_amdgcn_readfirstlane(tid >> 6), q4 = lane >> 4, li = lane & 15;
  const bf16_t* Q = (const bf16_t*)(p.ws + B_Q); const bf16_t* KB = (const bf16_t*)(p.ws + B_K); const bf16_t* VT = (const bf16_t*)(p.ws + B_VT);
  bf16_t* OCAT = (bf16_t*)(p.ws + B_OCAT);
  constexpr int STG = 20480, NKT = NKEY / 64, NQF = 4, QW = 16 * NQF, QU = 8 * QW;
  int koff[4], voff[2];
#pragma unroll
  for (int f = 0; f < 4; ++f) {
    const int row = 32 * (f >> 1) + 8 * (li >> 2) + 4 * (f & 1) + (li & 3);
    koff[f] = row * 192 + ((q4 ^ ((row >> 2) & 3)) << 4);
  }
#pragma unroll
  for (int g = 0; g < 2; ++g) voff[g] = 12288 + li * 128 + ((((4 * g + q4) ^ (lane & 7))) << 4);
  int soff[3]; bool isk[3];
#pragma unroll
  for (int i = 0; i < 3; ++i) {
    const int pi = wave + 8 * i;
    if (pi < 12) { const int P = pi * 1024 + lane * 16, row = P / 192, rem = P - row * 192, ks = rem >> 6, pq = (rem & 63) >> 4; soff[i] = row * DQK + ks * 32 + ((pq ^ ((row >> 2) & 3)) << 3); isk[i] = true; }
    else { const int P = (pi - 12) * 1024 + lane * 16, dv = P >> 7, pc = (P & 127) >> 4; soff[i] = dv * NKEY + ((pc ^ (dv & 7)) << 3); isk[i] = false; }
  }
  const bool three = wave < 4;
  constexpr int UPB = SEQ / QU;
  for (int unit = vb; unit < NB * NH * UPB; unit += nblocks) {
    const int qb = unit % UPB, bh = unit / UPB;
    const bf16_t* Qp = Q + ((size_t)bh * SEQ + qb * QU + wave * QW) * DQK;
    const bf16_t* Kp = KB + (size_t)bh * NKEY * DQK;
    const bf16_t* Vp = VT + (size_t)bh * DV * NKEY;
    bf16x8 qf[NQF][3];
#pragma unroll
    for (int f2 = 0; f2 < NQF; ++f2)
#pragma unroll
      for (int ks = 0; ks < 3; ++ks) qf[f2][ks] = *(const bf16x8*)(Qp + (f2 * 16 + li) * DQK + ks * 32 + q4 * 8);
    WAIT_VM(0);
#define ATT_ISSUE(kt_, stage_) do { \
      _Pragma("unroll") for (int i_ = 0; i_ < 3; ++i_) { if (i_ < 2 || three) { \
        const bf16_t* g_ = isk[i_] ? Kp + (size_t)(kt_) * 64 * DQK + soff[i_] : Vp + (kt_) * 64 + soff[i_]; \
        glds16(g_, lds + (stage_) * STG + (wave + 8 * i_) * 1024); } } } while (0)
#pragma unroll
    for (int t = 0; t < 3; ++t) ATT_ISSUE(t, t);
    f32x4 o[4][NQF];
    float mrun[NQF], lrun[NQF];
#pragma unroll
    for (int f2 = 0; f2 < NQF; ++f2) { mrun[f2] = -1000.f; lrun[f2] = 0.f;
#pragma unroll
      for (int a = 0; a < 4; ++a) o[a][f2] = (f32x4){0.f, 0.f, 0.f, 0.f}; }
    int st = 0;
    for (int kt = 0; kt < NKT; ++kt) {
      if (kt + 2 < NKT) { if (three) WAIT_VM(6); else WAIT_VM(4); }
      else if (kt + 1 < NKT) { if (three) WAIT_VM(3); else WAIT_VM(2); }
      else WAIT_VM(0);
      asm volatile("s_waitcnt lgkmcnt(0)" ::: "memory");
      __builtin_amdgcn_s_barrier();
      asm volatile("" ::: "memory");
      if (kt + 3 < NKT) ATT_ISSUE(kt + 3, (st + 3) & 3);
      const lptr cur = lds + st * STG;
#pragma unroll
      for (int hh = 0; hh < NQF / 2; ++hh) {
        f32x4 s[2][4];
#pragma unroll
        for (int f2 = 0; f2 < 2; ++f2)
#pragma unroll
          for (int f = 0; f < 4; ++f) { const float nm = -mrun[2 * hh + f2]; s[f2][f] = (f32x4){nm, nm, nm, nm}; }
#pragma unroll
        for (int ks = 0; ks < 3; ++ks)
#pragma unroll
          for (int f = 0; f < 4; ++f) {
            const bf16x8 kf = lds_r16(cur + koff[f] + ks * 64);
            s[0][f] = __builtin_amdgcn_mfma_f32_16x16x32_bf16(kf, qf[2 * hh][ks], s[0][f], 0, 0, 0);
            s[1][f] = __builtin_amdgcn_mfma_f32_16x16x32_bf16(kf, qf[2 * hh + 1][ks], s[1][f], 0, 0, 0);
          }
        bf16x8 pf[2][2];
        float mx[2];
#pragma unroll
        for (int f2 = 0; f2 < 2; ++f2) {
          float m_ = s[f2][0][0];
#pragma unroll
          for (int f = 0; f < 4; ++f)
#pragma unroll
            for (int r = 0; r < 4; ++r) m_ = fmaxf(m_, s[f2][f][r]);
          mx[f2] = m_;
        }
        if (!__all(fmaxf(mx[0], mx[1]) <= 6.0f)) {
#pragma unroll
          for (int f2 = 0; f2 < 2; ++f2) {
            const int q = 2 * hh + f2;
            float m_ = mx[f2];
            m_ = fmaxf(m_, __shfl_xor(m_, 16)); m_ = fmaxf(m_, __shfl_xor(m_, 32));
            const float d = fmaxf(m_, 0.f);
            const float alpha = __builtin_amdgcn_exp2f(-d);
            mrun[q] += d; lrun[q] *= alpha;
#pragma unroll
            for (int a = 0; a < 4; ++a) o[a][q] = o[a][q] * alpha;
#pragma unroll
            for (int f = 0; f < 4; ++f) s[f2][f] = s[f2][f] - d;
          }
        }
#pragma unroll
        for (int f2 = 0; f2 < 2; ++f2) {
          const int q = 2 * hh + f2;
          float rsum = 0.f;
#pragma unroll
          for (int f = 0; f < 4; ++f)
#pragma unroll
            for (int r = 0; r < 4; ++r) { const float e = __builtin_amdgcn_exp2f(s[f2][f][r]); s[f2][f][r] = e; rsum += e; }
          lrun[q] += rsum;
#pragma unroll
          for (int g = 0; g < 2; ++g) {
            union { bf16x8 v; unsigned u[4]; } cv;
            cv.u[0] = pk2(s[f2][2 * g][0], s[f2][2 * g][1]); cv.u[1] = pk2(s[f2][2 * g][2], s[f2][2 * g][3]);
            cv.u[2] = pk2(s[f2][2 * g + 1][0], s[f2][2 * g + 1][1]); cv.u[3] = pk2(s[f2][2 * g + 1][2], s[f2][2 * g + 1][3]);
            pf[f2][g] = cv.v;
          }
        }
#pragma unroll
        for (int g = 0; g < 2; ++g)
#pragma unroll
          for (int a = 0; a < 4; ++a) {
            const bf16x8 vf = lds_r16(cur + voff[g] + a * 2048);
            o[a][2 * hh] = __builtin_amdgcn_mfma_f32_16x16x32_bf16(vf, pf[0][g], o[a][2 * hh], 0, 0, 0);
            o[a][2 * hh + 1] = __builtin_amdgcn_mfma_f32_16x16x32_bf16(vf, pf[1][g], o[a][2 * hh + 1], 0, 0, 0);
          }
        __builtin_amdgcn_sched_barrier(0);
      }
      st = (st + 1) & 3;
    }
    __syncthreads();
    const int b = bh >> 3, h = bh & 7;
#pragma unroll
    for (int f2 = 0; f2 < NQF; ++f2) {
      float lt = lrun[f2]; lt += __shfl_xor(lt, 16); lt += __shfl_xor(lt, 32);
      const float inv = 1.0f / lt;
      const size_t row = (size_t)b * SEQ + qb * QU + wave * QW + f2 * 16 + li;
      store_row4(OCAT + row * D + 512 + h * 64, o[0][f2] * inv, o[1][f2] * inv, o[2][f2] * inv, o[3][f2] * inv, q4);
    }
  }
#undef ATT_ISSUE
}

__device__ __forceinline__ void outproj_panel(const Params& p, int L, lptr lds, int mt) {
  const int tid_ = opaque((int)threadIdx.x);
  const bf16_t* A = (const bf16_t*)(p.ws + (L == 0 ? B_OCAT : B_S)); const bf16_t* W = (const bf16_t*)(p.ws + (L == 0 ? WS_WOUT0 : WS_WOUT1));
  const float* mod = (const float*)(p.ws + WS_MOD) + (size_t)L * 9 * 6144;
  StrideLoader al, bl;
  al.p0 = A + (size_t)(mt * 128 + ROW8(0)) * D + CO8; al.ld64 = 64 * D;
  bl.p0 = W + (size_t)ROW8(0) * D + CO8; bl.ld64 = 64 * D;
  int st = 0;
  gemm_pre_at<4>(al, bl, st, lds);
#pragma unroll 1
  for (int nt = 0; nt < 4; ++nt) {
    f32x4 acc[4][4]; zero_acc(acc);
    StrideLoader bln = bl; bln.p0 += (size_t)256 * D;
    gemm_chain<true, 4>(acc, al, bl, 16, lds, st, nt < 3, al, bln);
    bl = bln;
    const int te = opaque(tid_), le = te & 63, we = te >> 6, wm = we >> 2, wn = we & 3, q4 = le >> 4;
#pragma unroll
    for (int mi = 0; mi < 4; ++mi) {
      const int row = mt * 128 + wm * 64 + mi * 16 + (le & 15), b = (mt * 128) >> 12;
      bf16_t* hrow = HROW(row) + nt * 256 + wn * 64;
      f32x4 xv[4];
      if (L == 0) {
#pragma unroll
        for (int n4 = 0; n4 < 4; ++n4) xv[n4] = *(const f32x4*)(p.in[I_X] + (size_t)row * D + nt * 256 + wn * 64 + n4 * 16 + q4 * 4);
      } else {
        const u32x4 t0 = ((const u32x4*)(hrow + q4 * 16))[0], t1 = ((const u32x4*)(hrow + q4 * 16))[1];
        uint2 ha = make_uint2(t0[0], t0[1]), hb = make_uint2(t0[2], t0[3]), hc = make_uint2(t1[0], t1[1]), hd = make_uint2(t1[2], t1[3]);
        tr4x4(ha.x, hb.x, hc.x, hd.x); tr4x4(ha.y, hb.y, hc.y, hd.y);
        xv[0] = unpack4(ha); xv[1] = unpack4(hb); xv[2] = unpack4(hc); xv[3] = unpack4(hd);
      }
#pragma unroll
      for (int n4 = 0; n4 < 4; ++n4) {
        const f32x4 g1 = *(const f32x4*)(mod + (size_t)b * 6144 + 2048 + nt * 256 + wn * 64 + n4 * 16 + q4 * 4);
        xv[n4] = xv[n4] + g1 * acc[mi][n4];
      }
      store_row4(hrow, xv[0], xv[1], xv[2], xv[3], q4);
    }
  }
  __syncthreads();
}

__device__ __forceinline__ void expert_unit(const Params& p, int L, const bf16_t* Wgu, const bf16_t* Wd, const int* list, int nvalid, int m0, lptr lds, int dry = 0) {
  const int tid = opaque((int)threadIdx.x), tid_ = tid;
  const bf16_t* AF = (const bf16_t*)(p.ws + WS_AF8);
  unsigned char* ACT = p.ws + WS_ACT + (size_t)blockIdx.x * 128 * 256;
  LAS int* info = (LAS int*)(lds + XLDS + 512);
  LAS float* wrow = (LAS float*)(lds + XLDS);
  __syncthreads();
  if (tid < 128) {
    const int inf = list ? ((tid < nvalid) ? list[tid] : -1) : ((m0 + tid) * 8 + 7);
    info[tid] = inf;
    wrow[tid] = (inf >= 0 && (inf & 7) != 7) ? ((const float*)(p.ws + WS_WTS))[inf] : 1.0f;
  }
  __syncthreads();
  {
    RowLoader2 al; StrideLoader bl;
#pragma unroll
    for (int i = 0; i < 2; ++i) { const int inf = info[ROW8(i)]; al.p[i] = AF + (size_t)((inf >= 0) ? (inf >> 3) : 0) * 512 + CO8; }
    bl.p0 = Wgu + (size_t)ROW8(0) * 512 + CO8; bl.ld64 = 64 * 512;
    int st = 0;
    gemm_pre_at<4>(al, bl, st, lds);
#pragma unroll 1
    for (int nt = 0; nt < 2; ++nt) {
      f32x4 acc[4][4]; zero_acc(acc);
      StrideLoader bln = bl; bln.p0 += (size_t)256 * 512;
      gemm_chain8<4>(acc, al, bl, 8, lds, st, nt == 0, al, bln);
      bl = bln;
      {
        const int te = opaque(tid), le = te & 63, we = te >> 6, wm = we >> 2, wn = we & 3, q4 = le >> 4;
#pragma unroll
        for (int mi = 0; mi < 4; ++mi)
          {
            unsigned x[2];
#pragma unroll
            for (int j2 = 0; j2 < 2; ++j2) {
              const f32x4 g = acc[mi][2 * j2], u = acc[mi][2 * j2 + 1]; f32x4 v;
#pragma unroll
              for (int r = 0; r < 4; ++r) { const float gg = g[r] * F8_INV; v[r] = gg * sigmoid_fast(gg) * u[r] * (F8_INV * F8_SACT); }
              x[j2] = pack4_fp8c(v);
            }
            { auto r = __builtin_amdgcn_permlane16_swap(x[0], x[1], false, false); x[0] = r[0]; x[1] = r[1]; }
            *(uint2*)(ACT + (size_t)(wm * 64 + mi * 16 + (le & 15)) * 256 + nt * 128 + wn * 32 + (q4 & 1) * 16 + (q4 >> 1) * 8) = make_uint2(x[0], x[1]);
          }
      }
    }
  }
  asm volatile("s_waitcnt vmcnt(0)" ::: "memory");
  __syncthreads();
  const bool shared_u = (list == nullptr);
  unsigned char* CONTRIB = p.ws + B_CONTRIB; unsigned char* SHC = p.ws + B_SHC;
  {
    StrideLoader al, bl;
    al.p0 = (const bf16_t*)ACT + (size_t)ROW8(0) * 128 + CO8; al.ld64 = 64 * 128;
    bl.p0 = Wd + (size_t)ROW8(0) * 128 + CO8; bl.ld64 = 64 * 128;
    int st = 0;
    gemm_pre_at<4>(al, bl, st, lds);
#pragma unroll 1
    for (int nt = 0; nt < 4; ++nt) {
      f32x4 acc[4][4]; zero_acc(acc);
      StrideLoader bln = bl; bln.p0 += (size_t)256 * 128;
      gemm_chain8<4>(acc, al, bl, 2, lds, st, nt < 3, al, bln);
      bl = bln;
      {
        const int te = opaque(tid), le = te & 63, we = te >> 6, wm = we >> 2, wn = we & 3, q4 = le >> 4;
#pragma unroll
        for (int mi = 0; mi < 4; ++mi) {
          const int rl = wm * 64 + mi * 16 + (le & 15);
          const int inf = info[rl];
          const int tok = inf >> 3, k = inf & 7;
          const float w = wrow[rl] * F8_INV;
          {
            unsigned x0 = pack4_fp8c(acc[mi][0] * w), x1 = pack4_fp8c(acc[mi][1] * w), x2 = pack4_fp8c(acc[mi][2] * w), x3 = pack4_fp8c(acc[mi][3] * w);
            tr4x4(x0, x1, x2, x3);
            unsigned char* dstrow = shared_u ? SHC + (size_t)tok * D : CONTRIB + ((size_t)tok * 6 + k) * D;
            if (inf >= 0 && !dry) *(u32x4*)(dstrow + nt * 256 + wn * 64 + q4 * 16) = (u32x4){x0, x1, x2, x3};
          }
        }
      }
    }
  }
  __syncthreads();
}

struct RouterA {
  static constexpr bool DIRECT = true;
  typedef uint4 Raw; const bf16_t* ph; const bf16_t* pl;
  __device__ __forceinline__ const bf16_t* gp(int i, int kt) const { return ((kt >= 16 && kt < 32) ? pl + (kt - 16) * 64 : ph + (kt & 15) * 64) + (size_t)i * 64 * D; }
  __device__ __forceinline__ void pre(int) {}
  __device__ __forceinline__ Raw ld(int, int) const { return make_uint4(0, 0, 0, 0); }
  __device__ __forceinline__ uint4 cvt(const Raw& r, int) const { return r; }
};

__device__ __forceinline__ void router_tile(const Params& p, int L, lptr lds, int mt) {
  const int tid_ = opaque((int)threadIdx.x);
  const bool dry = false;
  const int tid = tid_, lane = tid & 63, wave = tid >> 6, wm = wave >> 2, wn = wave & 3, q4 = lane >> 4;
  unsigned char* ws = p.ws;
  const bf16_t* AF = (const bf16_t*)(ws + WS_AF); const bf16_t* FLO = (const bf16_t*)(ws + B_FLO);
  const bf16_t* WR = (const bf16_t*)(ws + WS_WR) + (size_t)L * 128 * 3072;
  int* counts = (int*)(ws + WS_CNT) + L * NE; int* lists = (int*)(ws + WS_LISTS); float* wts = (float*)(ws + WS_WTS);
  const float* rbias = opq(p.in[I_RB] + L * NE);
  {
    {
      RouterA al; StrideLoader bl;
      al.ph = AF + (size_t)(mt * 128 + ROW8(0)) * D + CO8;
      al.pl = FLO + (size_t)(mt * 128 + ROW8(0)) * D + CO8;
      bl.p0 = WR + (size_t)ROW8(0) * 3072 + CO8; bl.ld64 = 64 * 3072;
      f32x4 acc[4][1]; zero_acc(acc);
      gemm_core<true, 1>(acc, al, bl, 48, lds);
      LAS float* lg = (LAS float*)lds;
      LAS float* sg = (LAS float*)(lds + 33280);
      LAS int* lcnt = (LAS int*)(lds + XLDS + 1280);
#pragma unroll
      for (int mi = 0; mi < 4; ++mi)
#pragma unroll
        for (int r = 0; r < 4; ++r) lg[(wm * 64 + mi * 16 + (lane & 15)) * 65 + wn * 16 + q4 * 4 + r] = acc[mi][0][r];
      if (tid < 64) lcnt[tid] = 0;
      __syncthreads();
      int eidx[TOPK]; int lslot[TOPK]; float wk[TOPK];
      if (tid < 128) {
        LAS float* lr = lg + tid * 65; LAS float* sr = sg + tid * 65;
        float gs[8];
#pragma unroll
        for (int g = 0; g < 8; ++g) {
          float m1 = -INFINITY, m2 = -INFINITY;
#pragma unroll
          for (int j = 0; j < 8; ++j) {
            const float sc = sigmoidf_(lr[g * 8 + j]); sr[g * 8 + j] = sc;
            const float v = sc + rbias[g * 8 + j]; lr[g * 8 + j] = v;
            if (v > m1) { m2 = m1; m1 = v; } else if (v > m2) m2 = v;
          }
          gs[g] = m1 + m2;
        }
        unsigned gmask = 0;
#pragma unroll
        for (int it = 0; it < 4; ++it) {
          float best = -INFINITY; int bi = 0;
#pragma unroll
          for (int g = 0; g < 8; ++g) if (!((gmask >> g) & 1u) && gs[g] > best) { best = gs[g]; bi = g; }
          gmask |= 1u << bi;
        }
        unsigned long long taken = 0ull; float ssum = 0.f;
#pragma unroll
        for (int k = 0; k < TOPK; ++k) {
          float best = -INFINITY; int bi = 0;
#pragma unroll 8
          for (int e = 0; e < NE; ++e) {
            const float v = lr[e];
            if (((gmask >> (e >> 3)) & 1u) && !((taken >> e) & 1ull) && v > best) { best = v; bi = e; }
          }
          taken |= 1ull << bi; eidx[k] = bi; wk[k] = sr[bi]; ssum += wk[k];
        }
        const float inv = 2.5f / ssum;
#pragma unroll
        for (int k = 0; k < TOPK; ++k) { wk[k] *= inv; lslot[k] = dry ? 0 : atomicAdd((int*)(lcnt + eidx[k]), 1); }
      }
      __syncthreads();
      if (tid < 64 && !dry) { const int c = lcnt[tid]; lcnt[64 + tid] = c ? atomicAdd(&counts[tid], c) : 0; }
      __syncthreads();
      if (tid < 128 && !dry) {
        const int tok = mt * 128 + tid;
#pragma unroll
        for (int k = 0; k < TOPK; ++k) {
          lists[(size_t)eidx[k] * T + lcnt[64 + eidx[k]] + lslot[k]] = tok * 8 + k;
          wts[tok * 8 + k] = wk[k];
        }
      }
      __syncthreads();
    }
  }
}

__device__ __forceinline__ void shared_unit(const Params& p, int L, lptr lds, int mt) {
  const bf16_t* wg = (const bf16_t*)(p.ws + WS_WSGU + (size_t)L * 512 * 1024); const bf16_t* wd = (const bf16_t*)(p.ws + WS_WSD + (size_t)L * 1024 * 256); const int* nolist = nullptr;
  asm volatile("" : "+s"(wg), "+s"(wd), "+s"(nolist));
  expert_unit(p, L, wg, wd, nolist, 128, mt * 128, lds, 0);
}

__device__ __forceinline__ void phase_experts(const Params& p, int L, lptr lds, int vb, int nblocks, int dry = 0) {
  const int tid = threadIdx.x;
  int* counts = (int*)(p.ws + WS_CNT) + L * NE; const int* lists = (const int*)(p.ws + WS_LISTS);
  LAS int* cnt = (LAS int*)(lds + XLDS + 1024);
  __syncthreads();
  if (tid < 64) cnt[tid] = __hip_atomic_load(&counts[tid], __ATOMIC_RELAXED, __HIP_MEMORY_SCOPE_AGENT);
  __syncthreads();
  int e = 0, base = 0;
  for (int u = vb;; u += nblocks) {
    while (e < NE && u >= base + ((cnt[e] + 127) >> 7)) { base += (cnt[e] + 127) >> 7; ++e; }
    if (e >= NE) break;
    const int rb = u - base, c = cnt[e];
    int nv = c - rb * 128; if (nv > 128) nv = 128;
    expert_unit(p, L, (const bf16_t*)(p.ws + WS_WEGU + (size_t)e * 512 * 1024), (const bf16_t*)(p.ws + WS_WED + (size_t)e * 1024 * 256),
                      lists + (size_t)e * T + rb * 128, nv, 0, lds, dry);
  }
}

__device__ __forceinline__ void combine_panel(const Params& p, int L, int mt) {
  const int lane = threadIdx.x & 63, wave = threadIdx.x >> 6;
  const float* mod = opq((const float*)(p.ws + WS_MOD)); const float* nmix1 = opq(p.in[I_NMIX] + D); const float* fnw = opq(p.in[I_FNW]);
  const unsigned char* CONTRIB = p.ws + B_CONTRIB;
  bf16_t* AF = (bf16_t*)(p.ws + WS_AF);
#pragma unroll 2
  for (int r = mt * 128 + wave; r < mt * 128 + 128; r += NWAVES) {
    const int b = r >> 12;
    float4 v[4];
#pragma unroll
    for (int j = 0; j < 4; ++j) {
      const int c = lane + 64 * j;
      const f32x4 ht = unpack4(((const uint2*)HROW(r))[c]); float4 h = make_float4(ht[0], ht[1], ht[2], ht[3]);
      float s0 = 0.f, s1 = 0.f, s2 = 0.f, s3 = 0.f;
#pragma unroll
      for (int k = 0; k < 6; ++k) {
        const int u = (int)((const unsigned*)(CONTRIB + ((size_t)r * 6 + k) * D))[c];
        const f32x2 lo = __builtin_amdgcn_cvt_pk_f32_fp8(u, false), hi = __builtin_amdgcn_cvt_pk_f32_fp8(u, true);
        s0 += lo[0]; s1 += lo[1]; s2 += hi[0]; s3 += hi[1];
      }
      {
        const int u = (int)((const unsigned*)(p.ws + B_SHC + (size_t)r * D))[c];
        const f32x2 lo = __builtin_amdgcn_cvt_pk_f32_fp8(u, false), hi = __builtin_amdgcn_cvt_pk_f32_fp8(u, true);
        s0 += lo[0]; s1 += lo[1]; s2 += hi[0]; s3 += hi[1];
      }
      const float4 g2 = ((const float4*)(mod + (size_t)(L * 9 + b) * 6144 + 5120))[c];
      h.x += g2.x * s0; h.y += g2.y * s1; h.z += g2.z * s2; h.w += g2.w * s3;
      v[j] = h;
    }
    if (L == 0) {
#pragma unroll
      for (int j = 0; j < 4; ++j) ((uint2*)HROW(r))[lane + 64 * j] = pack4((f32x4){v[j].x, v[j].y, v[j].z, v[j].w});
      const float* m1 = mod + (size_t)(9 + b) * 6144;
      norm_mod_row(v, nmix1, m1 + 1024, m1, nullptr, nullptr, lane, p.ws + WS_AF8 + (size_t)r * D);
    } else {
      float ss = 0.f;
#pragma unroll
      for (int j = 0; j < 4; ++j) ss += (v[j].x * v[j].x + v[j].y * v[j].y) + (v[j].z * v[j].z + v[j].w * v[j].w);
      ss = wave_sum(ss);
      const float rstd = 1.0f / sqrtf(ss * (1.0f / 1024.0f) + EPS);
#pragma unroll
      for (int j = 0; j < 4; ++j) {
        const float4 w = ((const float4*)fnw)[lane + 64 * j];
        float4 o; o.x = v[j].x * rstd * w.x; o.y = v[j].y * rstd * w.y; o.z = v[j].z * rstd * w.z; o.w = v[j].w * rstd * w.w;
        ((float4*)(p.out + (size_t)r * D))[lane + 64 * j] = o;
      }
    }
  }
}

__device__ __forceinline__ void convert_experts(const Params& p, int L, lptr lds, int vb, int nblocks, int first = 0, int last = NE * 384) {
  const int lane = threadIdx.x & 63, wave = threadIdx.x >> 6;
  LAS float* scr = (LAS float*)(lds + wave * 8448);
  __syncthreads();
  for (int it = first + vb * NWAVES + wave; it < last; it += nblocks * NWAVES) expert_item(p, L, it, scr, lane);
  __syncthreads();
}
constexpr int CONV_EARLY = 10240;

__device__ __forceinline__ void inproj1_panel(const Params& p, lptr lds, int mt) {
  const int tid_ = opaque((int)threadIdx.x);
  const bf16_t* AF = (const bf16_t*)(p.ws + WS_AF8); const bf16_t* W = (const bf16_t*)(p.ws + WS_WIN1);
  bf16_t* PB = (bf16_t*)(p.ws + B_P); bf16_t* BB = (bf16_t*)(p.ws + B_B);
  StrideLoader al, bl;
  al.p0 = AF + (size_t)(mt * 128 + ROW8(0)) * 512 + CO8; al.ld64 = 64 * 512;
  bl.p0 = W + (size_t)ROW8(0) * 512 + CO8; bl.ld64 = 64 * 512;
  int st = 0;
  gemm_pre_at<4>(al, bl, st, lds);
#pragma unroll 1
  for (int nt = 0; nt < 12; ++nt) {
    f32x4 acc[4][4]; zero_acc(acc);
    StrideLoader bln = bl; bln.p0 += (size_t)256 * 512;
    gemm_chain8<4>(acc, al, bl, 8, lds, st, nt < 11, al, bln);
    bl = bln;
    const int te = opaque(tid_), le = te & 63, we = te >> 6, wm = we >> 2, wn = we & 3, q4 = le >> 4;
    const size_t row0 = (size_t)mt * 128 + wm * 64 + (le & 15);
    if (nt < 8) {
#pragma unroll
      for (int mi = 0; mi < 4; ++mi) store_row2(PB + (row0 + mi * 16) * D + nt * 128 + wn * 32, acc[mi][0] * acc[mi][1] * (F8_INV * F8_INV), acc[mi][2] * acc[mi][3] * (F8_INV * F8_INV), q4);
    } else {
#pragma unroll
      for (int mi = 0; mi < 4; ++mi) store_row4(BB + (row0 + mi * 16) * D + (nt - 8) * 256 + wn * 64, acc[mi][0] * F8_INV, acc[mi][1] * F8_INV, acc[mi][2] * F8_INV, acc[mi][3] * F8_INV, q4);
    }
  }
  __syncthreads();
}

__device__ __forceinline__ void conv3_panel(const Params& p, int mt) {
  const int lane = threadIdx.x & 63, wave = threadIdx.x >> 6;
  const bf16_t* PB = (const bf16_t*)(p.ws + B_P); const bf16_t* BB = (const bf16_t*)(p.ws + B_B); bf16_t* SB = (bf16_t*)(p.ws + B_S);
  const float* cw = opq(p.in[I_ODCW]);
  float w0[16], w1[16], w2[16];
#pragma unroll
  for (int h = 0; h < 2; ++h)
#pragma unroll
    for (int q = 0; q < 2; ++q) {
      const int c = h * 512 + lane * 8 + q * 4;
      const float4 a = *(const float4*)(cw + c), b = *(const float4*)(cw + 1024 + c), d = *(const float4*)(cw + 2048 + c);
      const int o = h * 8 + q * 4;
      w0[o] = a.x; w0[o + 1] = a.y; w0[o + 2] = a.z; w0[o + 3] = a.w; w1[o] = b.x; w1[o + 1] = b.y; w1[o + 2] = b.z; w1[o + 3] = b.w; w2[o] = d.x; w2[o + 1] = d.y; w2[o + 2] = d.z; w2[o + 3] = d.w;
    }
#pragma unroll 2
  for (int r = mt * 128 + wave; r < mt * 128 + 128; r += NWAVES) {
    const int tokb = r & 4095;
    const float fm = tokb > 0 ? 1.f : 0.f, fp = tokb < SEQ - 1 ? 1.f : 0.f;
#pragma unroll
    for (int h = 0; h < 2; ++h) {
      const size_t o = (size_t)r * D + h * 512 + lane * 8;
      const uint4 bq = *(const uint4*)(BB + o), pc = *(const uint4*)(PB + o);
      const uint4 pm = *(const uint4*)(PB + o - (tokb > 0 ? D : 0)), pn = *(const uint4*)(PB + o + (tokb < SEQ - 1 ? D : 0));
      const unsigned bb[4] = {bq.x, bq.y, bq.z, bq.w}, m[4] = {pm.x, pm.y, pm.z, pm.w}, c[4] = {pc.x, pc.y, pc.z, pc.w}, n[4] = {pn.x, pn.y, pn.z, pn.w};
      unsigned ov[4];
#pragma unroll
      for (int q = 0; q < 4; ++q) {
        const int e = h * 8 + 2 * q;
        const float lo = bflo(bb[q]) * (fm * w0[e] * bflo(m[q]) + w1[e] * bflo(c[q]) + fp * w2[e] * bflo(n[q]));
        const float hi = bfhi(bb[q]) * (fm * w0[e + 1] * bfhi(m[q]) + w1[e + 1] * bfhi(c[q]) + fp * w2[e + 1] * bfhi(n[q]));
        ov[q] = pk2(lo, hi);
      }
      *(uint4*)(SB + o) = make_uint4(ov[0], ov[1], ov[2], ov[3]);
    }
  }
}

#define XB_TMO      128
#define XB_XCNT(j)  (256  + 64 * (j))
#define XB_XSUB(j)  (1280 + 64 * (j))
#define XB_XGEN(j)  (2304 + 64 * (j))
#define XB_TOP      3328
#define XB_TOPGEN   3392
#define XCD_BAR_WORDS 3456
#define XB_SPIN_CAP (1u << 22)
__device__ __forceinline__ unsigned xb_ld(unsigned* p) { return __hip_atomic_load(p, __ATOMIC_RELAXED, __HIP_MEMORY_SCOPE_AGENT); }
__device__ __forceinline__ unsigned xb_add(unsigned* p, unsigned v) { return __hip_atomic_fetch_add(p, v, __ATOMIC_RELAXED, __HIP_MEMORY_SCOPE_AGENT); }
__device__ __forceinline__ unsigned xb_xcc_id() { return (unsigned)__builtin_amdgcn_s_getreg((3 << 11) | 20) & 0xFu; }
#define XB_SPIN(cond, bar) do { unsigned _sp = 0; while (cond) { __builtin_amdgcn_s_sleep(1); \
    if ((++_sp & 255u) == 0u) { if (xb_ld(&(bar)[XB_TMO])) break; if (_sp > XB_SPIN_CAP) { atomicAdd(&(bar)[XB_TMO], 1u); break; } } } } while (0)
struct XcdBarrier { unsigned* bar; unsigned x; volatile LAS unsigned* st; };
__device__ __forceinline__ XcdBarrier xcd_barrier_post(unsigned* bar, volatile LAS unsigned* st) {
  XcdBarrier b; b.bar = bar; b.x = xb_xcc_id(); b.st = st;
  if (threadIdx.x == 0) (void)xb_add(&bar[XB_XCNT(b.x)], 1u);
  return b;
}
__device__ __forceinline__ void xcd_barrier_complete(unsigned* bar, unsigned x, unsigned& nloc, unsigned& nx) {
  const unsigned G = gridDim.x * gridDim.y * gridDim.z;
  unsigned sum, cnt, mine, sp = 0u;
  for (;;) {
    sum = 0u; cnt = 0u; mine = 0u;
#pragma unroll
    for (unsigned j = 0; j < 16; ++j) { const unsigned c = xb_ld(&bar[XB_XCNT(j)]); sum += c; cnt += (c > 0u) ? 1u : 0u; mine = (j == x) ? c : mine; }
    if (sum == G) break;
    __builtin_amdgcn_s_sleep(1);
    if ((++sp & 255u) == 0u) { if (xb_ld(&bar[XB_TMO])) break; if (sp > XB_SPIN_CAP) { atomicAdd(&bar[XB_TMO], 1u); break; } }
  }
  nloc = mine > 0u ? mine : 1u; nx = cnt > 0u ? cnt : 1u;
}
__device__ __forceinline__ void xcd_barrier(unsigned* bar_, lptr lds) {
  asm volatile("s_waitcnt vmcnt(0)" ::: "memory");
  __syncthreads();
  if (threadIdx.x == 0) {
    XcdBarrier b; b.bar = bar_; b.x = xb_xcc_id(); b.st = (volatile LAS unsigned*)(lds + LDS_BYTES - 16);
    unsigned* bar = b.bar;
    __builtin_amdgcn_s_waitcnt(0);
    unsigned nloc = b.st[0], nx = b.st[1];
    if (nloc == 0u) { xcd_barrier_complete(bar, b.x, nloc, nx); b.st[0] = nloc; b.st[1] = nx; }
    const unsigned old = xb_add(&bar[XB_XSUB(b.x)], 1u);
    const unsigned gen = old / nloc;
    if (old + 1u == (gen + 1u) * nloc) {
      __builtin_amdgcn_fence(__ATOMIC_RELEASE, "agent");
      asm volatile("s_waitcnt vmcnt(0)" ::: "memory");
      const unsigned og = xb_add(&bar[XB_TOP], 1u);
      const unsigned tg = og / nx;
      if (og + 1u == (tg + 1u) * nx) xb_add(&bar[XB_TOPGEN], 1u);
      else XB_SPIN(xb_ld(&bar[XB_TOPGEN]) == tg, bar);
      __builtin_amdgcn_fence(__ATOMIC_ACQUIRE, "agent");
      xb_add(&bar[XB_XGEN(b.x)], 1u);
      asm volatile("s_waitcnt vmcnt(0)" ::: "memory");
    } else {
      XB_SPIN(xb_ld(&bar[XB_XGEN(b.x)]) == gen, bar);
      __builtin_amdgcn_fence(__ATOMIC_ACQUIRE, "agent");
      asm volatile("s_waitcnt vmcnt(0)" ::: "memory");
    }
  }
  __syncthreads();
}

__global__ void __launch_bounds__(NTHREADS, 2) fwd_kernel(Params p) {
  extern __shared__ __attribute__((aligned(16))) unsigned char smem[];
  lptr lds = (lptr)smem;
  const int nblocks = gridDim.x;
  const int bx = blockIdx.x;
  const int vb = ((nblocks & 7) == 0) ? (bx & 7) * (nblocks >> 3) + (bx >> 3) : bx;
  cg::grid_group grid = cg::this_grid();
  volatile LAS unsigned* bst = (volatile LAS unsigned*)(lds + LDS_BYTES - 16);
  if (threadIdx.x == 0) { bst[0] = 0u; bst[1] = 0u; }
  __syncthreads();
  if (p.ph_hi - p.ph_lo > 2) (void)xcd_barrier_post((unsigned*)(p.ws + WS_BAR), bst);
  const int lo = p.ph_lo, hi = p.ph_hi;
#ifdef ONLY_PHASE
#define IN(k) ((k) == ONLY_PHASE && lo <= (k) && (k) < hi)
#else
#define IN(k) (lo <= (k) && (k) < hi)
#endif
#ifndef PROBE_DOUBLE
#define PROBE_DOUBLE -1
#endif
#define SEAM(k) do { if (lo <= (k) && (k) + 1 < hi) { if ((k) == lo) grid.sync(); else xcd_barrier((unsigned*)(p.ws + WS_BAR), lds); } } while (0)
#define PANEL_SYNC() do { asm volatile("s_waitcnt vmcnt(0)" ::: "memory"); __syncthreads(); } while (0)
  if (IN(0)) phase0(p, lds, vb, nblocks);
  SEAM(0);
  if (IN(1)) {
    for (int pan = vb; pan < 272; pan += nblocks) {
      a0_panel(p, pan); PANEL_SYNC();
      inproj0_panel(p, lds, pan); PANEL_SYNC();
      upproj_panel(p, lds, pan);
    }
    if (nblocks == 256 && vb >= 16) convert_experts(p, 0, lds, vb - 16, 240, 0, CONV_EARLY);
  }
  SEAM(1);
  if (IN(2)) {
    const bool early = (blockIdx.x & 1) == 0;
    const int cfirst = (nblocks == 256) ? CONV_EARLY : 0;
    if (early) convert_experts(p, 0, lds, vb, nblocks, cfirst);
    phase4(p, lds, vb, nblocks); conv_units(p, lds, vb, nblocks);
    if (!early) convert_experts(p, 0, lds, vb, nblocks, cfirst);
  }
  SEAM(2);
  if (IN(3)) {
    for (int mt = vb; mt < 256; mt += nblocks) {
      outproj_panel(p, 0, lds, mt);
      ffnprep_panel(p, 0, mt); PANEL_SYNC();
      router_tile(p, 0, lds, mt);
      shared_unit(p, 0, lds, mt);
    }
  }
  SEAM(3);
  if (IN(4)) phase_experts(p, 0, lds, vb, nblocks);
  SEAM(4);
  if (IN(5)) {
    const bool early = (blockIdx.x & 1) == 0;
    if (early) convert_experts(p, 1, lds, vb, nblocks);
    for (int mt = vb; mt < 256; mt += nblocks) {
      combine_panel(p, 0, mt); PANEL_SYNC();
      inproj1_panel(p, lds, mt);
    }
    if (!early) convert_experts(p, 1, lds, vb, nblocks);
  }
  SEAM(5);
  if (IN(6)) {
    for (int mt = vb; mt < 256; mt += nblocks) {
      conv3_panel(p, mt); PANEL_SYNC();
      outproj_panel(p, 1, lds, mt);
      ffnprep_panel(p, 1, mt); PANEL_SYNC();
      router_tile(p, 1, lds, mt);
      shared_unit(p, 1, lds, mt);
    }
  }
  SEAM(6);
  if (IN(7)) phase_experts(p, 1, lds, vb, nblocks);
  SEAM(7);
  if (IN(8)) { for (int mt = vb; mt < 256; mt += nblocks) combine_panel(p, 1, mt); }
}

extern "C" void kernel_launch(void* const* d_in, const int* in_sizes, int n_in, void* d_out, int out_size,
                              void* d_ws, size_t ws_size, hipStream_t stream) {
  static int grid_blocks = 0;
  if (!grid_blocks) {
    int dev = 0, cus = 0, per_cu = 0;
    (void)hipGetDevice(&dev);
    (void)hipDeviceGetAttribute(&cus, hipDeviceAttributeMultiprocessorCount, dev);
    if (hipFuncSetAttribute((const void*)fwd_kernel, hipFuncAttributeMaxDynamicSharedMemorySize, LDS_BYTES) != hipSuccess) fprintf(stderr, "hipFuncSetAttribute failed\n");
    if (hipOccupancyMaxActiveBlocksPerMultiprocessor(&per_cu, fwd_kernel, NTHREADS, LDS_BYTES) != hipSuccess) per_cu = 0;
    fprintf(stderr, "kernel_launch: cus %d per_cu %d ws %zu n_in %d\n", cus, per_cu, ws_size, n_in);
    if (per_cu > 1) per_cu = 1;
    if (per_cu < 1) per_cu = 1;
    grid_blocks = cus * per_cu; if (grid_blocks > 256) grid_blocks = 256;
    if (ws_size < WS_END || n_in != N_IN) { fprintf(stderr, "kernel_launch: bad ws/n_in\n"); grid_blocks = -1; }
  }
  if (grid_blocks < 0) return;
  (void)hipMemsetAsync(d_ws, 0, 64 * 1024, stream);
  Params p{};
  for (int i = 0; i < N_IN; ++i) p.in[i] = (const float*)d_in[i];
  p.out = (float*)d_out; p.ws = (unsigned char*)d_ws;
#if MK_MULTI
  for (int ph = 0; ph < NPHASE; ++ph) {
    p.ph_lo = ph; p.ph_hi = ph + 1;
    hipLaunchKernelGGL(fwd_kernel, dim3(grid_blocks), dim3(NTHREADS), LDS_BYTES, stream, p);
  }
#else
  p.ph_lo = 0; p.ph_hi = NPHASE;
  void* args[] = {&p};
  hipError_t e = hipLaunchCooperativeKernel((void*)fwd_kernel, dim3(grid_blocks), dim3(NTHREADS), args, LDS_BYTES, stream);
  if (e != hipSuccess) fprintf(stderr, "cooperative launch failed: %s (grid %d)\n", hipGetErrorString(e), grid_blocks);
#endif
}
```

```cpp
#include <hip/hip_runtime.h>
#include <hip/hip_cooperative_groups.h>
#include <cstdio>
#include <cstdint>
namespace cg = cooperative_groups;

#ifndef MK_MULTI
#define MK_MULTI 0
#endif

#define LAS __attribute__((address_space(3)))
typedef unsigned short bf16_t;
typedef short bf16x8 __attribute__((ext_vector_type(8)));
typedef float f32x4 __attribute__((ext_vector_type(4)));
typedef LAS unsigned char* lptr;
typedef unsigned u32x4 __attribute__((ext_vector_type(4)));
typedef float f32x2 __attribute__((ext_vector_type(2)));
typedef int i32x4 __attribute__((ext_vector_type(4)));
typedef int i32x8 __attribute__((ext_vector_type(8)));
constexpr float F8_SA = 4.0f, F8_SW1 = 256.0f, F8_SACT = 8.0f, F8_SW2 = 128.0f, F8_INV = 1.0f / 1024.0f;

constexpr int D = 1024, NB = 8, SEQ = 4096, T = NB * SEQ, CL = 256, TC = NB * CL, TT = T + TC, NKEY = SEQ + CL;
constexpr int NH = 8, DQK = 96, DV = 64;
constexpr int NE = 64, TOPK = 6;
constexpr float EPS = 1e-6f;
constexpr int NPHASE = 9;
constexpr int NTHREADS = 512, NWAVES = 8;
constexpr int RING_BYTES = 147456;
constexpr int XLDS = RING_BYTES;
constexpr int LDS_BYTES = RING_BYTES + 2048;

enum { I_X = 0, I_C, I_CTX, I_CCTX, I_ADAW, I_ADAB, I_NMIX, I_NFFN, I_EVWIN, I_EVCW, I_EVCB, I_EVLNW, I_EVLNB, I_QNW, I_KVNW,
       I_WUQ, I_WUKV, I_EVWOUT, I_ODWIN, I_ODCW, I_ODWOUT, I_RW, I_RB, I_EG, I_EU, I_ED, I_SG, I_SU, I_SD, I_FNW, N_IN };

struct Params {
  const float* in[N_IN];
  float* out;
  unsigned char* ws;
  int ph_lo, ph_hi;
};

constexpr size_t MiB = 1u << 20;
constexpr size_t WS_CNT = 0;
constexpr size_t WS_BAR = 16 * 1024;
constexpr size_t WS_MOD = 64 * 1024;
constexpr size_t WS_ROPE = WS_MOD + 512 * 1024;
constexpr size_t WS_CW1 = WS_ROPE + 8 * 1024;
constexpr size_t WS_WTS = 1 * MiB;
constexpr size_t WS_LISTS = 2 * MiB;
constexpr size_t WS_ACT = 10 * MiB;
constexpr size_t WS_WIN0 = 26 * MiB;
constexpr size_t WS_WUQ = 29 * MiB;
constexpr size_t WS_WUKV = WS_WUQ + 512 * 1024;
constexpr size_t WS_WOUT0 = 30 * MiB;
constexpr size_t WS_WIN1 = 32 * MiB;
constexpr size_t WS_WOUT1 = 38 * MiB;
constexpr size_t WS_WR = 40 * MiB;
constexpr size_t WS_WSGU = 42 * MiB;
constexpr size_t WS_WSD = 44 * MiB;
constexpr size_t WS_WEGU = 46 * MiB;
constexpr size_t WS_AF8 = 78 * MiB;
constexpr size_t WS_WED = 110 * MiB;
constexpr size_t WS_AF = 142 * MiB;
constexpr size_t WS_BIG = 210 * MiB;
constexpr size_t WS_END = 594 * MiB;
constexpr size_t B_GLU = WS_BIG + 0 * MiB;
constexpr size_t B_CQ = WS_BIG + 32 * MiB;
constexpr size_t B_CKV = WS_BIG + 48 * MiB;
constexpr size_t B_KR = WS_BIG + 57 * MiB;
constexpr size_t B_Q = WS_BIG + 60 * MiB;
constexpr size_t B_K = WS_BIG + 108 * MiB;
constexpr size_t B_VT = WS_BIG + 159 * MiB;
constexpr size_t B_OCAT = WS_BIG + 193 * MiB;
constexpr size_t B_FLO = WS_BIG + 64 * MiB;
constexpr size_t B_CONTRIB = WS_BIG;
constexpr size_t B_P = WS_BIG + 192 * MiB;
constexpr size_t B_B = WS_BIG + 256 * MiB;
constexpr size_t B_SHC = WS_BIG + 320 * MiB;
constexpr size_t B_S = WS_BIG;

typedef __bf16 bf16v2_t __attribute__((ext_vector_type(2)));
__device__ __forceinline__ unsigned pk2(float lo, float hi) {
  bf16v2_t v; v[0] = (__bf16)lo; v[1] = (__bf16)hi; return __builtin_bit_cast(unsigned, v);
}
__device__ __forceinline__ float bflo(unsigned u) { return __uint_as_float(u << 16); }
__device__ __forceinline__ float bfhi(unsigned u) { return __uint_as_float(u & 0xffff0000u); }
__device__ __forceinline__ unsigned pack4_fp8(f32x4 v) {
  int u = __builtin_amdgcn_cvt_pk_fp8_f32(v[0], v[1], 0, false);
  u = __builtin_amdgcn_cvt_pk_fp8_f32(v[2], v[3], u, true);
  return (unsigned)u;
}
__device__ __forceinline__ unsigned pack4_fp8c(f32x4 v) {
#pragma unroll
  for (int r = 0; r < 4; ++r) v[r] = fminf(fmaxf(v[r], -448.0f), 448.0f);
  return pack4_fp8(v);
}
__device__ __forceinline__ uint2 pack4(f32x4 v) { uint2 r; r.x = pk2(v[0], v[1]); r.y = pk2(v[2], v[3]); return r; }
__device__ __forceinline__ f32x4 unpack4(uint2 u) { return (f32x4){bflo(u.x), bfhi(u.x), bflo(u.y), bfhi(u.y)}; }
#define HROW(r) ((bf16_t*)(p.out + (size_t)(r) * D))
__device__ __forceinline__ void tr4x4(unsigned& x0, unsigned& x1, unsigned& x2, unsigned& x3) {
  { auto r = __builtin_amdgcn_permlane32_swap(x0, x2, false, false); x0 = r[0]; x2 = r[1]; }
  { auto r = __builtin_amdgcn_permlane32_swap(x1, x3, false, false); x1 = r[0]; x3 = r[1]; }
  { auto r = __builtin_amdgcn_permlane16_swap(x0, x1, false, false); x0 = r[0]; x1 = r[1]; }
  { auto r = __builtin_amdgcn_permlane16_swap(x2, x3, false, false); x2 = r[0]; x3 = r[1]; }
}
__device__ __forceinline__ void store_row4(bf16_t* rowp, f32x4 v0, f32x4 v1, f32x4 v2, f32x4 v3, int q4) {
  uint2 a = pack4(v0), b = pack4(v1), c = pack4(v2), d = pack4(v3);
  tr4x4(a.x, b.x, c.x, d.x); tr4x4(a.y, b.y, c.y, d.y);
  u32x4* o = (u32x4*)(rowp + q4 * 16);
  o[0] = (u32x4){a.x, a.y, b.x, b.y}; o[1] = (u32x4){c.x, c.y, d.x, d.y};
}
__device__ __forceinline__ void store_row2(bf16_t* rowp, f32x4 v0, f32x4 v1, int q4) {
  uint2 a = pack4(v0), b = pack4(v1);
  { auto r = __builtin_amdgcn_permlane16_swap(a.x, b.x, false, false); a.x = r[0]; b.x = r[1]; }
  { auto r = __builtin_amdgcn_permlane16_swap(a.y, b.y, false, false); a.y = r[0]; b.y = r[1]; }
  *(u32x4*)(rowp + (q4 & 1) * 16 + (q4 >> 1) * 8) = (u32x4){a.x, a.y, b.x, b.y};
}
__device__ __forceinline__ float wave_sum(float v) {
#pragma unroll
  for (int o = 1; o < 64; o <<= 1) v += __shfl_xor(v, o);
  return v;
}
__device__ __forceinline__ void lds_w16(lptr p, uint4 v) { *(LAS u32x4*)p = (u32x4){v.x, v.y, v.z, v.w}; }
__device__ __forceinline__ bf16x8 lds_r16(lptr p) { return *(LAS bf16x8*)p; }
__device__ __forceinline__ i32x4 lds_r16i(lptr p) { return *(LAS i32x4*)p; }
__device__ __forceinline__ float sigmoidf_(float x) { return 1.0f / (1.0f + __expf(-x)); }
__device__ __forceinline__ float sigmoid_fast(float x) { return __builtin_amdgcn_rcpf(1.0f + __expf(-x)); }


#define GAS __attribute__((address_space(1)))
__device__ __forceinline__ void glds16(const bf16_t* g, lptr l) {
  __builtin_amdgcn_global_load_lds((const GAS unsigned*)g, (LAS unsigned*)l, 16, 0, 0);
}
__device__ __forceinline__ int opaque(int x) { asm volatile("" : "+v"(x)); return x; }
template <class TP> __device__ __forceinline__ TP* opq(TP* x) { asm volatile("" : "+s"(x)); return x; }
#define CO8 ((((tid_ & 7) ^ ((tid_ >> 3) & 7))) << 3)
#define ROW8(i) ((i) * 64 + (tid_ >> 6) * 8 + ((tid_ & 63) >> 3))
#define WAIT_VM(n) asm volatile("s_waitcnt vmcnt(" #n ")" ::: "memory")
struct StrideLoader {
  static constexpr bool DIRECT = true;
  typedef uint4 Raw;
  const bf16_t* p0; int ld64;
  __device__ __forceinline__ const bf16_t* gp(int i, int kt) const { return p0 + (size_t)i * ld64 + kt * 64; }
  __device__ __forceinline__ void pre(int) {}
  __device__ __forceinline__ Raw ld(int, int) const { return make_uint4(0, 0, 0, 0); }
  __device__ __forceinline__ uint4 cvt(const Raw& r, int) const { return r; }
};
struct RowLoader2 {
  static constexpr bool DIRECT = true;
  typedef uint4 Raw;
  const bf16_t* p[2];
  __device__ __forceinline__ const bf16_t* gp(int i, int kt) const { return p[i] + kt * 64; }
  __device__ __forceinline__ void pre(int) {}
  __device__ __forceinline__ Raw ld(int, int) const { return make_uint4(0, 0, 0, 0); }
  __device__ __forceinline__ uint4 cvt(const Raw& r, int) const { return r; }
};

template <int NW, class AL, class BL>
__device__ __forceinline__ void gemm_pre(AL& al, BL& bl, int nk, lptr lds) {
  static_assert(AL::DIRECT && BL::DIRECT, "gemm_pre: LDS-DMA loaders only");
  const int wbase = __builtin_amdgcn_readfirstlane(opaque((int)threadIdx.x) >> 6) * 1024;
#pragma unroll
  for (int t = 0; t < 2; ++t) {
    if (t < nk) {
#pragma unroll
      for (int i = 0; i < 2; ++i) glds16(al.gp(i, t), lds + t * 49152 + i * 8192 + wbase);
#pragma unroll
      for (int i = 0; i < NW; ++i) glds16(bl.gp(i, t), lds + t * 49152 + 16384 + i * 8192 + wbase);
    }
  }
}
template <bool SWAP, int NW, bool PRE = false, class AL, class BL>
__device__ __forceinline__ void gemm_core(f32x4 (&acc)[4][NW], AL& al, BL& bl, int nk, lptr lds) {
  static_assert(BL::DIRECT, "B operand is always staged by LDS-DMA");
  static_assert(NW == 4 || NW == 1, "NW");
  constexpr int BS = NW;
  constexpr int STAGE = 49152, B_OFF = 16384;
  const int tid = opaque((int)threadIdx.x), lane = tid & 63, wave = __builtin_amdgcn_readfirstlane(tid >> 6), wm = wave >> 2, wn = wave & 3;
  int aoff[2], boff[2];
#pragma unroll
  for (int ks = 0; ks < 2; ++ks) {
    const int sw = (((ks * 4 + (lane >> 4)) ^ (lane & 7)) << 4);
    aoff[ks] = (wm * 64 + (lane & 15)) * 128 + sw;
    boff[ks] = B_OFF + (wn * 16 * NW + (lane & 15)) * 128 + sw;
  }
  const int wbase = wave * 1024;
  const int woff = (wave * 8 + (lane >> 3)) * 128 + (((lane & 7) ^ ((lane >> 3) & 7)) << 4);
  typename AL::Raw ra[2];
#pragma unroll
  for (int t = 0; t < 2; ++t) {
    if (!PRE && t < nk) {
      if constexpr (AL::DIRECT) {
#pragma unroll
        for (int i = 0; i < 2; ++i) glds16(al.gp(i, t), lds + t * STAGE + i * 8192 + wbase);
      } else {
        al.pre(t);
#pragma unroll
        for (int i = 0; i < 2; ++i) ra[i] = al.ld(i, t);
#pragma unroll
        for (int i = 0; i < 2; ++i) lds_w16(lds + t * STAGE + woff + i * 8192, al.cvt(ra[i], i));
      }
#pragma unroll
      for (int i = 0; i < BS; ++i) glds16(bl.gp(i, t), lds + t * STAGE + B_OFF + i * 8192 + wbase);
    }
  }
  int st = 0;
  for (int kt = 0; kt < nk; ++kt) {
    if constexpr (AL::DIRECT) {
      if (kt > 0 && kt + 1 < nk) { if constexpr (NW == 4) WAIT_VM(6); else WAIT_VM(3); } else WAIT_VM(0);
    } else WAIT_VM(0);
    asm volatile("s_waitcnt lgkmcnt(0)" ::: "memory");
    __builtin_amdgcn_s_barrier();
    asm volatile("" ::: "memory");
    const int s2 = (st == 0) ? 2 : st - 1;
    const bool more = (kt + 2 < nk);
    if (more) {
      if constexpr (AL::DIRECT) {
#pragma unroll
        for (int i = 0; i < 2; ++i) glds16(al.gp(i, kt + 2), lds + s2 * STAGE + i * 8192 + wbase);
      } else {
        al.pre(kt + 2);
#pragma unroll
        for (int i = 0; i < 2; ++i) ra[i] = al.ld(i, kt + 2);
      }
#pragma unroll
      for (int i = 0; i < BS; ++i) glds16(bl.gp(i, kt + 2), lds + s2 * STAGE + B_OFF + i * 8192 + wbase);
    }
    const lptr base = lds + st * STAGE;
#pragma unroll
    for (int ks = 0; ks < 2; ++ks) {
      bf16x8 af[4], bfr[NW];
#pragma unroll
      for (int i = 0; i < 4; ++i) af[i] = lds_r16(base + aoff[ks] + i * 2048);
#pragma unroll
      for (int j = 0; j < NW; ++j) bfr[j] = lds_r16(base + boff[ks] + j * 2048);
      __builtin_amdgcn_s_setprio(1);
#pragma unroll
      for (int i = 0; i < 4; ++i)
#pragma unroll
        for (int j = 0; j < NW; ++j)
          acc[i][j] = SWAP ? __builtin_amdgcn_mfma_f32_16x16x32_bf16(bfr[j], af[i], acc[i][j], 0, 0, 0)
                           : __builtin_amdgcn_mfma_f32_16x16x32_bf16(af[i], bfr[j], acc[i][j], 0, 0, 0);
      __builtin_amdgcn_s_setprio(0);
    }
    if constexpr (!AL::DIRECT) {
      if (more) {
#pragma unroll
        for (int i = 0; i < 2; ++i) lds_w16(lds + s2 * STAGE + woff + i * 8192, al.cvt(ra[i], i));
      }
    }
    st = (st == 2) ? 0 : st + 1;
  }
  __syncthreads();
}

template <int NW>
__device__ __forceinline__ void zero_acc(f32x4 (&acc)[4][NW]) {
#pragma unroll
  for (int i = 0; i < 4; ++i)
#pragma unroll
    for (int j = 0; j < NW; ++j) acc[i][j] = (f32x4){0.f, 0.f, 0.f, 0.f};
}


template <int NW, class AL, class BL>
__device__ __forceinline__ void gemm_pre_at(AL& al, BL& bl, int st, lptr lds) {
  const int wbase = __builtin_amdgcn_readfirstlane(opaque((int)threadIdx.x) >> 6) * 1024;
#pragma unroll
  for (int t = 0; t < 2; ++t) {
    const int sg = (st + t) % 3;
#pragma unroll
    for (int i = 0; i < 2; ++i) glds16(al.gp(i, t), lds + sg * 49152 + i * 8192 + wbase);
#pragma unroll
    for (int i = 0; i < NW; ++i) glds16(bl.gp(i, t), lds + sg * 49152 + 16384 + i * 8192 + wbase);
  }
}
template <bool SWAP, int NW, class AL, class BL, class ALN, class BLN>
__device__ __forceinline__ void gemm_chain(f32x4 (&acc)[4][NW], AL& al, BL& bl, int nk, lptr lds, int& st_io, bool has_next, ALN& aln, BLN& bln) {
  constexpr int STAGE = 49152, B_OFF = 16384;
  const int tid = opaque((int)threadIdx.x), lane = tid & 63, wave = __builtin_amdgcn_readfirstlane(tid >> 6), wm = wave >> 2, wn = wave & 3;
  int aoff[2], boff[2];
#pragma unroll
  for (int ks = 0; ks < 2; ++ks) {
    const int sw = (((ks * 4 + (lane >> 4)) ^ (lane & 7)) << 4);
    aoff[ks] = (wm * 64 + (lane & 15)) * 128 + sw;
    boff[ks] = B_OFF + (wn * 16 * NW + (lane & 15)) * 128 + sw;
  }
  const int wbase = wave * 1024;
  int st = st_io;
  for (int kt = 0; kt < nk; ++kt) {
    if (kt > 0 && (kt + 1 < nk || has_next)) { if constexpr (NW == 4) WAIT_VM(6); else WAIT_VM(3); } else WAIT_VM(0);
    asm volatile("s_waitcnt lgkmcnt(0)" ::: "memory");
    __builtin_amdgcn_s_barrier();
    asm volatile("" ::: "memory");
    const lptr base = lds + st * STAGE;
#pragma unroll
    for (int ks = 0; ks < 2; ++ks) {
      bf16x8 af[4], bfr[NW];
#pragma unroll
      for (int i = 0; i < 4; ++i) af[i] = lds_r16(base + aoff[ks] + i * 2048);
#pragma unroll
      for (int j = 0; j < NW; ++j) bfr[j] = lds_r16(base + boff[ks] + j * 2048);
      if (ks == 1) {
      const int s2 = (st == 0) ? 2 : st - 1;
      const int t2 = kt + 2;
      if (t2 < nk) {
  #pragma unroll
        for (int i = 0; i < 2; ++i) glds16(al.gp(i, t2), lds + s2 * STAGE + i * 8192 + wbase);
  #pragma unroll
        for (int i = 0; i < NW; ++i) glds16(bl.gp(i, t2), lds + s2 * STAGE + B_OFF + i * 8192 + wbase);
      } else if (has_next) {
  #pragma unroll
        for (int i = 0; i < 2; ++i) glds16(aln.gp(i, t2 - nk), lds + s2 * STAGE + i * 8192 + wbase);
  #pragma unroll
        for (int i = 0; i < NW; ++i) glds16(bln.gp(i, t2 - nk), lds + s2 * STAGE + B_OFF + i * 8192 + wbase);
      }
      }
      __builtin_amdgcn_s_setprio(1);
#pragma unroll
      for (int i = 0; i < 4; ++i)
#pragma unroll
        for (int j = 0; j < NW; ++j)
          acc[i][j] = SWAP ? __builtin_amdgcn_mfma_f32_16x16x32_bf16(bfr[j], af[i], acc[i][j], 0, 0, 0)
                           : __builtin_amdgcn_mfma_f32_16x16x32_bf16(af[i], bfr[j], acc[i][j], 0, 0, 0);
      __builtin_amdgcn_s_setprio(0);
    }
    st = (st == 2) ? 0 : st + 1;
  }
  st_io = st;
}
template <int NW, class AL, class BL, class ALN, class BLN>
__device__ __forceinline__ void gemm_chain8(f32x4 (&acc)[4][NW], AL& al, BL& bl, int nk, lptr lds, int& st_io, bool has_next, ALN& aln, BLN& bln) {
  constexpr int STAGE = 49152, B_OFF = 16384;
  const int tid = opaque((int)threadIdx.x), lane = tid & 63, wave = __builtin_amdgcn_readfirstlane(tid >> 6), wm = wave >> 2, wn = wave & 3;
  int aoff[2], boff[2];
#pragma unroll
  for (int ks = 0; ks < 2; ++ks) {
    const int sw = (((ks * 4 + (lane >> 4)) ^ (lane & 7)) << 4);
    aoff[ks] = (wm * 64 + (lane & 15)) * 128 + sw;
    boff[ks] = B_OFF + (wn * 16 * NW + (lane & 15)) * 128 + sw;
  }
  const int wbase = wave * 1024;
  int st = st_io;
  asm volatile("" : "+s"(nk));
#pragma unroll 1
  for (int kt = 0; kt < nk; ++kt) {
    if (kt > 0 && (kt + 1 < nk || has_next)) { if constexpr (NW == 4) WAIT_VM(6); else WAIT_VM(3); } else WAIT_VM(0);
    asm volatile("s_waitcnt lgkmcnt(0)" ::: "memory");
    __builtin_amdgcn_s_barrier();
    asm volatile("" ::: "memory");
    const lptr base = lds + st * STAGE;
    i32x8 af[4], bfr[NW];
#pragma unroll
    for (int j = 0; j < NW; ++j) bfr[j] = __builtin_shufflevector(lds_r16i(base + boff[0] + j * 2048), lds_r16i(base + boff[1] + j * 2048), 0, 1, 2, 3, 4, 5, 6, 7);
#pragma unroll
    for (int i = 0; i < 4; ++i) af[i] = __builtin_shufflevector(lds_r16i(base + aoff[0] + i * 2048), lds_r16i(base + aoff[1] + i * 2048), 0, 1, 2, 3, 4, 5, 6, 7);
    {
      const int s2 = (st == 0) ? 2 : st - 1;
      const int t2 = kt + 2;
      if (t2 < nk) {
  #pragma unroll
        for (int i = 0; i < 2; ++i) glds16(al.gp(i, t2), lds + s2 * STAGE + i * 8192 + wbase);
  #pragma unroll
        for (int i = 0; i < NW; ++i) glds16(bl.gp(i, t2), lds + s2 * STAGE + B_OFF + i * 8192 + wbase);
      } else if (has_next) {
  #pragma unroll
        for (int i = 0; i < 2; ++i) glds16(aln.gp(i, t2 - nk), lds + s2 * STAGE + i * 8192 + wbase);
  #pragma unroll
        for (int i = 0; i < NW; ++i) glds16(bln.gp(i, t2 - nk), lds + s2 * STAGE + B_OFF + i * 8192 + wbase);
      }
    }
    __builtin_amdgcn_s_setprio(1);
#pragma unroll
    for (int i = 0; i < 4; ++i)
#pragma unroll
      for (int j = 0; j < NW; ++j)
        acc[i][j] = __builtin_amdgcn_mfma_scale_f32_16x16x128_f8f6f4(bfr[j], af[i], acc[i][j], 0, 0, 0, 0x7f7f7f7f, 0, 0x7f7f7f7f);
    __builtin_amdgcn_s_setprio(0);
    st = (st == 2) ? 0 : st + 1;
  }
  st_io = st;
}

constexpr int EP_PITCH = 1040;
constexpr int EP_BASE = 98304;
constexpr int EPT_PITCH = 528;
template <int NW>
struct PutPlain {
  const f32x4 (&acc)[4][NW];
  template <class W> __device__ __forceinline__ void operator()(int band, int tid, W w) const {
    const int lane = tid & 63, wave = tid >> 6, wm = wave >> 2, wn = wave & 3;
    if (wm != (band >> 1)) return;
#pragma unroll
    for (int m2 = 0; m2 < 2; ++m2)
#pragma unroll
      for (int nj = 0; nj < NW; ++nj) w(m2 * 16 + (lane & 15), wn * 16 * NW + nj * 16 + (lane >> 4) * 4, acc[2 * (band & 1) + m2][nj]);
  }
};
template <class OP>
struct PutPair {
  const f32x4 (&acc)[4][4]; OP op;
  template <class W> __device__ __forceinline__ void operator()(int band, int tid, W w) const {
    const int lane = tid & 63, wave = tid >> 6, wm = wave >> 2, wn = wave & 3;
    if (wm != (band >> 1)) return;
#pragma unroll
    for (int m2 = 0; m2 < 2; ++m2)
#pragma unroll
      for (int j2 = 0; j2 < 2; ++j2) {
        const f32x4 x = acc[2 * (band & 1) + m2][2 * j2], y = acc[2 * (band & 1) + m2][2 * j2 + 1]; f32x4 v;
#pragma unroll
        for (int r = 0; r < 4; ++r) v[r] = op(x[r], y[r]);
        w(m2 * 16 + (lane & 15), wn * 32 + j2 * 16 + (lane >> 4) * 4, v);
      }
  }
};
template <int NC, int UNR = 4, class PUT, class F>
__device__ __forceinline__ void ep_banded(lptr lds, const PUT& put, F f) {
  constexpr int CPR = NC / 4;
  const int tid = opaque((int)threadIdx.x);
#pragma unroll
  for (int band = 0; band < 4; ++band) {
    put(band, tid, [&](int rb, int col, f32x4 v) { *(LAS f32x4*)(lds + EP_BASE + rb * EP_PITCH + col * 4) = v; });
    __syncthreads();
    static_assert((32 * CPR) % NTHREADS == 0, "ep_banded: whole passes");
#pragma unroll
    for (int it = 0; it < (32 * CPR) / NTHREADS; ++it) {
      const int idx = tid + it * NTHREADS;
      const int rb = idx / CPR, c4 = idx - rb * CPR;
      const f32x4 v = *(const LAS f32x4*)(lds + EP_BASE + rb * EP_PITCH + c4 * 16);
      f(band * 32 + rb, c4 * 4, v);
    }
    __syncthreads();
    __builtin_amdgcn_sched_barrier(0);
  }
}

enum { M_ID = 0, M_WIN0, M_WUQ, M_WUKV, M_WIN1, M_GATE, M_UP };
__device__ __forceinline__ int map_col(int mode, int n) {
  switch (mode) {
    case M_WIN0:
      if (n < 512) return ((n >> 4) << 5) + (n & 15);
      if (n < 1024) { const int c = n - 512; return ((c >> 4) << 5) + 16 + (c & 15); }
      if (n < 1408) return n;
      { const int i = n - 1408; return 1408 + (i & 16) + ((i & 7) << 1) + ((i >> 3) & 1); }
    case M_WUQ: { const int h = n / 96, d = n - h * 96; if (d < 64) return n; const int i = d - 64; return h * 96 + 64 + (i & 16) + ((i & 7) << 1) + ((i >> 3) & 1); }
    case M_WUKV: { const int h = n >> 7, d = n & 127; return d < 64 ? h * 64 + d : 512 + h * 64 + (d - 64); }
    case M_WIN1:
      if (n < 1024) return 2048 + n;
      if (n < 2048) { const int c = n - 1024; return ((c >> 4) << 5) + (c & 15); }
      { const int c = n - 2048; return ((c >> 4) << 5) + 16 + (c & 15); }
    case M_GATE: return ((n >> 4) << 5) + (n & 15);
    case M_UP: return ((n >> 4) << 5) + 16 + (n & 15);
    default: return n;
  }
}
#define WAVE_LDS_SYNC() do { asm volatile("s_waitcnt lgkmcnt(0)" ::: "memory"); __builtin_amdgcn_wave_barrier(); asm volatile("" ::: "memory"); } while (0)
__device__ __forceinline__ void transpose_item(const float* W, int K, int N, bf16_t* dst, int ldd, int mode, const float* kscale, int item, LAS float* scr, int lane) {
  const int nblk = N >> 5, kb = item / nblk, nb = item - kb * nblk, k0 = kb * 64, n0 = nb * 32;
  float4 tv[8];
#pragma unroll
  for (int i = 0; i < 8; ++i) tv[i] = *(const float4*)(W + (size_t)(k0 + 8 * i + (lane >> 3)) * N + n0 + (lane & 7) * 4);
#pragma unroll
  for (int i = 0; i < 8; ++i) {
    const int kk = 8 * i + (lane >> 3);
    const float ks = kscale ? kscale[k0 + kk] : 1.0f;
    LAS float* d = scr + kk * 33 + (lane & 7) * 4;
    d[0] = tv[i].x * ks; d[1] = tv[i].y * ks; d[2] = tv[i].z * ks; d[3] = tv[i].w * ks;
  }
  WAVE_LDS_SYNC();
  const int c = lane & 7;
#pragma unroll
  for (int j = 0; j < 4; ++j) {
    const int n = (lane >> 3) + 8 * j; const LAS float* s = scr + (8 * c) * 33 + n;
    uint4 o; o.x = pk2(s[0], s[33]); o.y = pk2(s[66], s[99]); o.z = pk2(s[132], s[165]); o.w = pk2(s[198], s[231]);
    *(uint4*)(dst + (size_t)map_col(mode, n0 + n) * ldd + k0 + 8 * c) = o;
  }
  WAVE_LDS_SYNC();
}
__device__ __forceinline__ void transpose_item8(const float* W, int K, int N, unsigned char* dst, int ldd, int mode, float scale, int item, LAS float* scr, int lane) {
  const int nblk = N >> 5, kb = item / nblk, nb = item - kb * nblk, k0 = kb * 64, n0 = nb * 32;
  float4 tv[8];
#pragma unroll
  for (int i = 0; i < 8; ++i) tv[i] = *(const float4*)(W + (size_t)(k0 + 8 * i + (lane >> 3)) * N + n0 + (lane & 7) * 4);
#pragma unroll
  for (int i = 0; i < 8; ++i) {
    LAS float* d = scr + (8 * i + (lane >> 3)) * 33 + (lane & 7) * 4;
    d[0] = tv[i].x * scale; d[1] = tv[i].y * scale; d[2] = tv[i].z * scale; d[3] = tv[i].w * scale;
  }
  WAVE_LDS_SYNC();
  const int c = lane & 7;
#pragma unroll
  for (int j = 0; j < 4; ++j) {
    const int n = (lane >> 3) + 8 * j; const LAS float* s = scr + (8 * c) * 33 + n;
    uint2 o;
    o.x = pack4_fp8c((f32x4){s[0], s[33], s[66], s[99]}); o.y = pack4_fp8c((f32x4){s[132], s[165], s[198], s[231]});
    *(uint2*)(dst + (size_t)map_col(mode, n0 + n) * ldd + k0 + 8 * c) = o;
  }
  WAVE_LDS_SYNC();
}
__device__ __forceinline__ void router_item(const float* W, bf16_t* dst, int item, LAS float* scr, int lane) {
  const int kb = item >> 1, nb = item & 1, k0 = kb * 64, n0 = nb * 32;
#pragma unroll 8
  for (int i = 0; i < 32; ++i) { const int kk = 2 * i + (lane >> 5); scr[kk * 33 + (lane & 31)] = W[(size_t)(k0 + kk) * 64 + n0 + (lane & 31)]; }
  WAVE_LDS_SYNC();
  const int c = lane & 7;
#pragma unroll
  for (int j = 0; j < 4; ++j) {
    const int n = (lane >> 3) + 8 * j; const LAS float* s = scr + (8 * c) * 33 + n;
    float v[8]; unsigned hb[4], lb[4];
#pragma unroll
    for (int q = 0; q < 8; ++q) v[q] = s[q * 33];
#pragma unroll
    for (int q = 0; q < 4; ++q) { hb[q] = pk2(v[2 * q], v[2 * q + 1]); lb[q] = pk2(v[2 * q] - bflo(hb[q]), v[2 * q + 1] - bfhi(hb[q])); }
    const int e = n0 + n;
    bf16_t* dh = dst + (size_t)((e >> 4) * 32 + (e & 15)) * 2048 + k0 + 8 * c;
    *(uint4*)(dh) = make_uint4(hb[0], hb[1], hb[2], hb[3]);
    *(uint4*)(dh + 1024) = make_uint4(hb[0], hb[1], hb[2], hb[3]);
    *(uint4*)(dh + 16 * 2048) = make_uint4(lb[0], lb[1], lb[2], lb[3]);
    *(uint4*)(dh + 16 * 2048 + 1024) = make_uint4(lb[0], lb[1], lb[2], lb[3]);
  }
  WAVE_LDS_SYNC();
}
__device__ __forceinline__ void expert_item(const Params& p, int L, int item, LAS float* scr, int lane) {
  const int e = item / 384, r = item - e * 384;
  const size_t eo = (size_t)(L * NE + e);
  unsigned char* gu = p.ws + WS_WEGU + (size_t)e * 512 * 1024;
  unsigned char* dn = p.ws + WS_WED + (size_t)e * 1024 * 256;
  if (r < 128) transpose_item8(p.in[I_EG] + eo * 1024 * 256, 1024, 256, gu, 1024, M_GATE, F8_SW1, r, scr, lane);
  else if (r < 256) transpose_item8(p.in[I_EU] + eo * 1024 * 256, 1024, 256, gu, 1024, M_UP, F8_SW1, r - 128, scr, lane);
  else transpose_item8(p.in[I_ED] + eo * 256 * 1024, 256, 1024, dn, 256, M_ID, F8_SW2, r - 256, scr, lane);
}

__device__ __forceinline__ void phase0(const Params& p, lptr lds, int vb, int nblocks) {
  const int tid = threadIdx.x, lane = tid & 63, wave = tid >> 6;
  unsigned char* ws = p.ws;
  if (vb == 0) {
    if (tid < 128) ((int*)(ws + WS_CNT))[tid] = 0;
  }
  if (vb == 2 || nblocks == 1) {
    for (int i = tid; i < 3 * 512; i += NTHREADS) { const float2 v = *(const float2*)(p.in[I_ODCW] + 2 * i); ((unsigned*)(ws + WS_CW1))[i] = pk2(v.x, v.y); }
  }
  if (vb == 1 || nblocks == 1) {
    for (int t = tid; t < 512; t += NTHREADS) {
      const int pos = t >> 3, j = t & 7;
      const float inv = 1.0f / powf(10000.0f, (float)(2 * j) / 16.0f);
      const float ang = (float)pos * inv;
      ((float2*)(ws + WS_ROPE))[t] = make_float2(cosf(ang), sinf(ang));
    }
  }
  {
    LAS float* sc = (LAS float*)lds;
    LAS float* red = (LAS float*)(lds + 36864);
    bool have = false;
    for (int it = vb; it < 384; it += nblocks) {
      if (!have) {
        float cv[18];
#pragma unroll
        for (int q = 0; q < 18; ++q) { const int i = tid + q * NTHREADS, r = i >> 10, k = i & 1023; cv[q] = (r < 8) ? p.in[I_C][r * 1024 + k] : p.in[I_CCTX][k]; }
#pragma unroll
        for (int q = 0; q < 18; ++q) sc[tid + q * NTHREADS] = cv[q] / (1.0f + __expf(-cv[q]));
        have = true;
      }
      __syncthreads();
      const int L = it / 192, n0 = (it - L * 192) * 32;
      const int col = n0 + (tid & 31), kp = tid >> 5;
      const float* w = p.in[I_ADAW] + (size_t)L * 1024 * 6144 + (size_t)(kp * 64) * 6144 + col;
      float a[9];
#pragma unroll
      for (int r = 0; r < 9; ++r) a[r] = 0.f;
      float wv[64];
#pragma unroll
      for (int k = 0; k < 64; ++k) wv[k] = w[(size_t)k * 6144];
#pragma unroll
      for (int k = 0; k < 64; ++k) {
#pragma unroll
        for (int r = 0; r < 9; ++r) a[r] += sc[r * 1024 + kp * 64 + k] * wv[k];
      }
#pragma unroll
      for (int r = 0; r < 9; ++r) red[(kp * 9 + r) * 32 + (tid & 31)] = a[r];
      __syncthreads();
      for (int o = tid; o < 288; o += NTHREADS) {
        const int r = o >> 5, cc = o & 31;
        float s = 0.f;
#pragma unroll
        for (int q = 0; q < 16; ++q) s += red[(q * 9 + r) * 32 + cc];
        ((float*)(ws + WS_MOD))[(size_t)(L * 9 + r) * 6144 + n0 + cc] = s + p.in[I_ADAB][L * 6144 + n0 + cc];
      }
    }
    __syncthreads();
  }
  LAS float* scr = (LAS float*)(lds + wave * 8448);
  const int gw = (nblocks - 1 - vb) * NWAVES + wave, NGW = nblocks * NWAVES;
  constexpr int J0 = 720, J1 = 96, J2 = 64, J3 = 512, J4 = 1536, J5 = 512, JS = 384, JR = 32, JE = NE * 384;
  constexpr int NIT = J0 + J1 + J2 + J3 + J4 + J5 + 2 * JS + 2 * JR;
  for (int it0 = gw; it0 < NIT; it0 += NGW) {
    int it = it0;
    if (it < J0) { transpose_item(p.in[I_EVWIN], 1024, 1440, (bf16_t*)(ws + WS_WIN0), 1024, M_WIN0, nullptr, it, scr, lane); continue; } it -= J0;
    if (it < J1) { transpose_item(p.in[I_WUQ], 256, 768, (bf16_t*)(ws + WS_WUQ), 256, M_WUQ, p.in[I_QNW], it, scr, lane); continue; } it -= J1;
    if (it < J2) { transpose_item(p.in[I_WUKV], 128, 1024, (bf16_t*)(ws + WS_WUKV), 128, M_WUKV, p.in[I_KVNW], it, scr, lane); continue; } it -= J2;
    if (it < J3) { transpose_item(p.in[I_EVWOUT], 1024, 1024, (bf16_t*)(ws + WS_WOUT0), 1024, M_ID, nullptr, it, scr, lane); continue; } it -= J3;
    if (it < J4) { transpose_item8(p.in[I_ODWIN], 1024, 3072, ws + WS_WIN1, 1024, M_WIN1, F8_SW1, it, scr, lane); continue; } it -= J4;
    if (it < J5) { transpose_item(p.in[I_ODWOUT], 1024, 1024, (bf16_t*)(ws + WS_WOUT1), 1024, M_ID, nullptr, it, scr, lane); continue; } it -= J5;
    if (it < 2 * JS) {
      const int L = it / JS, r = it - L * JS;
      unsigned char* gu = ws + WS_WSGU + (size_t)L * 512 * 1024; unsigned char* dn = ws + WS_WSD + (size_t)L * 1024 * 256;
      if (r < 128) transpose_item8(p.in[I_SG] + (size_t)L * 1024 * 256, 1024, 256, gu, 1024, M_GATE, F8_SW1, r, scr, lane);
      else if (r < 256) transpose_item8(p.in[I_SU] + (size_t)L * 1024 * 256, 1024, 256, gu, 1024, M_UP, F8_SW1, r - 128, scr, lane);
      else transpose_item8(p.in[I_SD] + (size_t)L * 256 * 1024, 256, 1024, dn, 256, M_ID, F8_SW2, r - 256, scr, lane);
      continue;
    }
    it -= 2 * JS;
    if (it < 2 * JR) { const int L = it / JR, r = it - L * JR; router_item(p.in[I_RW] + (size_t)L * 1024 * 64, (bf16_t*)(ws + WS_WR) + (size_t)L * 128 * 2048, r, scr, lane); continue; }
  }
}

__device__ __forceinline__ void norm_mod_row(const float4 (&v)[4], const float* nw, const float* sc, const float* sh, bf16_t* dhi, bf16_t* dlo, int lane, unsigned char* d8 = nullptr) {
  float ss = 0.f;
#pragma unroll
  for (int j = 0; j < 4; ++j) ss += (v[j].x * v[j].x + v[j].y * v[j].y) + (v[j].z * v[j].z + v[j].w * v[j].w);
  ss = wave_sum(ss);
  const float rstd = 1.0f / sqrtf(ss * (1.0f / 1024.0f) + EPS);
#pragma unroll
  for (int j = 0; j < 4; ++j) {
    const int c = lane + 64 * j;
    const float4 w = ((const float4*)nw)[c], s = ((const float4*)sc)[c], h = ((const float4*)sh)[c];
    const float y0 = v[j].x * rstd * w.x * (1.f + s.x) + h.x, y1 = v[j].y * rstd * w.y * (1.f + s.y) + h.y;
    const float y2 = v[j].z * rstd * w.z * (1.f + s.z) + h.z, y3 = v[j].w * rstd * w.w * (1.f + s.w) + h.w;
    uint2 hi; hi.x = pk2(y0, y1); hi.y = pk2(y2, y3);
    if (dhi) ((uint2*)dhi)[c] = hi;
    if (d8) ((unsigned*)d8)[c] = pack4_fp8c((f32x4){y0, y1, y2, y3} * F8_SA);
    if (dlo) { uint2 lo; lo.x = pk2(y0 - bflo(hi.x), y1 - bfhi(hi.x)); lo.y = pk2(y2 - bflo(hi.y), y3 - bfhi(hi.y)); ((uint2*)dlo)[c] = lo; }
  }
}

__device__ __forceinline__ void a0_panel(const Params& p, int pan) {
  const int lane = threadIdx.x & 63, wave = threadIdx.x >> 6;
  const float* mod = opq((const float*)(p.ws + WS_MOD)); const float* nmix = opq(p.in[I_NMIX]);
  bf16_t* AF = (bf16_t*)(p.ws + WS_AF);
#pragma unroll 1
  for (int i0 = 0; i0 < 16; i0 += 4) {
    float4 v[4][4];
#pragma unroll
    for (int u = 0; u < 4; ++u) {
      const int r = pan * 128 + wave + 8 * (i0 + u);
      const float* src = (r < T) ? p.in[I_X] + (size_t)r * D : p.in[I_CTX] + (size_t)(r - T) * D;
#pragma unroll
      for (int j = 0; j < 4; ++j) v[u][j] = ((const float4*)src)[lane + 64 * j];
    }
#pragma unroll
    for (int u = 0; u < 4; ++u) {
      const int r = pan * 128 + wave + 8 * (i0 + u);
      const int b = (r < T) ? (r >> 12) : 8;
      norm_mod_row(v[u], nmix, mod + (size_t)b * 6144 + 1024, mod + (size_t)b * 6144, AF + (size_t)r * D, nullptr, lane);
    }
  }
}

__device__ __forceinline__ void ffnprep_panel(const Params& p, int L, int mt) {
  const int lane = threadIdx.x & 63, wave = threadIdx.x >> 6;
  const float* mod = opq((const float*)(p.ws + WS_MOD) + (size_t)L * 9 * 6144); const float* nffn = opq(p.in[I_NFFN] + L * D);
  bf16_t* AF = (bf16_t*)(p.ws + WS_AF); bf16_t* FLO = (bf16_t*)(p.ws + B_FLO);
  asm volatile("s_waitcnt vmcnt(0)" ::: "memory");
  __syncthreads();
#pragma unroll 1
  for (int i0 = 0; i0 < 16; i0 += 4) {
    float4 v[4][4];
#pragma unroll
    for (int u = 0; u < 4; ++u) {
      const int r = mt * 128 + wave + 8 * (i0 + u);
#pragma unroll
      for (int j = 0; j < 4; ++j) { const f32x4 t = unpack4(((const uint2*)HROW(r))[lane + 64 * j]); v[u][j] = make_float4(t[0], t[1], t[2], t[3]); }
    }
#pragma unroll
    for (int u = 0; u < 4; ++u) {
      const int r = mt * 128 + wave + 8 * (i0 + u), b = r >> 12;
      norm_mod_row(v[u], nffn, mod + (size_t)b * 6144 + 4096, mod + (size_t)b * 6144 + 3072, AF + (size_t)r * D, FLO + (size_t)r * D, lane, p.ws + WS_AF8 + (size_t)r * D);
    }
  }
}

__device__ __forceinline__ void inproj0_panel(const Params& p, lptr lds, int pan) {
  const int tid_ = opaque((int)threadIdx.x);
  const bf16_t* AF = (const bf16_t*)(p.ws + WS_AF); const bf16_t* W = (const bf16_t*)(p.ws + WS_WIN0);
  bf16_t* GLU = (bf16_t*)(p.ws + B_GLU); bf16_t* CQ = (bf16_t*)(p.ws + B_CQ); bf16_t* CKV = (bf16_t*)(p.ws + B_CKV); bf16_t* KR = (bf16_t*)(p.ws + B_KR);
  const int mt = pan, nj = (pan < 256) ? 6 : 1, nt0 = (pan < 256) ? 0 : 5;
  StrideLoader al, bl;
  al.p0 = AF + (size_t)(mt * 128 + ROW8(0)) * D + CO8; al.ld64 = 64 * D;
  bl.p0 = W + (size_t)(nt0 * 256 + ROW8(0)) * D + CO8; bl.ld64 = 64 * D;
  int st = 0;
  gemm_pre_at<4>(al, bl, st, lds);
#pragma unroll 1
  for (int j = 0; j < nj; ++j) {
    const int nt = nt0 + j;
    f32x4 acc[4][4]; zero_acc(acc);
    StrideLoader bln = bl; bln.p0 += (size_t)256 * D;
    gemm_chain<true, 4>(acc, al, bl, 16, lds, st, j + 1 < nj, al, bln);
    bl = bln;
    const int te = opaque(tid_), le = te & 63, we = te >> 6, wm = we >> 2, wn = we & 3, q4 = le >> 4;
    const size_t row0 = (size_t)mt * 128 + wm * 64 + (le & 15);
    if (nt < 4) {
#pragma unroll
      for (int mi = 0; mi < 4; ++mi) {
        f32x4 v[2];
#pragma unroll
        for (int j2 = 0; j2 < 2; ++j2) {
          const f32x4 a = acc[mi][2 * j2], g = acc[mi][2 * j2 + 1];
#pragma unroll
          for (int r = 0; r < 4; ++r) v[j2][r] = a[r] * sigmoid_fast(g[r]);
        }
        store_row2(GLU + (row0 + mi * 16) * 512 + nt * 128 + wn * 32, v[0], v[1], q4);
      }
    } else if (nt == 4) {
#pragma unroll
      for (int mi = 0; mi < 4; ++mi) store_row4(CQ + (row0 + mi * 16) * 256 + wn * 64, acc[mi][0], acc[mi][1], acc[mi][2], acc[mi][3], q4);
    } else if (wn < 2) {
#pragma unroll
      for (int mi = 0; mi < 4; ++mi) store_row4(CKV + (row0 + mi * 16) * 128 + wn * 64, acc[mi][0], acc[mi][1], acc[mi][2], acc[mi][3], q4);
    } else if (wn == 2) {
#pragma unroll
      for (int mi = 0; mi < 4; ++mi) store_row2(KR + (row0 + mi * 16) * 32, acc[mi][0], acc[mi][1], q4);
    }
  }
  __syncthreads();
}

constexpr float QSCALE = 0.14724445f;

__device__ __forceinline__ void rstd_rows(const bf16_t* A, int lda, int klen, float extra, lptr lds) {
  const int tid = threadIdx.x, r = tid >> 2, qd = tid & 3;
  const bf16_t* ptr = A + (size_t)r * lda + qd * (klen >> 2);
  float ss = 0.f;
  for (int c = 0; c < (klen >> 5); ++c) {
    const uint4 u = *(const uint4*)(ptr + c * 8);
    const unsigned w[4] = {u.x, u.y, u.z, u.w};
#pragma unroll
    for (int q = 0; q < 4; ++q) { const float a = bflo(w[q]), b = bfhi(w[q]); ss += a * a + b * b; }
  }
  ss += __shfl_xor(ss, 1); ss += __shfl_xor(ss, 2);
  __syncthreads();
  if (qd == 0) ((LAS float*)(lds + XLDS))[r] = extra / sqrtf(ss / (float)klen + EPS);
}

__device__ __forceinline__ void upproj_panel(const Params& p, lptr lds, int pan) {
  const int tid_ = opaque((int)threadIdx.x);
  const int tid = tid_, lane = tid & 63, wave = tid >> 6, wm = wave >> 2, wn = wave & 3, q4 = lane >> 4;
  unsigned char* ws = p.ws;
  const float2* rope = opq((const float2*)(ws + WS_ROPE));
  const LAS float* rs = (const LAS float*)(lds + XLDS);
  bf16_t* Q = (bf16_t*)(ws + B_Q); bf16_t* KB = (bf16_t*)(ws + B_K); bf16_t* VT = (bf16_t*)(ws + B_VT);
  const int mt = pan;
  if (pan < 256) {
    const bf16_t* CQ = (const bf16_t*)(ws + B_CQ); const bf16_t* W = (const bf16_t*)(ws + WS_WUQ);
    rstd_rows(CQ + (size_t)mt * 128 * 256, 256, 256, QSCALE, lds);
#pragma unroll 1
    for (int nt = 0; nt < 3; ++nt) {
      StrideLoader al, bl;
      al.p0 = CQ + (size_t)(mt * 128 + ROW8(0)) * 256 + CO8; al.ld64 = 64 * 256;
      bl.p0 = W + (size_t)(nt * 256 + ROW8(0)) * 256 + CO8; bl.ld64 = 64 * 256;
      f32x4 acc[4][4]; zero_acc(acc);
      gemm_core<true, 4>(acc, al, bl, 4, lds);
      ep_banded<256>(lds, PutPlain<4>{acc}, [&](int rl, int col, f32x4 v) {
        const int row = mt * 128 + rl, b = row >> 12, tokb = row & 4095;
        const int fc = nt * 256 + (col & ~15), head = fc / 96, d0 = fc - head * 96, ci = col & 15;
        v = v * rs[rl];
        if (d0 >= 64) {
          const int pos = (d0 >= 80) ? (tokb & 63) : (tokb >> 6);
          const float2 c0 = rope[pos * 8 + (ci >> 1)], c1 = rope[pos * 8 + (ci >> 1) + 1];
          f32x4 o;
          o[0] = v[0] * c0.x - v[1] * c0.y; o[1] = v[1] * c0.x + v[0] * c0.y;
          o[2] = v[2] * c1.x - v[3] * c1.y; o[3] = v[3] * c1.x + v[2] * c1.y;
          v = o;
        }
        *(uint2*)(Q + ((size_t)(b * NH + head) * SEQ + tokb) * DQK + d0 + ci) = pack4(v);
      });
    }
  }
  {
    const bf16_t* CKV = (const bf16_t*)(ws + B_CKV); const bf16_t* W = (const bf16_t*)(ws + WS_WUKV);
    rstd_rows(CKV + (size_t)mt * 128 * 128, 128, 128, 1.0f, lds);
#pragma unroll 1
    for (int nt = 0; nt < 4; ++nt) {
      StrideLoader al, bl;
      al.p0 = CKV + (size_t)(mt * 128 + ROW8(0)) * 128 + CO8; al.ld64 = 64 * 128;
      bl.p0 = W + (size_t)(nt * 256 + ROW8(0)) * 128 + CO8; bl.ld64 = 64 * 128;
      f32x4 acc[4][4]; zero_acc(acc);
      if (nt < 2) {
        gemm_core<true, 4>(acc, al, bl, 2, lds);
        ep_banded<256>(lds, PutPlain<4>{acc}, [&](int rl, int colt, f32x4 v) {
          const int r = mt * 128 + rl;
          int b, key; if (r < T) { b = r >> 12; key = CL + (r & 4095); } else { const int rc = r - T; b = rc >> 8; key = rc & 255; }
          const int col = nt * 256 + colt, h = col >> 6, d = col & 63;
          *(uint2*)(KB + ((size_t)(b * NH + h) * NKEY + key) * DQK + d) = pack4(v * rs[rl]);
        });
      } else {
        gemm_core<false, 4>(acc, al, bl, 2, lds);
#pragma unroll
        for (int mi = 0; mi < 4; ++mi)
#pragma unroll
          for (int nj = 0; nj < 4; ++nj)
            *(LAS f32x4*)(lds + (wn * 64 + nj * 16 + (lane & 15)) * EPT_PITCH + (wm * 64 + mi * 16 + q4 * 4) * 4) = acc[mi][nj];
        __syncthreads();
#pragma unroll 4
        for (int idx = tid; idx < 256 * 32; idx += NTHREADS) {
          const int cr = idx >> 5, t4 = (idx & 31) * 4;
          f32x4 v = *(const LAS f32x4*)(lds + cr * EPT_PITCH + t4 * 4);
          v[0] *= rs[t4]; v[1] *= rs[t4 + 1]; v[2] *= rs[t4 + 2]; v[3] *= rs[t4 + 3];
          const int r = mt * 128 + t4;
          int b, key; if (r < T) { b = r >> 12; key = CL + (r & 4095); } else { const int rc = r - T; b = rc >> 8; key = rc & 255; }
          const int n = (nt - 2) * 256 + cr, h = n >> 6, dv = n & 63;
          *(uint2*)(VT + ((size_t)(b * NH + h) * DV + dv) * NKEY + key) = pack4(v);
        }
        __syncthreads();
      }
    }
  }
  {
    const bf16_t* KR = (const bf16_t*)(ws + B_KR);
#pragma unroll
    for (int i = 0; i < 2; ++i) {
      const int idx = pan * 1024 + tid + NTHREADS * i;
      const int r = idx >> 3, pc = idx & 7;
      const uint2 u = *(const uint2*)(KR + (size_t)r * 32 + pc * 4);
      float v0 = bflo(u.x), v1 = bfhi(u.x), v2 = bflo(u.y), v3 = bfhi(u.y);
      int b, key;
      if (r < T) {
        b = r >> 12; const int tokb = r & 4095; key = CL + tokb;
        const int pos = (pc >= 4) ? (tokb & 63) : (tokb >> 6), jb = (pc & 3) * 2;
        const float2 c0 = rope[pos * 8 + jb], c1 = rope[pos * 8 + jb + 1];
        const float o0 = v0 * c0.x - v1 * c0.y, o1 = v1 * c0.x + v0 * c0.y, o2 = v2 * c1.x - v3 * c1.y, o3 = v3 * c1.x + v2 * c1.y;
        v0 = o0; v1 = o1; v2 = o2; v3 = o3;
      } else { const int rc = r - T; b = rc >> 8; key = rc & 255; }
      uint2 o; o.x = pk2(v0, v1); o.y = pk2(v2, v3);
#pragma unroll
      for (int h = 0; h < NH; ++h) *(uint2*)(KB + ((size_t)(b * NH + h) * NKEY + key) * DQK + 64 + pc * 4) = o;
    }
  }
}

__device__ __forceinline__ void conv_units(const Params& p, lptr lds, int vb, int nblocks) {
  const int tid = threadIdx.x, lane = tid & 63, wave = tid >> 6;
  unsigned char* ws = p.ws;
  {
    const bf16_t* GLU = (const bf16_t*)(ws + B_GLU); bf16_t* OCAT = (bf16_t*)(ws + B_OCAT);
    const float* cw = p.in[I_EVCW]; const float* cb = p.in[I_EVCB]; const float* lw = p.in[I_EVLNW]; const float* lb = p.in[I_EVLNB];
    const int cp = tid & 255, th = tid >> 8;
    const lptr outl = lds + 65536;
    for (int u = vb; u < NB * 128; u += nblocks) {
      const int b = u >> 7, t0 = (u & 127) * 32;
      __syncthreads();
      for (int c = tid; c < 62 * 64; c += NTHREADS) {
        const int ti = c >> 6, ch = c & 63, tok = t0 - 15 + ti;
        uint4 v = make_uint4(0, 0, 0, 0);
        if (tok >= 0 && tok < SEQ) v = *(const uint4*)(GLU + ((size_t)(b * SEQ + tok)) * 512 + ch * 8);
        lds_w16(lds + ti * 1024 + ch * 16, v);
      }
      __syncthreads();
      float a0[16], a1[16];
#pragma unroll
      for (int k = 0; k < 16; ++k) { a0[k] = 0.f; a1[k] = 0.f; }
      for (int tap = 0; tap < 31; ++tap) {
        const float2 w = *(const float2*)(cw + tap * 512 + 2 * cp);
#pragma unroll
        for (int k = 0; k < 16; ++k) {
          const unsigned x = *(const LAS unsigned*)(lds + (th * 16 + k + tap) * 1024 + cp * 4);
          a0[k] += w.x * bflo(x); a1[k] += w.y * bfhi(x);
        }
      }
      const float2 bias = *(const float2*)(cb + 2 * cp);
#pragma unroll
      for (int k = 0; k < 16; ++k) *(LAS f32x2*)(outl + ((th * 16 + k) * 512 + 2 * cp) * 4) = (f32x2){a0[k] + bias.x, a1[k] + bias.y};
      __syncthreads();
#pragma unroll 1
      for (int q = 0; q < 4; ++q) {
        const int tk = wave * 4 + q;
        const f32x4 x0 = *(const LAS f32x4*)(outl + (tk * 512 + lane * 8) * 4), x1 = *(const LAS f32x4*)(outl + (tk * 512 + lane * 8 + 4) * 4);
        float s = (x0.x + x0.y) + (x0.z + x0.w) + (x1.x + x1.y) + (x1.z + x1.w);
        s = wave_sum(s);
        const float mean = s * (1.0f / 512.0f);
        const float d[8] = {x0.x - mean, x0.y - mean, x0.z - mean, x0.w - mean, x1.x - mean, x1.y - mean, x1.z - mean, x1.w - mean};
        float ss = 0.f;
#pragma unroll
        for (int e = 0; e < 8; ++e) ss += d[e] * d[e];
        ss = wave_sum(ss);
        const float rstd = 1.0f / sqrtf(ss * (1.0f / 512.0f) + EPS);
        const float4 w0 = *(const float4*)(lw + lane * 8), w1 = *(const float4*)(lw + lane * 8 + 4), b0 = *(const float4*)(lb + lane * 8), b1 = *(const float4*)(lb + lane * 8 + 4);
        const float wv[8] = {w0.x, w0.y, w0.z, w0.w, w1.x, w1.y, w1.z, w1.w}, bv[8] = {b0.x, b0.y, b0.z, b0.w, b1.x, b1.y, b1.z, b1.w};
        float y[8];
#pragma unroll
        for (int e = 0; e < 8; ++e) { const float z = d[e] * rstd * wv[e] + bv[e]; y[e] = z * sigmoid_fast(z); }
        uint4 o; o.x = pk2(y[0], y[1]); o.y = pk2(y[2], y[3]); o.z = pk2(y[4], y[5]); o.w = pk2(y[6], y[7]);
        *(uint4*)(OCAT + ((size_t)(b * SEQ + t0 + tk)) * D + lane * 8) = o;
      }
    }
    __syncthreads();
  }
}

__device__ __forceinline__ void phase4(const Params& p, lptr lds, int vb, int nblocks) {
  const int tid = threadIdx.x, lane = tid & 63, wave = __builtin_amdgcn_readfirstlane(tid >> 6), q4 = lane >> 4, li = lane & 15;
  const bf16_t* Q = (const bf16_t*)(p.ws + B_Q); const bf16_t* KB = (const bf16_t*)(p.ws + B_K); const bf16_t* VT = (const bf16_t*)(p.ws + B_VT);
  bf16_t* OCAT = (bf16_t*)(p.ws + B_OCAT);
  constexpr int STG = 20480, NKT = NKEY / 64, NQF = 4, QW = 16 * NQF, QU = 8 * QW;
  int koff[4], voff[2];
#pragma unroll
  for (int f = 0; f < 4; ++f) {
    const int row = 32 * (f >> 1) + 8 * (li >> 2) + 4 * (f & 1) + (li & 3);
    koff[f] = row * 192 + ((q4 ^ ((row >> 2) & 3)) << 4);
  }
#pragma unroll
  for (int g = 0; g < 2; ++g) voff[g] = 12288 + li * 128 + ((((4 * g + q4) ^ (lane & 7))) << 4);
  int soff[3]; bool isk[3];
#pragma unroll
  for (int i = 0; i < 3; ++i) {
    const int pi = wave + 8 * i;
    if (pi < 12) { const int P = pi * 1024 + lane * 16, row = P / 192, rem = P - row * 192, ks = rem >> 6, pq = (rem & 63) >> 4; soff[i] = row * DQK + ks * 32 + ((pq ^ ((row >> 2) & 3)) << 3); isk[i] = true; }
    else { const int P = (pi - 12) * 1024 + lane * 16, dv = P >> 7, pc = (P & 127) >> 4; soff[i] = dv * NKEY + ((pc ^ (dv & 7)) << 3); isk[i] = false; }
  }
  const bool three = wave < 4;
  constexpr int UPB = SEQ / QU;
  for (int unit = vb; unit < NB * NH * UPB; unit += nblocks) {
    const int qb = unit % UPB, bh = unit / UPB;
    const bf16_t* Qp = Q + ((size_t)bh * SEQ + qb * QU + wave * QW) * DQK;
    const bf16_t* Kp = KB + (size_t)bh * NKEY * DQK;
    const bf16_t* Vp = VT + (size_t)bh * DV * NKEY;
    bf16x8 qf[NQF][3];
#pragma unroll
    for (int f2 = 0; f2 < NQF; ++f2)
#pragma unroll
      for (int ks = 0; ks < 3; ++ks) qf[f2][ks] = *(const bf16x8*)(Qp + (f2 * 16 + li) * DQK + ks * 32 + q4 * 8);
    WAIT_VM(0);
#define ATT_ISSUE(kt_, stage_) do { \
      _Pragma("unroll") for (int i_ = 0; i_ < 3; ++i_) { if (i_ < 2 || three) { \
        const bf16_t* g_ = isk[i_] ? Kp + (size_t)(kt_) * 64 * DQK + soff[i_] : Vp + (kt_) * 64 + soff[i_]; \
        glds16(g_, lds + (stage_) * STG + (wave + 8 * i_) * 1024); } } } while (0)
#pragma unroll
    for (int t = 0; t < 3; ++t) ATT_ISSUE(t, t);
    f32x4 o[4][NQF];
    float mrun[NQF], lrun[NQF];
#pragma unroll
    for (int f2 = 0; f2 < NQF; ++f2) { mrun[f2] = -1000.f; lrun[f2] = 0.f;
#pragma unroll
      for (int a = 0; a < 4; ++a) o[a][f2] = (f32x4){0.f, 0.f, 0.f, 0.f}; }
    int st = 0;
    for (int kt = 0; kt < NKT; ++kt) {
      if (kt + 2 < NKT) { if (three) WAIT_VM(6); else WAIT_VM(4); }
      else if (kt + 1 < NKT) { if (three) WAIT_VM(3); else WAIT_VM(2); }
      else WAIT_VM(0);
      asm volatile("s_waitcnt lgkmcnt(0)" ::: "memory");
      __builtin_amdgcn_s_barrier();
      asm volatile("" ::: "memory");
      if (kt + 3 < NKT) ATT_ISSUE(kt + 3, (st + 3) & 3);
      const lptr cur = lds + st * STG;
#pragma unroll
      for (int hh = 0; hh < NQF / 2; ++hh) {
        f32x4 s[2][4];
#pragma unroll
        for (int f2 = 0; f2 < 2; ++f2)
#pragma unroll
          for (int f = 0; f < 4; ++f) { const float nm = -mrun[2 * hh + f2]; s[f2][f] = (f32x4){nm, nm, nm, nm}; }
#pragma unroll
        for (int ks = 0; ks < 3; ++ks)
#pragma unroll
          for (int f = 0; f < 4; ++f) {
            const bf16x8 kf = lds_r16(cur + koff[f] + ks * 64);
            s[0][f] = __builtin_amdgcn_mfma_f32_16x16x32_bf16(kf, qf[2 * hh][ks], s[0][f], 0, 0, 0);
            s[1][f] = __builtin_amdgcn_mfma_f32_16x16x32_bf16(kf, qf[2 * hh + 1][ks], s[1][f], 0, 0, 0);
          }
        bf16x8 pf[2][2];
        float mx[2];
#pragma unroll
        for (int f2 = 0; f2 < 2; ++f2) {
          float m_ = s[f2][0][0];
#pragma unroll
          for (int f = 0; f < 4; ++f)
#pragma unroll
            for (int r = 0; r < 4; ++r) m_ = fmaxf(m_, s[f2][f][r]);
          mx[f2] = m_;
        }
        if (!__all(fmaxf(mx[0], mx[1]) <= 6.0f)) {
#pragma unroll
          for (int f2 = 0; f2 < 2; ++f2) {
            const int q = 2 * hh + f2;
            float m_ = mx[f2];
            m_ = fmaxf(m_, __shfl_xor(m_, 16)); m_ = fmaxf(m_, __shfl_xor(m_, 32));
            const float d = fmaxf(m_, 0.f);
            const float alpha = __builtin_amdgcn_exp2f(-d);
            mrun[q] += d; lrun[q] *= alpha;
#pragma unroll
            for (int a = 0; a < 4; ++a) o[a][q] = o[a][q] * alpha;
#pragma unroll
            for (int f = 0; f < 4; ++f) s[f2][f] = s[f2][f] - d;
          }
        }
#pragma unroll
        for (int f2 = 0; f2 < 2; ++f2) {
          const int q = 2 * hh + f2;
          float rsum = 0.f;
#pragma unroll
          for (int f = 0; f < 4; ++f)
#pragma unroll
            for (int r = 0; r < 4; ++r) { const float e = __builtin_amdgcn_exp2f(s[f2][f][r]); s[f2][f][r] = e; rsum += e; }
          lrun[q] += rsum;
#pragma unroll
          for (int g = 0; g < 2; ++g) {
            union { bf16x8 v; unsigned u[4]; } cv;
            cv.u[0] = pk2(s[f2][2 * g][0], s[f2][2 * g][1]); cv.u[1] = pk2(s[f2][2 * g][2], s[f2][2 * g][3]);
            cv.u[2] = pk2(s[f2][2 * g + 1][0], s[f2][2 * g + 1][1]); cv.u[3] = pk2(s[f2][2 * g + 1][2], s[f2][2 * g + 1][3]);
            pf[f2][g] = cv.v;
          }
        }
#pragma unroll
        for (int g = 0; g < 2; ++g)
#pragma unroll
          for (int a = 0; a < 4; ++a) {
            const bf16x8 vf = lds_r16(cur + voff[g] + a * 2048);
            o[a][2 * hh] = __builtin_amdgcn_mfma_f32_16x16x32_bf16(vf, pf[0][g], o[a][2 * hh], 0, 0, 0);
            o[a][2 * hh + 1] = __builtin_amdgcn_mfma_f32_16x16x32_bf16(vf, pf[1][g], o[a][2 * hh + 1], 0, 0, 0);
          }
        __builtin_amdgcn_sched_barrier(0);
      }
      st = (st + 1) & 3;
    }
    __syncthreads();
    const int b = bh >> 3, h = bh & 7;
#pragma unroll
    for (int f2 = 0; f2 < NQF; ++f2) {
      float lt = lrun[f2]; lt += __shfl_xor(lt, 16); lt += __shfl_xor(lt, 32);
      const float inv = 1.0f / lt;
      const size_t row = (size_t)b * SEQ + qb * QU + wave * QW + f2 * 16 + li;
      store_row4(OCAT + row * D + 512 + h * 64, o[0][f2] * inv, o[1][f2] * inv, o[2][f2] * inv, o[3][f2] * inv, q4);
    }
  }
#undef ATT_ISSUE
}

__device__ __forceinline__ void outproj_panel(const Params& p, int L, lptr lds, int mt) {
  const int tid_ = opaque((int)threadIdx.x);
  const bf16_t* A = (const bf16_t*)(p.ws + (L == 0 ? B_OCAT : B_S)); const bf16_t* W = (const bf16_t*)(p.ws + (L == 0 ? WS_WOUT0 : WS_WOUT1));
  const float* mod = (const float*)(p.ws + WS_MOD) + (size_t)L * 9 * 6144;
  StrideLoader al, bl;
  al.p0 = A + (size_t)(mt * 128 + ROW8(0)) * D + CO8; al.ld64 = 64 * D;
  bl.p0 = W + (size_t)ROW8(0) * D + CO8; bl.ld64 = 64 * D;
  int st = 0;
  gemm_pre_at<4>(al, bl, st, lds);
#pragma unroll 1
  for (int nt = 0; nt < 4; ++nt) {
    f32x4 acc[4][4]; zero_acc(acc);
    StrideLoader bln = bl; bln.p0 += (size_t)256 * D;
    gemm_chain<true, 4>(acc, al, bl, 16, lds, st, nt < 3, al, bln);
    bl = bln;
    const int te = opaque(tid_), le = te & 63, we = te >> 6, wm = we >> 2, wn = we & 3, q4 = le >> 4;
#pragma unroll
    for (int mi = 0; mi < 4; ++mi) {
      const int row = mt * 128 + wm * 64 + mi * 16 + (le & 15), b = (mt * 128) >> 12;
      bf16_t* hrow = HROW(row) + nt * 256 + wn * 64;
      f32x4 xv[4];
      if (L == 0) {
#pragma unroll
        for (int n4 = 0; n4 < 4; ++n4) xv[n4] = *(const f32x4*)(p.in[I_X] + (size_t)row * D + nt * 256 + wn * 64 + n4 * 16 + q4 * 4);
      } else {
        const u32x4 t0 = ((const u32x4*)(hrow + q4 * 16))[0], t1 = ((const u32x4*)(hrow + q4 * 16))[1];
        uint2 ha = make_uint2(t0[0], t0[1]), hb = make_uint2(t0[2], t0[3]), hc = make_uint2(t1[0], t1[1]), hd = make_uint2(t1[2], t1[3]);
        tr4x4(ha.x, hb.x, hc.x, hd.x); tr4x4(ha.y, hb.y, hc.y, hd.y);
        xv[0] = unpack4(ha); xv[1] = unpack4(hb); xv[2] = unpack4(hc); xv[3] = unpack4(hd);
      }
#pragma unroll
      for (int n4 = 0; n4 < 4; ++n4) {
        const f32x4 g1 = *(const f32x4*)(mod + (size_t)b * 6144 + 2048 + nt * 256 + wn * 64 + n4 * 16 + q4 * 4);
        xv[n4] = xv[n4] + g1 * acc[mi][n4];
      }
      store_row4(hrow, xv[0], xv[1], xv[2], xv[3], q4);
    }
  }
  __syncthreads();
}

__device__ __forceinline__ void expert_unit(const Params& p, int L, const bf16_t* Wgu, const bf16_t* Wd, const int* list, int nvalid, int m0, lptr lds, int dry = 0) {
  const int tid = opaque((int)threadIdx.x), tid_ = tid;
  const bf16_t* AF = (const bf16_t*)(p.ws + WS_AF8);
  unsigned char* ACT = p.ws + WS_ACT + (size_t)blockIdx.x * 128 * 256;
  LAS int* info = (LAS int*)(lds + XLDS + 512);
  LAS float* wrow = (LAS float*)(lds + XLDS);
  __syncthreads();
  if (tid < 128) {
    const int inf = list ? ((tid < nvalid) ? list[tid] : -1) : ((m0 + tid) * 8 + 7);
    info[tid] = inf;
    wrow[tid] = (inf >= 0 && (inf & 7) != 7) ? ((const float*)(p.ws + WS_WTS))[inf] : 1.0f;
  }
  __syncthreads();
  {
    RowLoader2 al; StrideLoader bl;
#pragma unroll
    for (int i = 0; i < 2; ++i) { const int inf = info[ROW8(i)]; al.p[i] = AF + (size_t)((inf >= 0) ? (inf >> 3) : 0) * 512 + CO8; }
    bl.p0 = Wgu + (size_t)ROW8(0) * 512 + CO8; bl.ld64 = 64 * 512;
    int st = 0;
    gemm_pre_at<4>(al, bl, st, lds);
#pragma unroll 1
    for (int nt = 0; nt < 2; ++nt) {
      f32x4 acc[4][4]; zero_acc(acc);
      StrideLoader bln = bl; bln.p0 += (size_t)256 * 512;
      gemm_chain8<4>(acc, al, bl, 8, lds, st, nt == 0, al, bln);
      bl = bln;
      {
        const int te = opaque(tid), le = te & 63, we = te >> 6, wm = we >> 2, wn = we & 3, q4 = le >> 4;
#pragma unroll
        for (int mi = 0; mi < 4; ++mi)
          {
            unsigned x[2];
#pragma unroll
            for (int j2 = 0; j2 < 2; ++j2) {
              const f32x4 g = acc[mi][2 * j2], u = acc[mi][2 * j2 + 1]; f32x4 v;
#pragma unroll
              for (int r = 0; r < 4; ++r) { const float gg = g[r] * F8_INV; v[r] = gg * sigmoid_fast(gg) * u[r] * (F8_INV * F8_SACT); }
              x[j2] = pack4_fp8c(v);
            }
            { auto r = __builtin_amdgcn_permlane16_swap(x[0], x[1], false, false); x[0] = r[0]; x[1] = r[1]; }
            *(uint2*)(ACT + (size_t)(wm * 64 + mi * 16 + (le & 15)) * 256 + nt * 128 + wn * 32 + (q4 & 1) * 16 + (q4 >> 1) * 8) = make_uint2(x[0], x[1]);
          }
      }
    }
  }
  asm volatile("s_waitcnt vmcnt(0)" ::: "memory");
  __syncthreads();
  const bool shared_u = (list == nullptr);
  unsigned char* CONTRIB = p.ws + B_CONTRIB; unsigned char* SHC = p.ws + B_SHC;
  {
    StrideLoader al, bl;
    al.p0 = (const bf16_t*)ACT + (size_t)ROW8(0) * 128 + CO8; al.ld64 = 64 * 128;
    bl.p0 = Wd + (size_t)ROW8(0) * 128 + CO8; bl.ld64 = 64 * 128;
    int st = 0;
    gemm_pre_at<4>(al, bl, st, lds);
#pragma unroll 1
    for (int nt = 0; nt < 4; ++nt) {
      f32x4 acc[4][4]; zero_acc(acc);
      StrideLoader bln = bl; bln.p0 += (size_t)256 * 128;
      gemm_chain8<4>(acc, al, bl, 2, lds, st, nt < 3, al, bln);
      bl = bln;
      {
        const int te = opaque(tid), le = te & 63, we = te >> 6, wm = we >> 2, wn = we & 3, q4 = le >> 4;
#pragma unroll
        for (int mi = 0; mi < 4; ++mi) {
          const int rl = wm * 64 + mi * 16 + (le & 15);
          const int inf = info[rl];
          const int tok = inf >> 3, k = inf & 7;
          const float w = wrow[rl] * F8_INV;
          {
            unsigned x0 = pack4_fp8c(acc[mi][0] * w), x1 = pack4_fp8c(acc[mi][1] * w), x2 = pack4_fp8c(acc[mi][2] * w), x3 = pack4_fp8c(acc[mi][3] * w);
            tr4x4(x0, x1, x2, x3);
            unsigned char* dstrow = shared_u ? SHC + (size_t)tok * D : CONTRIB + ((size_t)tok * 6 + k) * D;
            if (inf >= 0 && !dry) *(u32x4*)(dstrow + nt * 256 + wn * 64 + q4 * 16) = (u32x4){x0, x1, x2, x3};
          }
        }
      }
    }
  }
  __syncthreads();
}

__device__ __forceinline__ void router_gemm(f32x4 (&acc)[4][2], const bf16_t* ph, const bf16_t* pl, const bf16_t* pb, lptr lds) {
  constexpr int STG = 32768, B_OFF = 16384, NKT = 32;
  const int tid = opaque((int)threadIdx.x), lane = tid & 63, wave = __builtin_amdgcn_readfirstlane(tid >> 6), wm = wave >> 2, wn = wave & 3;
  int aoff[2], boff[2];
#pragma unroll
  for (int ks = 0; ks < 2; ++ks) {
    const int sw = (((ks * 4 + (lane >> 4)) ^ (lane & 7)) << 4);
    aoff[ks] = (wm * 64 + (lane & 15)) * 128 + sw;
    boff[ks] = B_OFF + (wn * 32 + (lane & 15)) * 128 + sw;
  }
  const int wbase = wave * 1024;
#define RG_ISSUE(t_) do { const int t__ = (t_); const lptr sb_ = lds + (t__ & 3) * STG + wbase; \
    const bf16_t* ap_ = ((t__ < 16) ? ph : pl) + (t__ & 15) * 64; const bf16_t* bp_ = pb + t__ * 64; \
    glds16(ap_, sb_); glds16(ap_ + (size_t)64 * D, sb_ + 8192); glds16(bp_, sb_ + B_OFF); glds16(bp_ + (size_t)64 * 2048, sb_ + B_OFF + 8192); } while (0)
  RG_ISSUE(0); RG_ISSUE(1); RG_ISSUE(2);
#pragma unroll 1
  for (int kt = 0; kt < NKT; ++kt) {
    if (kt + 2 < NKT) WAIT_VM(8); else if (kt + 1 < NKT) WAIT_VM(4); else WAIT_VM(0);
    asm volatile("s_waitcnt lgkmcnt(0)" ::: "memory");
    __builtin_amdgcn_s_barrier();
    asm volatile("" ::: "memory");
    const lptr base = lds + (kt & 3) * STG;
#pragma unroll
    for (int ks = 0; ks < 2; ++ks) {
      bf16x8 af[4], bfr[2];
#pragma unroll
      for (int i = 0; i < 4; ++i) af[i] = lds_r16(base + aoff[ks] + i * 2048);
#pragma unroll
      for (int j = 0; j < 2; ++j) bfr[j] = lds_r16(base + boff[ks] + j * 2048);
      if (ks == 1 && kt + 3 < NKT) RG_ISSUE(kt + 3);
#pragma unroll
      for (int i = 0; i < 4; ++i)
#pragma unroll
        for (int j = 0; j < 2; ++j) acc[i][j] = __builtin_amdgcn_mfma_f32_16x16x32_bf16(bfr[j], af[i], acc[i][j], 0, 0, 0);
    }
  }
#undef RG_ISSUE
  __syncthreads();
}

struct RouterA {
  static constexpr bool DIRECT = true;
  typedef uint4 Raw; const bf16_t* ph; const bf16_t* pl;
  __device__ __forceinline__ const bf16_t* gp(int i, int kt) const { return ((kt >= 16 && kt < 32) ? pl + (kt - 16) * 64 : ph + (kt & 15) * 64) + (size_t)i * 64 * D; }
  __device__ __forceinline__ void pre(int) {}
  __device__ __forceinline__ Raw ld(int, int) const { return make_uint4(0, 0, 0, 0); }
  __device__ __forceinline__ uint4 cvt(const Raw& r, int) const { return r; }
};

__device__ __forceinline__ void router_tile(const Params& p, int L, lptr lds, int mt) {
  const int tid_ = opaque((int)threadIdx.x);
  const bool dry = false;
  const int tid = tid_, lane = tid & 63, wave = tid >> 6, wm = wave >> 2, wn = wave & 3, q4 = lane >> 4;
  unsigned char* ws = p.ws;
  const bf16_t* AF = (const bf16_t*)(ws + WS_AF); const bf16_t* FLO = (const bf16_t*)(ws + B_FLO);
  const bf16_t* WR = (const bf16_t*)(ws + WS_WR) + (size_t)L * 128 * 2048;
  int* counts = (int*)(ws + WS_CNT) + L * NE; int* lists = (int*)(ws + WS_LISTS); float* wts = (float*)(ws + WS_WTS);
  const float* rbias = opq(p.in[I_RB] + L * NE);
  {
    {
      f32x4 acc[4][2]; zero_acc(acc);
      router_gemm(acc, AF + (size_t)(mt * 128 + ROW8(0)) * D + CO8, FLO + (size_t)(mt * 128 + ROW8(0)) * D + CO8, WR + (size_t)ROW8(0) * 2048 + CO8, lds);
      LAS float* lg = (LAS float*)lds;
      LAS float* sg = (LAS float*)(lds + 33280);
      LAS int* lcnt = (LAS int*)(lds + XLDS + 1280);
#pragma unroll
      for (int mi = 0; mi < 4; ++mi)
#pragma unroll
        for (int r = 0; r < 4; ++r) lg[(wm * 64 + mi * 16 + (lane & 15)) * 65 + wn * 16 + q4 * 4 + r] = acc[mi][0][r] + acc[mi][1][r];
      if (tid < 64) lcnt[tid] = 0;
      __syncthreads();
      int eidx[TOPK]; int lslot[TOPK]; float wk[TOPK];
      if (tid < 128) {
        LAS float* lr = lg + tid * 65; LAS float* sr = sg + tid * 65;
        float gs[8];
#pragma unroll
        for (int g = 0; g < 8; ++g) {
          float m1 = -INFINITY, m2 = -INFINITY;
#pragma unroll
          for (int j = 0; j < 8; ++j) {
            const float sc = sigmoidf_(lr[g * 8 + j]); sr[g * 8 + j] = sc;
            const float v = sc + rbias[g * 8 + j]; lr[g * 8 + j] = v;
            if (v > m1) { m2 = m1; m1 = v; } else if (v > m2) m2 = v;
          }
          gs[g] = m1 + m2;
        }
        unsigned gmask = 0;
#pragma unroll
        for (int it = 0; it < 4; ++it) {
          float best = -INFINITY; int bi = 0;
#pragma unroll
          for (int g = 0; g < 8; ++g) if (!((gmask >> g) & 1u) && gs[g] > best) { best = gs[g]; bi = g; }
          gmask |= 1u << bi;
        }
        unsigned long long taken = 0ull; float ssum = 0.f;
#pragma unroll
        for (int k = 0; k < TOPK; ++k) {
          float best = -INFINITY; int bi = 0;
#pragma unroll 8
          for (int e = 0; e < NE; ++e) {
            const float v = lr[e];
            if (((gmask >> (e >> 3)) & 1u) && !((taken >> e) & 1ull) && v > best) { best = v; bi = e; }
          }
          taken |= 1ull << bi; eidx[k] = bi; wk[k] = sr[bi]; ssum += wk[k];
        }
        const float inv = 2.5f / ssum;
#pragma unroll
        for (int k = 0; k < TOPK; ++k) { wk[k] *= inv; lslot[k] = dry ? 0 : atomicAdd((int*)(lcnt + eidx[k]), 1); }
      }
      __syncthreads();
      if (tid < 64 && !dry) { const int c = lcnt[tid]; lcnt[64 + tid] = c ? atomicAdd(&counts[tid], c) : 0; }
      __syncthreads();
      if (tid < 128 && !dry) {
        const int tok = mt * 128 + tid;
#pragma unroll
        for (int k = 0; k < TOPK; ++k) {
          lists[(size_t)eidx[k] * T + lcnt[64 + eidx[k]] + lslot[k]] = tok * 8 + k;
          wts[tok * 8 + k] = wk[k];
        }
      }
      __syncthreads();
    }
  }
}

__device__ __forceinline__ void shared_unit(const Params& p, int L, lptr lds, int mt) {
  const bf16_t* wg = (const bf16_t*)(p.ws + WS_WSGU + (size_t)L * 512 * 1024); const bf16_t* wd = (const bf16_t*)(p.ws + WS_WSD + (size_t)L * 1024 * 256); const int* nolist = nullptr;
  asm volatile("" : "+s"(wg), "+s"(wd), "+s"(nolist));
  expert_unit(p, L, wg, wd, nolist, 128, mt * 128, lds, 0);
}

__device__ __forceinline__ void phase_experts(const Params& p, int L, lptr lds, int vb, int nblocks, int dry = 0) {
  const int tid = threadIdx.x;
  int* counts = (int*)(p.ws + WS_CNT) + L * NE; const int* lists = (const int*)(p.ws + WS_LISTS);
  LAS int* cnt = (LAS int*)(lds + XLDS + 1024);
  __syncthreads();
  if (tid < 64) cnt[tid] = __hip_atomic_load(&counts[tid], __ATOMIC_RELAXED, __HIP_MEMORY_SCOPE_AGENT);
  __syncthreads();
  int e = 0, base = 0;
  for (int u = vb;; u += nblocks) {
    while (e < NE && u >= base + ((cnt[e] + 127) >> 7)) { base += (cnt[e] + 127) >> 7; ++e; }
    if (e >= NE) break;
    const int rb = u - base, c = cnt[e];
    int nv = c - rb * 128; if (nv > 128) nv = 128;
    expert_unit(p, L, (const bf16_t*)(p.ws + WS_WEGU + (size_t)e * 512 * 1024), (const bf16_t*)(p.ws + WS_WED + (size_t)e * 1024 * 256),
                      lists + (size_t)e * T + rb * 128, nv, 0, lds, dry);
  }
}

__device__ __forceinline__ void combine_panel(const Params& p, int L, int mt) {
  const int lane = threadIdx.x & 63, wave = threadIdx.x >> 6;
  const float* mod = opq((const float*)(p.ws + WS_MOD)); const float* nmix1 = opq(p.in[I_NMIX] + D); const float* fnw = opq(p.in[I_FNW]);
  const unsigned char* CONTRIB = p.ws + B_CONTRIB;
  bf16_t* AF = (bf16_t*)(p.ws + WS_AF);
#pragma unroll 2
  for (int r = mt * 128 + wave; r < mt * 128 + 128; r += NWAVES) {
    const int b = r >> 12;
    float4 v[4];
#pragma unroll
    for (int j = 0; j < 4; ++j) {
      const int c = lane + 64 * j;
      const f32x4 ht = unpack4(((const uint2*)HROW(r))[c]); float4 h = make_float4(ht[0], ht[1], ht[2], ht[3]);
      float s0 = 0.f, s1 = 0.f, s2 = 0.f, s3 = 0.f;
#pragma unroll
      for (int k = 0; k < 6; ++k) {
        const int u = (int)((const unsigned*)(CONTRIB + ((size_t)r * 6 + k) * D))[c];
        const f32x2 lo = __builtin_amdgcn_cvt_pk_f32_fp8(u, false), hi = __builtin_amdgcn_cvt_pk_f32_fp8(u, true);
        s0 += lo[0]; s1 += lo[1]; s2 += hi[0]; s3 += hi[1];
      }
      {
        const int u = (int)((const unsigned*)(p.ws + B_SHC + (size_t)r * D))[c];
        const f32x2 lo = __builtin_amdgcn_cvt_pk_f32_fp8(u, false), hi = __builtin_amdgcn_cvt_pk_f32_fp8(u, true);
        s0 += lo[0]; s1 += lo[1]; s2 += hi[0]; s3 += hi[1];
      }
      const float4 g2 = ((const float4*)(mod + (size_t)(L * 9 + b) * 6144 + 5120))[c];
      h.x += g2.x * s0; h.y += g2.y * s1; h.z += g2.z * s2; h.w += g2.w * s3;
      v[j] = h;
    }
    if (L == 0) {
#pragma unroll
      for (int j = 0; j < 4; ++j) ((uint2*)HROW(r))[lane + 64 * j] = pack4((f32x4){v[j].x, v[j].y, v[j].z, v[j].w});
      const float* m1 = mod + (size_t)(9 + b) * 6144;
      norm_mod_row(v, nmix1, m1 + 1024, m1, nullptr, nullptr, lane, p.ws + WS_AF8 + (size_t)r * D);
    } else {
      float ss = 0.f;
#pragma unroll
      for (int j = 0; j < 4; ++j) ss += (v[j].x * v[j].x + v[j].y * v[j].y) + (v[j].z * v[j].z + v[j].w * v[j].w);
      ss = wave_sum(ss);
      const float rstd = 1.0f / sqrtf(ss * (1.0f / 1024.0f) + EPS);
#pragma unroll
      for (int j = 0; j < 4; ++j) {
        const float4 w = ((const float4*)fnw)[lane + 64 * j];
        float4 o; o.x = v[j].x * rstd * w.x; o.y = v[j].y * rstd * w.y; o.z = v[j].z * rstd * w.z; o.w = v[j].w * rstd * w.w;
        ((float4*)(p.out + (size_t)r * D))[lane + 64 * j] = o;
      }
    }
  }
}

__device__ __forceinline__ void convert_experts(const Params& p, int L, lptr lds, int vb, int nblocks, int first = 0, int last = NE * 384) {
  const int lane = threadIdx.x & 63, wave = threadIdx.x >> 6;
  LAS float* scr = (LAS float*)(lds + wave * 8448);
  __syncthreads();
  for (int it = first + vb * NWAVES + wave; it < last; it += nblocks * NWAVES) expert_item(p, L, it, scr, lane);
  __syncthreads();
}
constexpr int CONV_EARLY = 10240;

__device__ __forceinline__ void inproj1_panel(const Params& p, lptr lds, int mt) {
  const int tid_ = opaque((int)threadIdx.x);
  const bf16_t* AF = (const bf16_t*)(p.ws + WS_AF8); const bf16_t* W = (const bf16_t*)(p.ws + WS_WIN1);
  bf16_t* PB = (bf16_t*)(p.ws + B_P); bf16_t* BB = (bf16_t*)(p.ws + B_B);
  StrideLoader al, bl;
  al.p0 = AF + (size_t)(mt * 128 + ROW8(0)) * 512 + CO8; al.ld64 = 64 * 512;
  bl.p0 = W + (size_t)ROW8(0) * 512 + CO8; bl.ld64 = 64 * 512;
  int st = 0;
  gemm_pre_at<4>(al, bl, st, lds);
#pragma unroll 1
  for (int nt = 0; nt < 12; ++nt) {
    f32x4 acc[4][4]; zero_acc(acc);
    StrideLoader bln = bl; bln.p0 += (size_t)256 * 512;
    gemm_chain8<4>(acc, al, bl, 8, lds, st, nt < 11, al, bln);
    bl = bln;
    const int te = opaque(tid_), le = te & 63, we = te >> 6, wm = we >> 2, wn = we & 3, q4 = le >> 4;
    const size_t row0 = (size_t)mt * 128 + wm * 64 + (le & 15);
    if (nt < 8) {
#pragma unroll
      for (int mi = 0; mi < 4; ++mi) store_row2(PB + (row0 + mi * 16) * D + nt * 128 + wn * 32, acc[mi][0] * acc[mi][1] * (F8_INV * F8_INV), acc[mi][2] * acc[mi][3] * (F8_INV * F8_INV), q4);
    } else {
#pragma unroll
      for (int mi = 0; mi < 4; ++mi) store_row4(BB + (row0 + mi * 16) * D + (nt - 8) * 256 + wn * 64, acc[mi][0] * F8_INV, acc[mi][1] * F8_INV, acc[mi][2] * F8_INV, acc[mi][3] * F8_INV, q4);
    }
  }
  __syncthreads();
}

__device__ __forceinline__ void conv3_panel(const Params& p, int mt) {
  const int lane = threadIdx.x & 63, wave = threadIdx.x >> 6;
  const bf16_t* PB = (const bf16_t*)(p.ws + B_P); const bf16_t* BB = (const bf16_t*)(p.ws + B_B); bf16_t* SB = (bf16_t*)(p.ws + B_S);
  const float* cw = opq(p.in[I_ODCW]);
  float w0[16], w1[16], w2[16];
#pragma unroll
  for (int h = 0; h < 2; ++h)
#pragma unroll
    for (int q = 0; q < 2; ++q) {
      const int c = h * 512 + lane * 8 + q * 4;
      const float4 a = *(const float4*)(cw + c), b = *(const float4*)(cw + 1024 + c), d = *(const float4*)(cw + 2048 + c);
      const int o = h * 8 + q * 4;
      w0[o] = a.x; w0[o + 1] = a.y; w0[o + 2] = a.z; w0[o + 3] = a.w; w1[o] = b.x; w1[o + 1] = b.y; w1[o + 2] = b.z; w1[o + 3] = b.w; w2[o] = d.x; w2[o + 1] = d.y; w2[o + 2] = d.z; w2[o + 3] = d.w;
    }
#pragma unroll 2
  for (int r = mt * 128 + wave; r < mt * 128 + 128; r += NWAVES) {
    const int tokb = r & 4095;
    const float fm = tokb > 0 ? 1.f : 0.f, fp = tokb < SEQ - 1 ? 1.f : 0.f;
#pragma unroll
    for (int h = 0; h < 2; ++h) {
      const size_t o = (size_t)r * D + h * 512 + lane * 8;
      const uint4 bq = *(const uint4*)(BB + o), pc = *(const uint4*)(PB + o);
      const uint4 pm = *(const uint4*)(PB + o - (tokb > 0 ? D : 0)), pn = *(const uint4*)(PB + o + (tokb < SEQ - 1 ? D : 0));
      const unsigned bb[4] = {bq.x, bq.y, bq.z, bq.w}, m[4] = {pm.x, pm.y, pm.z, pm.w}, c[4] = {pc.x, pc.y, pc.z, pc.w}, n[4] = {pn.x, pn.y, pn.z, pn.w};
      unsigned ov[4];
#pragma unroll
      for (int q = 0; q < 4; ++q) {
        const int e = h * 8 + 2 * q;
        const float lo = bflo(bb[q]) * (fm * w0[e] * bflo(m[q]) + w1[e] * bflo(c[q]) + fp * w2[e] * bflo(n[q]));
        const float hi = bfhi(bb[q]) * (fm * w0[e + 1] * bfhi(m[q]) + w1[e + 1] * bfhi(c[q]) + fp * w2[e + 1] * bfhi(n[q]));
        ov[q] = pk2(lo, hi);
      }
      *(uint4*)(SB + o) = make_uint4(ov[0], ov[1], ov[2], ov[3]);
    }
  }
}

#define XB_TMO      128
#define XB_XCNT(j)  (256  + 64 * (j))
#define XB_XSUB(j)  (1280 + 64 * (j))
#define XB_XGEN(j)  (2304 + 64 * (j))
#define XB_TOP      3328
#define XB_TOPGEN   3392
#define XCD_BAR_WORDS 3456
#define XB_SPIN_CAP (1u << 22)
__device__ __forceinline__ unsigned xb_ld(unsigned* p) { return __hip_atomic_load(p, __ATOMIC_RELAXED, __HIP_MEMORY_SCOPE_AGENT); }
__device__ __forceinline__ unsigned xb_add(unsigned* p, unsigned v) { return __hip_atomic_fetch_add(p, v, __ATOMIC_RELAXED, __HIP_MEMORY_SCOPE_AGENT); }
__device__ __forceinline__ unsigned xb_xcc_id() { return (unsigned)__builtin_amdgcn_s_getreg((3 << 11) | 20) & 0xFu; }
#define XB_SPIN(cond, bar) do { unsigned _sp = 0; while (cond) { __builtin_amdgcn_s_sleep(1); \
    if ((++_sp & 255u) == 0u) { if (xb_ld(&(bar)[XB_TMO])) break; if (_sp > XB_SPIN_CAP) { atomicAdd(&(bar)[XB_TMO], 1u); break; } } } } while (0)
struct XcdBarrier { unsigned* bar; unsigned x; volatile LAS unsigned* st; };
__device__ __forceinline__ XcdBarrier xcd_barrier_post(unsigned* bar, volatile LAS unsigned* st) {
  XcdBarrier b; b.bar = bar; b.x = xb_xcc_id(); b.st = st;
  if (threadIdx.x == 0) (void)xb_add(&bar[XB_XCNT(b.x)], 1u);
  return b;
}
__device__ __forceinline__ void xcd_barrier_complete(unsigned* bar, unsigned x, unsigned& nloc, unsigned& nx) {
  const unsigned G = gridDim.x * gridDim.y * gridDim.z;
  unsigned sum, cnt, mine, sp = 0u;
  for (;;) {
    sum = 0u; cnt = 0u; mine = 0u;
#pragma unroll
    for (unsigned j = 0; j < 16; ++j) { const unsigned c = xb_ld(&bar[XB_XCNT(j)]); sum += c; cnt += (c > 0u) ? 1u : 0u; mine = (j == x) ? c : mine; }
    if (sum == G) break;
    __builtin_amdgcn_s_sleep(1);
    if ((++sp & 255u) == 0u) { if (xb_ld(&bar[XB_TMO])) break; if (sp > XB_SPIN_CAP) { atomicAdd(&bar[XB_TMO], 1u); break; } }
  }
  nloc = mine > 0u ? mine : 1u; nx = cnt > 0u ? cnt : 1u;
}
__device__ __forceinline__ void xcd_barrier(unsigned* bar_, lptr lds) {
  asm volatile("s_waitcnt vmcnt(0)" ::: "memory");
  __syncthreads();
  if (threadIdx.x == 0) {
    XcdBarrier b; b.bar = bar_; b.x = xb_xcc_id(); b.st = (volatile LAS unsigned*)(lds + LDS_BYTES - 16);
    unsigned* bar = b.bar;
    __builtin_amdgcn_s_waitcnt(0);
    unsigned nloc = b.st[0], nx = b.st[1];
    if (nloc == 0u) { xcd_barrier_complete(bar, b.x, nloc, nx); b.st[0] = nloc; b.st[1] = nx; }
    const unsigned old = xb_add(&bar[XB_XSUB(b.x)], 1u);
    const unsigned gen = old / nloc;
    if (old + 1u == (gen + 1u) * nloc) {
      __builtin_amdgcn_fence(__ATOMIC_RELEASE, "agent");
      asm volatile("s_waitcnt vmcnt(0)" ::: "memory");
      const unsigned og = xb_add(&bar[XB_TOP], 1u);
      const unsigned tg = og / nx;
      if (og + 1u == (tg + 1u) * nx) xb_add(&bar[XB_TOPGEN], 1u);
      else XB_SPIN(xb_ld(&bar[XB_TOPGEN]) == tg, bar);
      __builtin_amdgcn_fence(__ATOMIC_ACQUIRE, "agent");
      xb_add(&bar[XB_XGEN(b.x)], 1u);
      asm volatile("s_waitcnt vmcnt(0)" ::: "memory");
    } else {
      XB_SPIN(xb_ld(&bar[XB_XGEN(b.x)]) == gen, bar);
      __builtin_amdgcn_fence(__ATOMIC_ACQUIRE, "agent");
      asm volatile("s_waitcnt vmcnt(0)" ::: "memory");
    }
  }
  __syncthreads();
}

__global__ void __launch_bounds__(NTHREADS, 2) fwd_kernel(Params p) {
  extern __shared__ __attribute__((aligned(16))) unsigned char smem[];
  lptr lds = (lptr)smem;
  const int nblocks = gridDim.x;
  const int bx = blockIdx.x;
  const int vb = ((nblocks & 7) == 0) ? (bx & 7) * (nblocks >> 3) + (bx >> 3) : bx;
  cg::grid_group grid = cg::this_grid();
  volatile LAS unsigned* bst = (volatile LAS unsigned*)(lds + LDS_BYTES - 16);
  if (threadIdx.x == 0) { bst[0] = 0u; bst[1] = 0u; }
  __syncthreads();
  if (p.ph_hi - p.ph_lo > 2) (void)xcd_barrier_post((unsigned*)(p.ws + WS_BAR), bst);
  const int lo = p.ph_lo, hi = p.ph_hi;
#ifdef ONLY_PHASE
#define IN(k) ((k) == ONLY_PHASE && lo <= (k) && (k) < hi)
#else
#define IN(k) (lo <= (k) && (k) < hi)
#endif
#ifndef PROBE_DOUBLE
#define PROBE_DOUBLE -1
#endif
#define SEAM(k) do { if (lo <= (k) && (k) + 1 < hi) { if ((k) == lo) grid.sync(); else xcd_barrier((unsigned*)(p.ws + WS_BAR), lds); } } while (0)
#define PANEL_SYNC() do { asm volatile("s_waitcnt vmcnt(0)" ::: "memory"); __syncthreads(); } while (0)
  if (IN(0)) phase0(p, lds, vb, nblocks);
  SEAM(0);
  if (IN(1)) {
    for (int pan = vb; pan < 272; pan += nblocks) {
      a0_panel(p, pan); PANEL_SYNC();
      inproj0_panel(p, lds, pan); PANEL_SYNC();
      upproj_panel(p, lds, pan);
    }
    if (nblocks == 256 && vb >= 16) convert_experts(p, 0, lds, vb - 16, 240, 0, CONV_EARLY);
  }
  SEAM(1);
  if (IN(2)) {
    const bool early = (blockIdx.x & 1) == 0;
    const int cfirst = (nblocks == 256) ? CONV_EARLY : 0;
    if (early) convert_experts(p, 0, lds, vb, nblocks, cfirst);
    phase4(p, lds, vb, nblocks); conv_units(p, lds, vb, nblocks);
    if (!early) convert_experts(p, 0, lds, vb, nblocks, cfirst);
  }
  SEAM(2);
  if (IN(3)) {
    for (int mt = vb; mt < 256; mt += nblocks) {
      outproj_panel(p, 0, lds, mt);
      ffnprep_panel(p, 0, mt); PANEL_SYNC();
      router_tile(p, 0, lds, mt);
      shared_unit(p, 0, lds, mt);
    }
  }
  SEAM(3);
  if (IN(4)) phase_experts(p, 0, lds, vb, nblocks);
  SEAM(4);
  if (IN(5)) {
    const bool early = (blockIdx.x & 1) == 0;
    if (early) convert_experts(p, 1, lds, vb, nblocks);
    for (int mt = vb; mt < 256; mt += nblocks) {
      combine_panel(p, 0, mt); PANEL_SYNC();
      inproj1_panel(p, lds, mt);
    }
    if (!early) convert_experts(p, 1, lds, vb, nblocks);
  }
  SEAM(5);
  if (IN(6)) {
    for (int mt = vb; mt < 256; mt += nblocks) {
      conv3_panel(p, mt); PANEL_SYNC();
      outproj_panel(p, 1, lds, mt);
      ffnprep_panel(p, 1, mt); PANEL_SYNC();
      router_tile(p, 1, lds, mt);
      shared_unit(p, 1, lds, mt);
    }
  }
  SEAM(6);
  if (IN(7)) phase_experts(p, 1, lds, vb, nblocks);
  SEAM(7);
  if (IN(8)) { for (int mt = vb; mt < 256; mt += nblocks) combine_panel(p, 1, mt); }
}

extern "C" void kernel_launch(void* const* d_in, const int* in_sizes, int n_in, void* d_out, int out_size,
                              void* d_ws, size_t ws_size, hipStream_t stream) {
  static int grid_blocks = 0;
  if (!grid_blocks) {
    int dev = 0, cus = 0, per_cu = 0;
    (void)hipGetDevice(&dev);
    (void)hipDeviceGetAttribute(&cus, hipDeviceAttributeMultiprocessorCount, dev);
    if (hipFuncSetAttribute((const void*)fwd_kernel, hipFuncAttributeMaxDynamicSharedMemorySize, LDS_BYTES) != hipSuccess) fprintf(stderr, "hipFuncSetAttribute failed\n");
    if (hipOccupancyMaxActiveBlocksPerMultiprocessor(&per_cu, fwd_kernel, NTHREADS, LDS_BYTES) != hipSuccess) per_cu = 0;
    fprintf(stderr, "kernel_launch: cus %d per_cu %d ws %zu n_in %d\n", cus, per_cu, ws_size, n_in);
    if (per_cu > 1) per_cu = 1;
    if (per_cu < 1) per_cu = 1;
    grid_blocks = cus * per_cu; if (grid_blocks > 256) grid_blocks = 256;
    if (ws_size < WS_END || n_in != N_IN) { fprintf(stderr, "kernel_launch: bad ws/n_in\n"); grid_blocks = -1; }
  }
  if (grid_blocks < 0) return;
  (void)hipMemsetAsync(d_ws, 0, 64 * 1024, stream);
  Params p{};
  for (int i = 0; i < N_IN; ++i) p.in[i] = (const float*)d_in[i];
  p.out = (float*)d_out; p.ws = (unsigned char*)d_ws;
#if MK_MULTI
  for (int ph = 0; ph < NPHASE; ++ph) {
    p.ph_lo = ph; p.ph_hi = ph + 1;
    hipLaunchKernelGGL(fwd_kernel, dim3(grid_blocks), dim3(NTHREADS), LDS_BYTES, stream, p);
  }
#else
  p.ph_lo = 0; p.ph_hi = NPHASE;
  void* args[] = {&p};
  hipError_t e = hipLaunchCooperativeKernel((void*)fwd_kernel, dim3(grid_blocks), dim3(NTHREADS), args, LDS_BYTES, stream);
  if (e != hipSuccess) fprintf(stderr, "cooperative launch failed: %s (grid %d)\n", hipGetErrorString(e), grid_blocks);
#endif
}
```

```cpp
#include <hip/hip_runtime.h>
#include <hip/hip_cooperative_groups.h>
#include <cstdio>
#include <cstdint>
namespace cg = cooperative_groups;

#ifndef MK_MULTI
#define MK_MULTI 0
#endif

#define LAS __attribute__((address_space(3)))
typedef unsigned short bf16_t;
typedef short bf16x8 __attribute__((ext_vector_type(8)));
typedef float f32x4 __attribute__((ext_vector_type(4)));
typedef LAS unsigned char* lptr;
typedef unsigned u32x4 __attribute__((ext_vector_type(4)));
typedef float f32x2 __attribute__((ext_vector_type(2)));
typedef int i32x4 __attribute__((ext_vector_type(4)));
typedef int i32x8 __attribute__((ext_vector_type(8)));
constexpr float F8_SA = 4.0f, F8_SW1 = 256.0f, F8_SACT = 8.0f, F8_SW2 = 128.0f, F8_INV = 1.0f / 1024.0f;

constexpr int D = 1024, NB = 8, SEQ = 4096, T = NB * SEQ, CL = 256, TC = NB * CL, TT = T + TC, NKEY = SEQ + CL;
constexpr int NH = 8, DQK = 96, DV = 64;
constexpr int NE = 64, TOPK = 6;
constexpr float EPS = 1e-6f;
constexpr int NPHASE = 9;
constexpr int NTHREADS = 512, NWAVES = 8;
constexpr int RING_BYTES = 147456;
constexpr int XLDS = RING_BYTES;
constexpr int LDS_BYTES = RING_BYTES + 2048;

enum { I_X = 0, I_C, I_CTX, I_CCTX, I_ADAW, I_ADAB, I_NMIX, I_NFFN, I_EVWIN, I_EVCW, I_EVCB, I_EVLNW, I_EVLNB, I_QNW, I_KVNW,
       I_WUQ, I_WUKV, I_EVWOUT, I_ODWIN, I_ODCW, I_ODWOUT, I_RW, I_RB, I_EG, I_EU, I_ED, I_SG, I_SU, I_SD, I_FNW, N_IN };

struct Params {
  const float* in[N_IN];
  float* out;
  unsigned char* ws;
  int ph_lo, ph_hi;
};

constexpr size_t MiB = 1u << 20;
constexpr size_t WS_CNT = 0;
constexpr size_t WS_BAR = 16 * 1024;
constexpr size_t WS_MOD = 64 * 1024;
constexpr size_t WS_ROPE = WS_MOD + 512 * 1024;
constexpr size_t WS_CW1 = WS_ROPE + 8 * 1024;
constexpr size_t WS_WTS = 1 * MiB;
constexpr size_t WS_LISTS = 2 * MiB;
constexpr size_t WS_ACT = 10 * MiB;
constexpr size_t WS_WIN0 = 26 * MiB;
constexpr size_t WS_WUQ = 29 * MiB;
constexpr size_t WS_WUKV = WS_WUQ + 512 * 1024;
constexpr size_t WS_WOUT0 = 30 * MiB;
constexpr size_t WS_WIN1 = 32 * MiB;
constexpr size_t WS_WOUT1 = 38 * MiB;
constexpr size_t WS_WR = 40 * MiB;
constexpr size_t WS_WSGU = 42 * MiB;
constexpr size_t WS_WSD = 44 * MiB;
constexpr size_t WS_WEGU = 46 * MiB;
constexpr size_t WS_AF8 = 78 * MiB;
constexpr size_t WS_WED = 110 * MiB;
constexpr size_t WS_AF = 142 * MiB;
constexpr size_t WS_BIG = 210 * MiB;
constexpr size_t WS_END = 594 * MiB;
constexpr size_t B_GLU = WS_BIG + 0 * MiB;
constexpr size_t B_CQ = WS_BIG + 32 * MiB;
constexpr size_t B_CKV = WS_BIG + 48 * MiB;
constexpr size_t B_KR = WS_BIG + 57 * MiB;
constexpr size_t B_Q = WS_BIG + 60 * MiB;
constexpr size_t B_K = WS_BIG + 108 * MiB;
constexpr size_t B_VT = WS_BIG + 159 * MiB;
constexpr size_t B_OCAT = WS_BIG + 193 * MiB;
constexpr size_t B_FLO = WS_BIG + 64 * MiB;
constexpr size_t B_CONTRIB = WS_BIG;
constexpr size_t B_P = WS_BIG + 192 * MiB;
constexpr size_t B_B = WS_BIG + 256 * MiB;
constexpr size_t B_SHC = WS_BIG + 320 * MiB;
constexpr size_t B_S = WS_BIG;

typedef __bf16 bf16v2_t __attribute__((ext_vector_type(2)));
__device__ __forceinline__ unsigned pk2(float lo, float hi) {
  bf16v2_t v; v[0] = (__bf16)lo; v[1] = (__bf16)hi; return __builtin_bit_cast(unsigned, v);
}
__device__ __forceinline__ float bflo(unsigned u) { return __uint_as_float(u << 16); }
__device__ __forceinline__ float bfhi(unsigned u) { return __uint_as_float(u & 0xffff0000u); }
__device__ __forceinline__ unsigned pack4_fp8(f32x4 v) {
  int u = __builtin_amdgcn_cvt_pk_fp8_f32(v[0], v[1], 0, false);
  u = __builtin_amdgcn_cvt_pk_fp8_f32(v[2], v[3], u, true);
  return (unsigned)u;
}
__device__ __forceinline__ unsigned pack4_fp8c(f32x4 v) {
#pragma unroll
  for (int r = 0; r < 4; ++r) v[r] = fminf(fmaxf(v[r], -448.0f), 448.0f);
  return pack4_fp8(v);
}
__device__ __forceinline__ uint2 pack4(f32x4 v) { uint2 r; r.x = pk2(v[0], v[1]); r.y = pk2(v[2], v[3]); return r; }
__device__ __forceinline__ f32x4 unpack4(uint2 u) { return (f32x4){bflo(u.x), bfhi(u.x), bflo(u.y), bfhi(u.y)}; }
#define HROW(r) ((bf16_t*)(p.out + (size_t)(r) * D))
__device__ __forceinline__ void tr4x4(unsigned& x0, unsigned& x1, unsigned& x2, unsigned& x3) {
  { auto r = __builtin_amdgcn_permlane32_swap(x0, x2, false, false); x0 = r[0]; x2 = r[1]; }
  { auto r = __builtin_amdgcn_permlane32_swap(x1, x3, false, false); x1 = r[0]; x3 = r[1]; }
  { auto r = __builtin_amdgcn_permlane16_swap(x0, x1, false, false); x0 = r[0]; x1 = r[1]; }
  { auto r = __builtin_amdgcn_permlane16_swap(x2, x3, false, false); x2 = r[0]; x3 = r[1]; }
}
__device__ __forceinline__ void store_row4(bf16_t* rowp, f32x4 v0, f32x4 v1, f32x4 v2, f32x4 v3, int q4) {
  uint2 a = pack4(v0), b = pack4(v1), c = pack4(v2), d = pack4(v3);
  tr4x4(a.x, b.x, c.x, d.x); tr4x4(a.y, b.y, c.y, d.y);
  u32x4* o = (u32x4*)(rowp + q4 * 16);
  o[0] = (u32x4){a.x, a.y, b.x, b.y}; o[1] = (u32x4){c.x, c.y, d.x, d.y};
}
__device__ __forceinline__ void store_row2(bf16_t* rowp, f32x4 v0, f32x4 v1, int q4) {
  uint2 a = pack4(v0), b = pack4(v1);
  { auto r = __builtin_amdgcn_permlane16_swap(a.x, b.x, false, false); a.x = r[0]; b.x = r[1]; }
  { auto r = __builtin_amdgcn_permlane16_swap(a.y, b.y, false, false); a.y = r[0]; b.y = r[1]; }
  *(u32x4*)(rowp + (q4 & 1) * 16 + (q4 >> 1) * 8) = (u32x4){a.x, a.y, b.x, b.y};
}
__device__ __forceinline__ float wave_sum(float v) {
#pragma unroll
  for (int o = 1; o < 64; o <<= 1) v += __shfl_xor(v, o);
  return v;
}
__device__ __forceinline__ void lds_w16(lptr p, uint4 v) { *(LAS u32x4*)p = (u32x4){v.x, v.y, v.z, v.w}; }
__device__ __forceinline__ bf16x8 lds_r16(lptr p) { return *(LAS bf16x8*)p; }
__device__ __forceinline__ i32x4 lds_r16i(lptr p) { return *(LAS i32x4*)p; }
__device__ __forceinline__ float sigmoidf_(float x) { return 1.0f / (1.0f + __expf(-x)); }
__device__ __forceinline__ float sigmoid_fast(float x) { return __builtin_amdgcn_rcpf(1.0f + __expf(-x)); }


#define GAS __attribute__((address_space(1)))
__device__ __forceinline__ void glds16(const bf16_t* g, lptr l) {
  __builtin_amdgcn_global_load_lds((const GAS unsigned*)g, (LAS unsigned*)l, 16, 0, 0);
}
__device__ __forceinline__ int opaque(int x) { asm volatile("" : "+v"(x)); return x; }
template <class TP> __device__ __forceinline__ TP* opq(TP* x) { asm volatile("" : "+s"(x)); return x; }
#define CO8 ((((tid_ & 7) ^ ((tid_ >> 3) & 7))) << 3)
#define ROW8(i) ((i) * 64 + (tid_ >> 6) * 8 + ((tid_ & 63) >> 3))
#define WAIT_VM(n) asm volatile("s_waitcnt vmcnt(" #n ")" ::: "memory")
struct StrideLoader {
  static constexpr bool DIRECT = true;
  typedef uint4 Raw;
  const bf16_t* p0; int ld64;
  __device__ __forceinline__ const bf16_t* gp(int i, int kt) const { return p0 + (size_t)i * ld64 + kt * 64; }
  __device__ __forceinline__ void pre(int) {}
  __device__ __forceinline__ Raw ld(int, int) const { return make_uint4(0, 0, 0, 0); }
  __device__ __forceinline__ uint4 cvt(const Raw& r, int) const { return r; }
};
struct RowLoader2 {
  static constexpr bool DIRECT = true;
  typedef uint4 Raw;
  const bf16_t* p[2];
  __device__ __forceinline__ const bf16_t* gp(int i, int kt) const { return p[i] + kt * 64; }
  __device__ __forceinline__ void pre(int) {}
  __device__ __forceinline__ Raw ld(int, int) const { return make_uint4(0, 0, 0, 0); }
  __device__ __forceinline__ uint4 cvt(const Raw& r, int) const { return r; }
};

template <int NW, class AL, class BL>
__device__ __forceinline__ void gemm_pre(AL& al, BL& bl, int nk, lptr lds) {
  static_assert(AL::DIRECT && BL::DIRECT, "gemm_pre: LDS-DMA loaders only");
  const int wbase = __builtin_amdgcn_readfirstlane(opaque((int)threadIdx.x) >> 6) * 1024;
#pragma unroll
  for (int t = 0; t < 2; ++t) {
    if (t < nk) {
#pragma unroll
      for (int i = 0; i < 2; ++i) glds16(al.gp(i, t), lds + t * 49152 + i * 8192 + wbase);
#pragma unroll
      for (int i = 0; i < NW; ++i) glds16(bl.gp(i, t), lds + t * 49152 + 16384 + i * 8192 + wbase);
    }
  }
}
template <bool SWAP, int NW, bool PRE = false, class AL, class BL>
__device__ __forceinline__ void gemm_core(f32x4 (&acc)[4][NW], AL& al, BL& bl, int nk, lptr lds) {
  static_assert(BL::DIRECT, "B operand is always staged by LDS-DMA");
  static_assert(NW == 4 || NW == 1, "NW");
  constexpr int BS = NW;
  constexpr int STAGE = 49152, B_OFF = 16384;
  const int tid = opaque((int)threadIdx.x), lane = tid & 63, wave = __builtin_amdgcn_readfirstlane(tid >> 6), wm = wave >> 2, wn = wave & 3;
  int aoff[2], boff[2];
#pragma unroll
  for (int ks = 0; ks < 2; ++ks) {
    const int sw = (((ks * 4 + (lane >> 4)) ^ (lane & 7)) << 4);
    aoff[ks] = (wm * 64 + (lane & 15)) * 128 + sw;
    boff[ks] = B_OFF + (wn * 16 * NW + (lane & 15)) * 128 + sw;
  }
  const int wbase = wave * 1024;
  const int woff = (wave * 8 + (lane >> 3)) * 128 + (((lane & 7) ^ ((lane >> 3) & 7)) << 4);
  typename AL::Raw ra[2];
#pragma unroll
  for (int t = 0; t < 2; ++t) {
    if (!PRE && t < nk) {
      if constexpr (AL::DIRECT) {
#pragma unroll
        for (int i = 0; i < 2; ++i) glds16(al.gp(i, t), lds + t * STAGE + i * 8192 + wbase);
      } else {
        al.pre(t);
#pragma unroll
        for (int i = 0; i < 2; ++i) ra[i] = al.ld(i, t);
#pragma unroll
        for (int i = 0; i < 2; ++i) lds_w16(lds + t * STAGE + woff + i * 8192, al.cvt(ra[i], i));
      }
#pragma unroll
      for (int i = 0; i < BS; ++i) glds16(bl.gp(i, t), lds + t * STAGE + B_OFF + i * 8192 + wbase);
    }
  }
  int st = 0;
  for (int kt = 0; kt < nk; ++kt) {
    if constexpr (AL::DIRECT) {
      if (kt > 0 && kt + 1 < nk) { if constexpr (NW == 4) WAIT_VM(6); else WAIT_VM(3); } else WAIT_VM(0);
    } else WAIT_VM(0);
    asm volatile("s_waitcnt lgkmcnt(0)" ::: "memory");
    __builtin_amdgcn_s_barrier();
    asm volatile("" ::: "memory");
    const int s2 = (st == 0) ? 2 : st - 1;
    const bool more = (kt + 2 < nk);
    if (more) {
      if constexpr (AL::DIRECT) {
#pragma unroll
        for (int i = 0; i < 2; ++i) glds16(al.gp(i, kt + 2), lds + s2 * STAGE + i * 8192 + wbase);
      } else {
        al.pre(kt + 2);
#pragma unroll
        for (int i = 0; i < 2; ++i) ra[i] = al.ld(i, kt + 2);
      }
#pragma unroll
      for (int i = 0; i < BS; ++i) glds16(bl.gp(i, kt + 2), lds + s2 * STAGE + B_OFF + i * 8192 + wbase);
    }
    const lptr base = lds + st * STAGE;
#pragma unroll
    for (int ks = 0; ks < 2; ++ks) {
      bf16x8 af[4], bfr[NW];
#pragma unroll
      for (int i = 0; i < 4; ++i) af[i] = lds_r16(base + aoff[ks] + i * 2048);
#pragma unroll
      for (int j = 0; j < NW; ++j) bfr[j] = lds_r16(base + boff[ks] + j * 2048);
      __builtin_amdgcn_s_setprio(1);
#pragma unroll
      for (int i = 0; i < 4; ++i)
#pragma unroll
        for (int j = 0; j < NW; ++j)
          acc[i][j] = SWAP ? __builtin_amdgcn_mfma_f32_16x16x32_bf16(bfr[j], af[i], acc[i][j], 0, 0, 0)
                           : __builtin_amdgcn_mfma_f32_16x16x32_bf16(af[i], bfr[j], acc[i][j], 0, 0, 0);
      __builtin_amdgcn_s_setprio(0);
    }
    if constexpr (!AL::DIRECT) {
      if (more) {
#pragma unroll
        for (int i = 0; i < 2; ++i) lds_w16(lds + s2 * STAGE + woff + i * 8192, al.cvt(ra[i], i));
      }
    }
    st = (st == 2) ? 0 : st + 1;
  }
  __syncthreads();
}

template <int NW>
__device__ __forceinline__ void zero_acc(f32x4 (&acc)[4][NW]) {
#pragma unroll
  for (int i = 0; i < 4; ++i)
#pragma unroll
    for (int j = 0; j < NW; ++j) acc[i][j] = (f32x4){0.f, 0.f, 0.f, 0.f};
}


template <int NW, class AL, class BL>
__device__ __forceinline__ void gemm_pre_at(AL& al, BL& bl, int st, lptr lds) {
  const int wbase = __builtin_amdgcn_readfirstlane(opaque((int)threadIdx.x) >> 6) * 1024;
#pragma unroll
  for (int t = 0; t < 2; ++t) {
    const int sg = (st + t) % 3;
#pragma unroll
    for (int i = 0; i < 2; ++i) glds16(al.gp(i, t), lds + sg * 49152 + i * 8192 + wbase);
#pragma unroll
    for (int i = 0; i < NW; ++i) glds16(bl.gp(i, t), lds + sg * 49152 + 16384 + i * 8192 + wbase);
  }
}
template <bool SWAP, int NW, class AL, class BL, class ALN, class BLN>
__device__ __forceinline__ void gemm_chain(f32x4 (&acc)[4][NW], AL& al, BL& bl, int nk, lptr lds, int& st_io, bool has_next, ALN& aln, BLN& bln) {
  constexpr int STAGE = 49152, B_OFF = 16384;
  const int tid = opaque((int)threadIdx.x), lane = tid & 63, wave = __builtin_amdgcn_readfirstlane(tid >> 6), wm = wave >> 2, wn = wave & 3;
  int aoff[2], boff[2];
#pragma unroll
  for (int ks = 0; ks < 2; ++ks) {
    const int sw = (((ks * 4 + (lane >> 4)) ^ (lane & 7)) << 4);
    aoff[ks] = (wm * 64 + (lane & 15)) * 128 + sw;
    boff[ks] = B_OFF + (wn * 16 * NW + (lane & 15)) * 128 + sw;
  }
  const int wbase = wave * 1024;
  int st = st_io;
  for (int kt = 0; kt < nk; ++kt) {
    if (kt > 0 && (kt + 1 < nk || has_next)) { if constexpr (NW == 4) WAIT_VM(6); else WAIT_VM(3); } else WAIT_VM(0);
    asm volatile("s_waitcnt lgkmcnt(0)" ::: "memory");
    __builtin_amdgcn_s_barrier();
    asm volatile("" ::: "memory");
    const lptr base = lds + st * STAGE;
#pragma unroll
    for (int ks = 0; ks < 2; ++ks) {
      bf16x8 af[4], bfr[NW];
#pragma unroll
      for (int i = 0; i < 4; ++i) af[i] = lds_r16(base + aoff[ks] + i * 2048);
#pragma unroll
      for (int j = 0; j < NW; ++j) bfr[j] = lds_r16(base + boff[ks] + j * 2048);
      if (ks == 1) {
      const int s2 = (st == 0) ? 2 : st - 1;
      const int t2 = kt + 2;
      if (t2 < nk) {
  #pragma unroll
        for (int i = 0; i < 2; ++i) glds16(al.gp(i, t2), lds + s2 * STAGE + i * 8192 + wbase);
  #pragma unroll
        for (int i = 0; i < NW; ++i) glds16(bl.gp(i, t2), lds + s2 * STAGE + B_OFF + i * 8192 + wbase);
      } else if (has_next) {
  #pragma unroll
        for (int i = 0; i < 2; ++i) glds16(aln.gp(i, t2 - nk), lds + s2 * STAGE + i * 8192 + wbase);
  #pragma unroll
        for (int i = 0; i < NW; ++i) glds16(bln.gp(i, t2 - nk), lds + s2 * STAGE + B_OFF + i * 8192 + wbase);
      }
      }
      __builtin_amdgcn_s_setprio(1);
#pragma unroll
      for (int i = 0; i < 4; ++i)
#pragma unroll
        for (int j = 0; j < NW; ++j)
          acc[i][j] = SWAP ? __builtin_amdgcn_mfma_f32_16x16x32_bf16(bfr[j], af[i], acc[i][j], 0, 0, 0)
                           : __builtin_amdgcn_mfma_f32_16x16x32_bf16(af[i], bfr[j], acc[i][j], 0, 0, 0);
      __builtin_amdgcn_s_setprio(0);
    }
    st = (st == 2) ? 0 : st + 1;
  }
  st_io = st;
}
template <int NW, class AL, class BL, class ALN, class BLN>
__device__ __forceinline__ void gemm_chain8(f32x4 (&acc)[4][NW], AL& al, BL& bl, int nk, lptr lds, int& st_io, bool has_next, ALN& aln, BLN& bln) {
  constexpr int STAGE = 49152, B_OFF = 16384;
  const int tid = opaque((int)threadIdx.x), lane = tid & 63, wave = __builtin_amdgcn_readfirstlane(tid >> 6), wm = wave >> 2, wn = wave & 3;
  int aoff[2], boff[2];
#pragma unroll
  for (int ks = 0; ks < 2; ++ks) {
    const int sw = (((ks * 4 + (lane >> 4)) ^ (lane & 7)) << 4);
    aoff[ks] = (wm * 64 + (lane & 15)) * 128 + sw;
    boff[ks] = B_OFF + (wn * 16 * NW + (lane & 15)) * 128 + sw;
  }
  const int wbase = wave * 1024;
  int st = st_io;
  asm volatile("" : "+s"(nk));
#pragma unroll 1
  for (int kt = 0; kt < nk; ++kt) {
    if (kt > 0 && (kt + 1 < nk || has_next)) { if constexpr (NW == 4) WAIT_VM(6); else WAIT_VM(3); } else WAIT_VM(0);
    asm volatile("s_waitcnt lgkmcnt(0)" ::: "memory");
    __builtin_amdgcn_s_barrier();
    asm volatile("" ::: "memory");
    const lptr base = lds + st * STAGE;
    i32x8 af[4], bfr[NW];
#pragma unroll
    for (int j = 0; j < NW; ++j) bfr[j] = __builtin_shufflevector(lds_r16i(base + boff[0] + j * 2048), lds_r16i(base + boff[1] + j * 2048), 0, 1, 2, 3, 4, 5, 6, 7);
#pragma unroll
    for (int i = 0; i < 4; ++i) af[i] = __builtin_shufflevector(lds_r16i(base + aoff[0] + i * 2048), lds_r16i(base + aoff[1] + i * 2048), 0, 1, 2, 3, 4, 5, 6, 7);
    {
      const int s2 = (st == 0) ? 2 : st - 1;
      const int t2 = kt + 2;
      if (t2 < nk) {
  #pragma unroll
        for (int i = 0; i < 2; ++i) glds16(al.gp(i, t2), lds + s2 * STAGE + i * 8192 + wbase);
  #pragma unroll
        for (int i = 0; i < NW; ++i) glds16(bl.gp(i, t2), lds + s2 * STAGE + B_OFF + i * 8192 + wbase);
      } else if (has_next) {
  #pragma unroll
        for (int i = 0; i < 2; ++i) glds16(aln.gp(i, t2 - nk), lds + s2 * STAGE + i * 8192 + wbase);
  #pragma unroll
        for (int i = 0; i < NW; ++i) glds16(bln.gp(i, t2 - nk), lds + s2 * STAGE + B_OFF + i * 8192 + wbase);
      }
    }
    __builtin_amdgcn_s_setprio(1);
#pragma unroll
    for (int i = 0; i < 4; ++i)
#pragma unroll
      for (int j = 0; j < NW; ++j)
        acc[i][j] = __builtin_amdgcn_mfma_scale_f32_16x16x128_f8f6f4(bfr[j], af[i], acc[i][j], 0, 0, 0, 0x7f7f7f7f, 0, 0x7f7f7f7f);
    __builtin_amdgcn_s_setprio(0);
    st = (st == 2) ? 0 : st + 1;
  }
  st_io = st;
}

constexpr int EP_PITCH = 1040;
constexpr int EP_BASE = 98304;
constexpr int EPT_PITCH = 528;
template <int NW>
struct PutPlain {
  const f32x4 (&acc)[4][NW];
  template <class W> __device__ __forceinline__ void operator()(int band, int tid, W w) const {
    const int lane = tid & 63, wave = tid >> 6, wm = wave >> 2, wn = wave & 3;
    if (wm != (band >> 1)) return;
#pragma unroll
    for (int m2 = 0; m2 < 2; ++m2)
#pragma unroll
      for (int nj = 0; nj < NW; ++nj) w(m2 * 16 + (lane & 15), wn * 16 * NW + nj * 16 + (lane >> 4) * 4, acc[2 * (band & 1) + m2][nj]);
  }
};
template <class OP>
struct PutPair {
  const f32x4 (&acc)[4][4]; OP op;
  template <class W> __device__ __forceinline__ void operator()(int band, int tid, W w) const {
    const int lane = tid & 63, wave = tid >> 6, wm = wave >> 2, wn = wave & 3;
    if (wm != (band >> 1)) return;
#pragma unroll
    for (int m2 = 0; m2 < 2; ++m2)
#pragma unroll
      for (int j2 = 0; j2 < 2; ++j2) {
        const f32x4 x = acc[2 * (band & 1) + m2][2 * j2], y = acc[2 * (band & 1) + m2][2 * j2 + 1]; f32x4 v;
#pragma unroll
        for (int r = 0; r < 4; ++r) v[r] = op(x[r], y[r]);
        w(m2 * 16 + (lane & 15), wn * 32 + j2 * 16 + (lane >> 4) * 4, v);
      }
  }
};
template <int NC, int UNR = 4, class PUT, class F>
__device__ __forceinline__ void ep_banded(lptr lds, const PUT& put, F f) {
  constexpr int CPR = NC / 4;
  const int tid = opaque((int)threadIdx.x);
#pragma unroll
  for (int band = 0; band < 4; ++band) {
    put(band, tid, [&](int rb, int col, f32x4 v) { *(LAS f32x4*)(lds + EP_BASE + rb * EP_PITCH + col * 4) = v; });
    __syncthreads();
    static_assert((32 * CPR) % NTHREADS == 0, "ep_banded: whole passes");
#pragma unroll
    for (int it = 0; it < (32 * CPR) / NTHREADS; ++it) {
      const int idx = tid + it * NTHREADS;
      const int rb = idx / CPR, c4 = idx - rb * CPR;
      const f32x4 v = *(const LAS f32x4*)(lds + EP_BASE + rb * EP_PITCH + c4 * 16);
      f(band * 32 + rb, c4 * 4, v);
    }
    __syncthreads();
    __builtin_amdgcn_sched_barrier(0);
  }
}

enum { M_ID = 0, M_WIN0, M_WUQ, M_WUKV, M_WIN1, M_GATE, M_UP };
__device__ __forceinline__ int map_col(int mode, int n) {
  switch (mode) {
    case M_WIN0:
      if (n < 512) return ((n >> 4) << 5) + (n & 15);
      if (n < 1024) { const int c = n - 512; return ((c >> 4) << 5) + 16 + (c & 15); }
      if (n < 1408) return n;
      { const int i = n - 1408; return 1408 + (i & 16) + ((i & 7) << 1) + ((i >> 3) & 1); }
    case M_WUQ: { const int h = n / 96, d = n - h * 96; if (d < 64) return n; const int i = d - 64; return h * 96 + 64 + (i & 16) + ((i & 7) << 1) + ((i >> 3) & 1); }
    case M_WUKV: { const int h = n >> 7, d = n & 127; return d < 64 ? h * 64 + d : 512 + h * 64 + (d - 64); }
    case M_WIN1:
      if (n < 1024) return 2048 + n;
      if (n < 2048) { const int c = n - 1024; return ((c >> 4) << 5) + (c & 15); }
      { const int c = n - 2048; return ((c >> 4) << 5) + 16 + (c & 15); }
    case M_GATE: return ((n >> 4) << 5) + (n & 15);
    case M_UP: return ((n >> 4) << 5) + 16 + (n & 15);
    default: return n;
  }
}
#define WAVE_LDS_SYNC() do { asm volatile("s_waitcnt lgkmcnt(0)" ::: "memory"); __builtin_amdgcn_wave_barrier(); asm volatile("" ::: "memory"); } while (0)
__device__ __forceinline__ void transpose_item(const float* W, int K, int N, bf16_t* dst, int ldd, int mode, const float* kscale, int item, LAS float* scr, int lane) {
  const int nblk = N >> 5, kb = item / nblk, nb = item - kb * nblk, k0 = kb * 64, n0 = nb * 32;
  float4 tv[8];
#pragma unroll
  for (int i = 0; i < 8; ++i) tv[i] = *(const float4*)(W + (size_t)(k0 + 8 * i + (lane >> 3)) * N + n0 + (lane & 7) * 4);
#pragma unroll
  for (int i = 0; i < 8; ++i) {
    const int kk = 8 * i + (lane >> 3);
    const float ks = kscale ? kscale[k0 + kk] : 1.0f;
    LAS float* d = scr + kk * 33 + (lane & 7) * 4;
    d[0] = tv[i].x * ks; d[1] = tv[i].y * ks; d[2] = tv[i].z * ks; d[3] = tv[i].w * ks;
  }
  WAVE_LDS_SYNC();
  const int c = lane & 7;
#pragma unroll
  for (int j = 0; j < 4; ++j) {
    const int n = (lane >> 3) + 8 * j; const LAS float* s = scr + (8 * c) * 33 + n;
    uint4 o; o.x = pk2(s[0], s[33]); o.y = pk2(s[66], s[99]); o.z = pk2(s[132], s[165]); o.w = pk2(s[198], s[231]);
    *(uint4*)(dst + (size_t)map_col(mode, n0 + n) * ldd + k0 + 8 * c) = o;
  }
  WAVE_LDS_SYNC();
}
__device__ __forceinline__ void transpose_item8(const float* W, int K, int N, unsigned char* dst, int ldd, int mode, float scale, int item, LAS float* scr, int lane) {
  const int nblk = N >> 5, kb = item / nblk, nb = item - kb * nblk, k0 = kb * 64, n0 = nb * 32;
  float4 tv[8];
#pragma unroll
  for (int i = 0; i < 8; ++i) tv[i] = *(const float4*)(W + (size_t)(k0 + 8 * i + (lane >> 3)) * N + n0 + (lane & 7) * 4);
#pragma unroll
  for (int i = 0; i < 8; ++i) {
    LAS float* d = scr + (8 * i + (lane >> 3)) * 33 + (lane & 7) * 4;
    d[0] = tv[i].x * scale; d[1] = tv[i].y * scale; d[2] = tv[i].z * scale; d[3] = tv[i].w * scale;
  }
  WAVE_LDS_SYNC();
  const int c = lane & 7;
#pragma unroll
  for (int j = 0; j < 4; ++j) {
    const int n = (lane >> 3) + 8 * j; const LAS float* s = scr + (8 * c) * 33 + n;
    uint2 o;
    o.x = pack4_fp8c((f32x4){s[0], s[33], s[66], s[99]}); o.y = pack4_fp8c((f32x4){s[132], s[165], s[198], s[231]});
    *(uint2*)(dst + (size_t)map_col(mode, n0 + n) * ldd + k0 + 8 * c) = o;
  }
  WAVE_LDS_SYNC();
}
__device__ __forceinline__ void router_item(const float* W, bf16_t* dst, int item, LAS float* scr, int lane) {
  const int kb = item >> 1, nb = item & 1, k0 = kb * 64, n0 = nb * 32;
#pragma unroll 8
  for (int i = 0; i < 32; ++i) { const int kk = 2 * i + (lane >> 5); scr[kk * 33 + (lane & 31)] = W[(size_t)(k0 + kk) * 64 + n0 + (lane & 31)]; }
  WAVE_LDS_SYNC();
  const int c = lane & 7;
#pragma unroll
  for (int j = 0; j < 4; ++j) {
    const int n = (lane >> 3) + 8 * j; const LAS float* s = scr + (8 * c) * 33 + n;
    float v[8]; unsigned hb[4], lb[4];
#pragma unroll
    for (int q = 0; q < 8; ++q) v[q] = s[q * 33];
#pragma unroll
    for (int q = 0; q < 4; ++q) { hb[q] = pk2(v[2 * q], v[2 * q + 1]); lb[q] = pk2(v[2 * q] - bflo(hb[q]), v[2 * q + 1] - bfhi(hb[q])); }
    const int e = n0 + n;
    bf16_t* dh = dst + (size_t)((e >> 4) * 32 + (e & 15)) * 2048 + k0 + 8 * c;
    *(uint4*)(dh) = make_uint4(hb[0], hb[1], hb[2], hb[3]);
    *(uint4*)(dh + 1024) = make_uint4(hb[0], hb[1], hb[2], hb[3]);
    *(uint4*)(dh + 16 * 2048) = make_uint4(lb[0], lb[1], lb[2], lb[3]);
    *(uint4*)(dh + 16 * 2048 + 1024) = make_uint4(lb[0], lb[1], lb[2], lb[3]);
  }
  WAVE_LDS_SYNC();
}
__device__ __forceinline__ void expert_item(const Params& p, int L, int item, LAS float* scr, int lane) {
  const int e = item / 384, r = item - e * 384;
  const size_t eo = (size_t)(L * NE + e);
  unsigned char* gu = p.ws + WS_WEGU + (size_t)e * 512 * 1024;
  unsigned char* dn = p.ws + WS_WED + (size_t)e * 1024 * 256;
  if (r < 128) transpose_item8(p.in[I_EG] + eo * 1024 * 256, 1024, 256, gu, 1024, M_GATE, F8_SW1, r, scr, lane);
  else if (r < 256) transpose_item8(p.in[I_EU] + eo * 1024 * 256, 1024, 256, gu, 1024, M_UP, F8_SW1, r - 128, scr, lane);
  else transpose_item8(p.in[I_ED] + eo * 256 * 1024, 256, 1024, dn, 256, M_ID, F8_SW2, r - 256, scr, lane);
}

__device__ __forceinline__ void phase0(const Params& p, lptr lds, int vb, int nblocks) {
  const int tid = threadIdx.x, lane = tid & 63, wave = tid >> 6;
  unsigned char* ws = p.ws;
  if (vb == 0) {
    if (tid < 128) ((int*)(ws + WS_CNT))[tid] = 0;
  }
  if (vb == 2 || nblocks == 1) {
    for (int i = tid; i < 3 * 512; i += NTHREADS) { const float2 v = *(const float2*)(p.in[I_ODCW] + 2 * i); ((unsigned*)(ws + WS_CW1))[i] = pk2(v.x, v.y); }
  }
  if (vb == 1 || nblocks == 1) {
    for (int t = tid; t < 512; t += NTHREADS) {
      const int pos = t >> 3, j = t & 7;
      const float inv = 1.0f / powf(10000.0f, (float)(2 * j) / 16.0f);
      const float ang = (float)pos * inv;
      ((float2*)(ws + WS_ROPE))[t] = make_float2(cosf(ang), sinf(ang));
    }
  }
  {
    LAS float* sc = (LAS float*)lds;
    LAS float* red = (LAS float*)(lds + 36864);
    bool have = false;
    for (int it = vb; it < 384; it += nblocks) {
      if (!have) {
        float cv[18];
#pragma unroll
        for (int q = 0; q < 18; ++q) { const int i = tid + q * NTHREADS, r = i >> 10, k = i & 1023; cv[q] = (r < 8) ? p.in[I_C][r * 1024 + k] : p.in[I_CCTX][k]; }
#pragma unroll
        for (int q = 0; q < 18; ++q) sc[tid + q * NTHREADS] = cv[q] / (1.0f + __expf(-cv[q]));
        have = true;
      }
      __syncthreads();
      const int L = it / 192, n0 = (it - L * 192) * 32;
      const int col = n0 + (tid & 31), kp = tid >> 5;
      const float* w = p.in[I_ADAW] + (size_t)L * 1024 * 6144 + (size_t)(kp * 64) * 6144 + col;
      float a[9];
#pragma unroll
      for (int r = 0; r < 9; ++r) a[r] = 0.f;
      float wv[64];
#pragma unroll
      for (int k = 0; k < 64; ++k) wv[k] = w[(size_t)k * 6144];
#pragma unroll
      for (int k = 0; k < 64; ++k) {
#pragma unroll
        for (int r = 0; r < 9; ++r) a[r] += sc[r * 1024 + kp * 64 + k] * wv[k];
      }
#pragma unroll
      for (int r = 0; r < 9; ++r) red[(kp * 9 + r) * 32 + (tid & 31)] = a[r];
      __syncthreads();
      for (int o = tid; o < 288; o += NTHREADS) {
        const int r = o >> 5, cc = o & 31;
        float s = 0.f;
#pragma unroll
        for (int q = 0; q < 16; ++q) s += red[(q * 9 + r) * 32 + cc];
        ((float*)(ws + WS_MOD))[(size_t)(L * 9 + r) * 6144 + n0 + cc] = s + p.in[I_ADAB][L * 6144 + n0 + cc];
      }
    }
    __syncthreads();
  }
  LAS float* scr = (LAS float*)(lds + wave * 8448);
  const int gw = (nblocks - 1 - vb) * NWAVES + wave, NGW = nblocks * NWAVES;
  constexpr int J0 = 720, J1 = 96, J2 = 64, J3 = 512, J4 = 1536, J5 = 512, JS = 384, JR = 32, JE = NE * 384;
  constexpr int NIT = J0 + J1 + J2 + J3 + J4 + J5 + 2 * JS + 2 * JR;
  for (int it0 = gw; it0 < NIT; it0 += NGW) {
    int it = it0;
    if (it < J0) { transpose_item(p.in[I_EVWIN], 1024, 1440, (bf16_t*)(ws + WS_WIN0), 1024, M_WIN0, nullptr, it, scr, lane); continue; } it -= J0;
    if (it < J1) { transpose_item(p.in[I_WUQ], 256, 768, (bf16_t*)(ws + WS_WUQ), 256, M_WUQ, p.in[I_QNW], it, scr, lane); continue; } it -= J1;
    if (it < J2) { transpose_item(p.in[I_WUKV], 128, 1024, (bf16_t*)(ws + WS_WUKV), 128, M_WUKV, p.in[I_KVNW], it, scr, lane); continue; } it -= J2;
    if (it < J3) { transpose_item(p.in[I_EVWOUT], 1024, 1024, (bf16_t*)(ws + WS_WOUT0), 1024, M_ID, nullptr, it, scr, lane); continue; } it -= J3;
    if (it < J4) { transpose_item8(p.in[I_ODWIN], 1024, 3072, ws + WS_WIN1, 1024, M_WIN1, F8_SW1, it, scr, lane); continue; } it -= J4;
    if (it < J5) { transpose_item(p.in[I_ODWOUT], 1024, 1024, (bf16_t*)(ws + WS_WOUT1), 1024, M_ID, nullptr, it, scr, lane); continue; } it -= J5;
    if (it < 2 * JS) {
      const int L = it / JS, r = it - L * JS;
      unsigned char* gu = ws + WS_WSGU + (size_t)L * 512 * 1024; unsigned char* dn = ws + WS_WSD + (size_t)L * 1024 * 256;
      if (r < 128) transpose_item8(p.in[I_SG] + (size_t)L * 1024 * 256, 1024, 256, gu, 1024, M_GATE, F8_SW1, r, scr, lane);
      else if (r < 256) transpose_item8(p.in[I_SU] + (size_t)L * 1024 * 256, 1024, 256, gu, 1024, M_UP, F8_SW1, r - 128, scr, lane);
      else transpose_item8(p.in[I_SD] + (size_t)L * 256 * 1024, 256, 1024, dn, 256, M_ID, F8_SW2, r - 256, scr, lane);
      continue;
    }
    it -= 2 * JS;
    if (it < 2 * JR) { const int L = it / JR, r = it - L * JR; router_item(p.in[I_RW] + (size_t)L * 1024 * 64, (bf16_t*)(ws + WS_WR) + (size_t)L * 128 * 2048, r, scr, lane); continue; }
  }
}

__device__ __forceinline__ void norm_mod_row(const float4 (&v)[4], const float* nw, const float* sc, const float* sh, bf16_t* dhi, bf16_t* dlo, int lane, unsigned char* d8 = nullptr) {
  float ss = 0.f;
#pragma unroll
  for (int j = 0; j < 4; ++j) ss += (v[j].x * v[j].x + v[j].y * v[j].y) + (v[j].z * v[j].z + v[j].w * v[j].w);
  ss = wave_sum(ss);
  const float rstd = 1.0f / sqrtf(ss * (1.0f / 1024.0f) + EPS);
#pragma unroll
  for (int j = 0; j < 4; ++j) {
    const int c = lane + 64 * j;
    const float4 w = ((const float4*)nw)[c], s = ((const float4*)sc)[c], h = ((const float4*)sh)[c];
    const float y0 = v[j].x * rstd * w.x * (1.f + s.x) + h.x, y1 = v[j].y * rstd * w.y * (1.f + s.y) + h.y;
    const float y2 = v[j].z * rstd * w.z * (1.f + s.z) + h.z, y3 = v[j].w * rstd * w.w * (1.f + s.w) + h.w;
    uint2 hi; hi.x = pk2(y0, y1); hi.y = pk2(y2, y3);
    if (dhi) ((uint2*)dhi)[c] = hi;
    if (d8) ((unsigned*)d8)[c] = pack4_fp8c((f32x4){y0, y1, y2, y3} * F8_SA);
    if (dlo) { uint2 lo; lo.x = pk2(y0 - bflo(hi.x), y1 - bfhi(hi.x)); lo.y = pk2(y2 - bflo(hi.y), y3 - bfhi(hi.y)); ((uint2*)dlo)[c] = lo; }
  }
}

__device__ __forceinline__ void a0_panel(const Params& p, int pan) {
  const int lane = threadIdx.x & 63, wave = threadIdx.x >> 6;
  const float* mod = opq((const float*)(p.ws + WS_MOD)); const float* nmix = opq(p.in[I_NMIX]);
  bf16_t* AF = (bf16_t*)(p.ws + WS_AF);
#pragma unroll 1
  for (int i0 = 0; i0 < 16; i0 += 4) {
    float4 v[4][4];
#pragma unroll
    for (int u = 0; u < 4; ++u) {
      const int r = pan * 128 + wave + 8 * (i0 + u);
      const float* src = (r < T) ? p.in[I_X] + (size_t)r * D : p.in[I_CTX] + (size_t)(r - T) * D;
#pragma unroll
      for (int j = 0; j < 4; ++j) v[u][j] = ((const float4*)src)[lane + 64 * j];
    }
#pragma unroll
    for (int u = 0; u < 4; ++u) {
      const int r = pan * 128 + wave + 8 * (i0 + u);
      const int b = (r < T) ? (r >> 12) : 8;
      norm_mod_row(v[u], nmix, mod + (size_t)b * 6144 + 1024, mod + (size_t)b * 6144, AF + (size_t)r * D, nullptr, lane);
    }
  }
}

__device__ __forceinline__ void ffnprep_panel(const Params& p, int L, int mt) {
  const int lane = threadIdx.x & 63, wave = threadIdx.x >> 6;
  const float* mod = opq((const float*)(p.ws + WS_MOD) + (size_t)L * 9 * 6144); const float* nffn = opq(p.in[I_NFFN] + L * D);
  bf16_t* AF = (bf16_t*)(p.ws + WS_AF); bf16_t* FLO = (bf16_t*)(p.ws + B_FLO);
  asm volatile("s_waitcnt vmcnt(0)" ::: "memory");
  __syncthreads();
#pragma unroll 1
  for (int i0 = 0; i0 < 16; i0 += 4) {
    float4 v[4][4];
#pragma unroll
    for (int u = 0; u < 4; ++u) {
      const int r = mt * 128 + wave + 8 * (i0 + u);
#pragma unroll
      for (int j = 0; j < 4; ++j) { const f32x4 t = unpack4(((const uint2*)HROW(r))[lane + 64 * j]); v[u][j] = make_float4(t[0], t[1], t[2], t[3]); }
    }
#pragma unroll
    for (int u = 0; u < 4; ++u) {
      const int r = mt * 128 + wave + 8 * (i0 + u), b = r >> 12;
      norm_mod_row(v[u], nffn, mod + (size_t)b * 6144 + 4096, mod + (size_t)b * 6144 + 3072, AF + (size_t)r * D, FLO + (size_t)r * D, lane, p.ws + WS_AF8 + (size_t)r * D);
    }
  }
}

__device__ __forceinline__ void inproj0_panel(const Params& p, lptr lds, int pan) {
  const int tid_ = opaque((int)threadIdx.x);
  const bf16_t* AF = (const bf16_t*)(p.ws + WS_AF); const bf16_t* W = (const bf16_t*)(p.ws + WS_WIN0);
  bf16_t* GLU = (bf16_t*)(p.ws + B_GLU); bf16_t* CQ = (bf16_t*)(p.ws + B_CQ); bf16_t* CKV = (bf16_t*)(p.ws + B_CKV); bf16_t* KR = (bf16_t*)(p.ws + B_KR);
  const int mt = pan, nj = (pan < 256) ? 6 : 1, nt0 = (pan < 256) ? 0 : 5;
  StrideLoader al, bl;
  al.p0 = AF + (size_t)(mt * 128 + ROW8(0)) * D + CO8; al.ld64 = 64 * D;
  bl.p0 = W + (size_t)(nt0 * 256 + ROW8(0)) * D + CO8; bl.ld64 = 64 * D;
  int st = 0;
  gemm_pre_at<4>(al, bl, st, lds);
#pragma unroll 1
  for (int j = 0; j < nj; ++j) {
    const int nt = nt0 + j;
    f32x4 acc[4][4]; zero_acc(acc);
    StrideLoader bln = bl; bln.p0 += (size_t)256 * D;
    gemm_chain<true, 4>(acc, al, bl, 16, lds, st, j + 1 < nj, al, bln);
    bl = bln;
    const int te = opaque(tid_), le = te & 63, we = te >> 6, wm = we >> 2, wn = we & 3, q4 = le >> 4;
    const size_t row0 = (size_t)mt * 128 + wm * 64 + (le & 15);
    if (nt < 4) {
#pragma unroll
      for (int mi = 0; mi < 4; ++mi) {
        f32x4 v[2];
#pragma unroll
        for (int j2 = 0; j2 < 2; ++j2) {
          const f32x4 a = acc[mi][2 * j2], g = acc[mi][2 * j2 + 1];
#pragma unroll
          for (int r = 0; r < 4; ++r) v[j2][r] = a[r] * sigmoid_fast(g[r]);
        }
        store_row2(GLU + (row0 + mi * 16) * 512 + nt * 128 + wn * 32, v[0], v[1], q4);
      }
    } else if (nt == 4) {
#pragma unroll
      for (int mi = 0; mi < 4; ++mi) store_row4(CQ + (row0 + mi * 16) * 256 + wn * 64, acc[mi][0], acc[mi][1], acc[mi][2], acc[mi][3], q4);
    } else if (wn < 2) {
#pragma unroll
      for (int mi = 0; mi < 4; ++mi) store_row4(CKV + (row0 + mi * 16) * 128 + wn * 64, acc[mi][0], acc[mi][1], acc[mi][2], acc[mi][3], q4);
    } else if (wn == 2) {
#pragma unroll
      for (int mi = 0; mi < 4; ++mi) store_row2(KR + (row0 + mi * 16) * 32, acc[mi][0], acc[mi][1], q4);
    }
  }
  __syncthreads();
}

constexpr float QSCALE = 0.14724445f;

__device__ __forceinline__ void rstd_rows(const bf16_t* A, int lda, int klen, float extra, lptr lds) {
  const int tid = threadIdx.x, r = tid >> 2, qd = tid & 3;
  const bf16_t* ptr = A + (size_t)r * lda + qd * (klen >> 2);
  float ss = 0.f;
  for (int c = 0; c < (klen >> 5); ++c) {
    const uint4 u = *(const uint4*)(ptr + c * 8);
    const unsigned w[4] = {u.x, u.y, u.z, u.w};
#pragma unroll
    for (int q = 0; q < 4; ++q) { const float a = bflo(w[q]), b = bfhi(w[q]); ss += a * a + b * b; }
  }
  ss += __shfl_xor(ss, 1); ss += __shfl_xor(ss, 2);
  __syncthreads();
  if (qd == 0) ((LAS float*)(lds + XLDS))[r] = extra / sqrtf(ss / (float)klen + EPS);
}

__device__ __forceinline__ void upproj_panel(const Params& p, lptr lds, int pan) {
  const int tid_ = opaque((int)threadIdx.x);
  const int tid = tid_, lane = tid & 63, wave = tid >> 6, wm = wave >> 2, wn = wave & 3, q4 = lane >> 4;
  unsigned char* ws = p.ws;
  const float2* rope = opq((const float2*)(ws + WS_ROPE));
  const LAS float* rs = (const LAS float*)(lds + XLDS);
  bf16_t* Q = (bf16_t*)(ws + B_Q); bf16_t* KB = (bf16_t*)(ws + B_K); bf16_t* VT = (bf16_t*)(ws + B_VT);
  const int mt = pan;
  if (pan < 256) {
    const bf16_t* CQ = (const bf16_t*)(ws + B_CQ); const bf16_t* W = (const bf16_t*)(ws + WS_WUQ);
    rstd_rows(CQ + (size_t)mt * 128 * 256, 256, 256, QSCALE, lds);
#pragma unroll 1
    for (int nt = 0; nt < 3; ++nt) {
      StrideLoader al, bl;
      al.p0 = CQ + (size_t)(mt * 128 + ROW8(0)) * 256 + CO8; al.ld64 = 64 * 256;
      bl.p0 = W + (size_t)(nt * 256 + ROW8(0)) * 256 + CO8; bl.ld64 = 64 * 256;
      f32x4 acc[4][4]; zero_acc(acc);
      gemm_core<true, 4>(acc, al, bl, 4, lds);
      ep_banded<256>(lds, PutPlain<4>{acc}, [&](int rl, int col, f32x4 v) {
        const int row = mt * 128 + rl, b = row >> 12, tokb = row & 4095;
        const int fc = nt * 256 + (col & ~15), head = fc / 96, d0 = fc - head * 96, ci = col & 15;
        v = v * rs[rl];
        if (d0 >= 64) {
          const int pos = (d0 >= 80) ? (tokb & 63) : (tokb >> 6);
          const float2 c0 = rope[pos * 8 + (ci >> 1)], c1 = rope[pos * 8 + (ci >> 1) + 1];
          f32x4 o;
          o[0] = v[0] * c0.x - v[1] * c0.y; o[1] = v[1] * c0.x + v[0] * c0.y;
          o[2] = v[2] * c1.x - v[3] * c1.y; o[3] = v[3] * c1.x + v[2] * c1.y;
          v = o;
        }
        *(uint2*)(Q + ((size_t)(b * NH + head) * SEQ + tokb) * DQK + d0 + ci) = pack4(v);
      });
    }
  }
  {
    const bf16_t* CKV = (const bf16_t*)(ws + B_CKV); const bf16_t* W = (const bf16_t*)(ws + WS_WUKV);
    rstd_rows(CKV + (size_t)mt * 128 * 128, 128, 128, 1.0f, lds);
#pragma unroll 1
    for (int nt = 0; nt < 4; ++nt) {
      StrideLoader al, bl;
      al.p0 = CKV + (size_t)(mt * 128 + ROW8(0)) * 128 + CO8; al.ld64 = 64 * 128;
      bl.p0 = W + (size_t)(nt * 256 + ROW8(0)) * 128 + CO8; bl.ld64 = 64 * 128;
      f32x4 acc[4][4]; zero_acc(acc);
      if (nt < 2) {
        gemm_core<true, 4>(acc, al, bl, 2, lds);
        ep_banded<256>(lds, PutPlain<4>{acc}, [&](int rl, int colt, f32x4 v) {
          const int r = mt * 128 + rl;
          int b, key; if (r < T) { b = r >> 12; key = CL + (r & 4095); } else { const int rc = r - T; b = rc >> 8; key = rc & 255; }
          const int col = nt * 256 + colt, h = col >> 6, d = col & 63;
          *(uint2*)(KB + ((size_t)(b * NH + h) * NKEY + key) * DQK + d) = pack4(v * rs[rl]);
        });
      } else {
        gemm_core<false, 4>(acc, al, bl, 2, lds);
#pragma unroll
        for (int mi = 0; mi < 4; ++mi)
#pragma unroll
          for (int nj = 0; nj < 4; ++nj)
            *(LAS f32x4*)(lds + (wn * 64 + nj * 16 + (lane & 15)) * EPT_PITCH + (wm * 64 + mi * 16 + q4 * 4) * 4) = acc[mi][nj];
        __syncthreads();
#pragma unroll 4
        for (int idx = tid; idx < 256 * 32; idx += NTHREADS) {
          const int cr = idx >> 5, t4 = (idx & 31) * 4;
          f32x4 v = *(const LAS f32x4*)(lds + cr * EPT_PITCH + t4 * 4);
          v[0] *= rs[t4]; v[1] *= rs[t4 + 1]; v[2] *= rs[t4 + 2]; v[3] *= rs[t4 + 3];
          const int r = mt * 128 + t4;
          int b, key; if (r < T) { b = r >> 12; key = CL + (r & 4095); } else { const int rc = r - T; b = rc >> 8; key = rc & 255; }
          const int n = (nt - 2) * 256 + cr, h = n >> 6, dv = n & 63;
          *(uint2*)(VT + ((size_t)(b * NH + h) * DV + dv) * NKEY + key) = pack4(v);
        }
        __syncthreads();
      }
    }
  }
  {
    const bf16_t* KR = (const bf16_t*)(ws + B_KR);
#pragma unroll
    for (int i = 0; i < 2; ++i) {
      const int idx = pan * 1024 + tid + NTHREADS * i;
      const int r = idx >> 3, pc = idx & 7;
      const uint2 u = *(const uint2*)(KR + (size_t)r * 32 + pc * 4);
      float v0 = bflo(u.x), v1 = bfhi(u.x), v2 = bflo(u.y), v3 = bfhi(u.y);
      int b, key;
      if (r < T) {
        b = r >> 12; const int tokb = r & 4095; key = CL + tokb;
        const int pos = (pc >= 4) ? (tokb & 63) : (tokb >> 6), jb = (pc & 3) * 2;
        const float2 c0 = rope[pos * 8 + jb], c1 = rope[pos * 8 + jb + 1];
        const float o0 = v0 * c0.x - v1 * c0.y, o1 = v1 * c0.x + v0 * c0.y, o2 = v2 * c1.x - v3 * c1.y, o3 = v3 * c1.x + v2 * c1.y;
        v0 = o0; v1 = o1; v2 = o2; v3 = o3;
      } else { const int rc = r - T; b = rc >> 8; key = rc & 255; }
      uint2 o; o.x = pk2(v0, v1); o.y = pk2(v2, v3);
#pragma unroll
      for (int h = 0; h < NH; ++h) *(uint2*)(KB + ((size_t)(b * NH + h) * NKEY + key) * DQK + 64 + pc * 4) = o;
    }
  }
}

__device__ __forceinline__ void conv_units(const Params& p, lptr lds, int vb, int nblocks) {
  const int tid = threadIdx.x, lane = tid & 63, wave = tid >> 6;
  unsigned char* ws = p.ws;
  {
    const bf16_t* GLU = (const bf16_t*)(ws + B_GLU); bf16_t* OCAT = (bf16_t*)(ws + B_OCAT);
    const float* cw = p.in[I_EVCW]; const float* cb = p.in[I_EVCB]; const float* lw = p.in[I_EVLNW]; const float* lb = p.in[I_EVLNB];
    const int cp = tid & 255, th = tid >> 8;
    const lptr outl = lds + 65536;
    for (int u = vb; u < NB * 128; u += nblocks) {
      const int b = u >> 7, t0 = (u & 127) * 32;
      __syncthreads();
      for (int c = tid; c < 62 * 64; c += NTHREADS) {
        const int ti = c >> 6, ch = c & 63, tok = t0 - 15 + ti;
        uint4 v = make_uint4(0, 0, 0, 0);
        if (tok >= 0 && tok < SEQ) v = *(const uint4*)(GLU + ((size_t)(b * SEQ + tok)) * 512 + ch * 8);
        lds_w16(lds + ti * 1024 + ch * 16, v);
      }
      __syncthreads();
      float a0[16], a1[16];
#pragma unroll
      for (int k = 0; k < 16; ++k) { a0[k] = 0.f; a1[k] = 0.f; }
      for (int tap = 0; tap < 31; ++tap) {
        const float2 w = *(const float2*)(cw + tap * 512 + 2 * cp);
#pragma unroll
        for (int k = 0; k < 16; ++k) {
          const unsigned x = *(const LAS unsigned*)(lds + (th * 16 + k + tap) * 1024 + cp * 4);
          a0[k] += w.x * bflo(x); a1[k] += w.y * bfhi(x);
        }
      }
      const float2 bias = *(const float2*)(cb + 2 * cp);
#pragma unroll
      for (int k = 0; k < 16; ++k) *(LAS f32x2*)(outl + ((th * 16 + k) * 512 + 2 * cp) * 4) = (f32x2){a0[k] + bias.x, a1[k] + bias.y};
      __syncthreads();
#pragma unroll 1
      for (int q = 0; q < 4; ++q) {
        const int tk = wave * 4 + q;
        const f32x4 x0 = *(const LAS f32x4*)(outl + (tk * 512 + lane * 8) * 4), x1 = *(const LAS f32x4*)(outl + (tk * 512 + lane * 8 + 4) * 4);
        float s = (x0.x + x0.y) + (x0.z + x0.w) + (x1.x + x1.y) + (x1.z + x1.w);
        s = wave_sum(s);
        const float mean = s * (1.0f / 512.0f);
        const float d[8] = {x0.x - mean, x0.y - mean, x0.z - mean, x0.w - mean, x1.x - mean, x1.y - mean, x1.z - mean, x1.w - mean};
        float ss = 0.f;
#pragma unroll
        for (int e = 0; e < 8; ++e) ss += d[e] * d[e];
        ss = wave_sum(ss);
        const float rstd = 1.0f / sqrtf(ss * (1.0f / 512.0f) + EPS);
        const float4 w0 = *(const float4*)(lw + lane * 8), w1 = *(const float4*)(lw + lane * 8 + 4), b0 = *(const float4*)(lb + lane * 8), b1 = *(const float4*)(lb + lane * 8 + 4);
        const float wv[8] = {w0.x, w0.y, w0.z, w0.w, w1.x, w1.y, w1.z, w1.w}, bv[8] = {b0.x, b0.y, b0.z, b0.w, b1.x, b1.y, b1.z, b1.w};
        float y[8];
#pragma unroll
        for (int e = 0; e < 8; ++e) { const float z = d[e] * rstd * wv[e] + bv[e]; y[e] = z * sigmoid_fast(z); }
        uint4 o; o.x = pk2(y[0], y[1]); o.y = pk2(y[2], y[3]); o.z = pk2(y[4], y[5]); o.w = pk2(y[6], y[7]);
        *(uint4*)(OCAT + ((size_t)(b * SEQ + t0 + tk)) * D + lane * 8) = o;
      }
    }
    __syncthreads();
  }
}

__device__ __forceinline__ void phase4(const Params& p, lptr lds, int vb, int nblocks) {
  const int tid = threadIdx.x, lane = tid & 63, wave = __builtin_amdgcn_readfirstlane(tid >> 6), q4 = lane >> 4, li = lane & 15;
  const bf16_t* Q = (const bf16_t*)(p.ws + B_Q); const bf16_t* KB = (const bf16_t*)(p.ws + B_K); const bf16_t* VT = (const bf16_t*)(p.ws + B_VT);
  bf16_t* OCAT = (bf16_t*)(p.ws + B_OCAT);
  constexpr int STG = 20480, NKT = NKEY / 64, NQF = 4, QW = 16 * NQF, QU = 8 * QW;
  int koff[4], voff[2];
#pragma unroll
  for (int f = 0; f < 4; ++f) {
    const int row = 32 * (f >> 1) + 8 * (li >> 2) + 4 * (f & 1) + (li & 3);
    koff[f] = row * 192 + ((q4 ^ ((row >> 2) & 3)) << 4);
  }
#pragma unroll
  for (int g = 0; g < 2; ++g) voff[g] = 12288 + li * 128 + ((((4 * g + q4) ^ (lane & 7))) << 4);
  int soff[3]; bool isk[3];
#pragma unroll
  for (int i = 0; i < 3; ++i) {
    const int pi = wave + 8 * i;
    if (pi < 12) { const int P = pi * 1024 + lane * 16, row = P / 192, rem = P - row * 192, ks = rem >> 6, pq = (rem & 63) >> 4; soff[i] = row * DQK + ks * 32 + ((pq ^ ((row >> 2) & 3)) << 3); isk[i] = true; }
    else { const int P = (pi - 12) * 1024 + lane * 16, dv = P >> 7, pc = (P & 127) >> 4; soff[i] = dv * NKEY + ((pc ^ (dv & 7)) << 3); isk[i] = false; }
  }
  const bool three = wave < 4;
  constexpr int UPB = SEQ / QU;
  for (int unit = vb; unit < NB * NH * UPB; unit += nblocks) {
    const int qb = unit % UPB, bh = unit / UPB;
    const bf16_t* Qp = Q + ((size_t)bh * SEQ + qb * QU + wave * QW) * DQK;
    const bf16_t* Kp = KB + (size_t)bh * NKEY * DQK;
    const bf16_t* Vp = VT + (size_t)bh * DV * NKEY;
    bf16x8 qf[NQF][3];
#pragma unroll
    for (int f2 = 0; f2 < NQF; ++f2)
#pragma unroll
      for (int ks = 0; ks < 3; ++ks) qf[f2][ks] = *(const bf16x8*)(Qp + (f2 * 16 + li) * DQK + ks * 32 + q4 * 8);
    WAIT_VM(0);
#define ATT_ISSUE(kt_, stage_) do { \
      _Pragma("unroll") for (int i_ = 0; i_ < 3; ++i_) { if (i_ < 2 || three) { \
        const bf16_t* g_ = isk[i_] ? Kp + (size_t)(kt_) * 64 * DQK + soff[i_] : Vp + (kt_) * 64 + soff[i_]; \
        glds16(g_, lds + (stage_) * STG + (wave + 8 * i_) * 1024); } } } while (0)
#pragma unroll
    for (int t = 0; t < 3; ++t) ATT_ISSUE(t, t);
    f32x4 o[4][NQF];
    float mrun[NQF], lrun[NQF];
#pragma unroll
    for (int f2 = 0; f2 < NQF; ++f2) { mrun[f2] = -1000.f; lrun[f2] = 0.f;
#pragma unroll
      for (int a = 0; a < 4; ++a) o[a][f2] = (f32x4){0.f, 0.f, 0.f, 0.f}; }
    int st = 0;
    for (int kt = 0; kt < NKT; ++kt) {
      if (kt + 2 < NKT) { if (three) WAIT_VM(6); else WAIT_VM(4); }
      else if (kt + 1 < NKT) { if (three) WAIT_VM(3); else WAIT_VM(2); }
      else WAIT_VM(0);
      asm volatile("s_waitcnt lgkmcnt(0)" ::: "memory");
      __builtin_amdgcn_s_barrier();
      asm volatile("" ::: "memory");
      if (kt + 3 < NKT) ATT_ISSUE(kt + 3, (st + 3) & 3);
      const lptr cur = lds + st * STG;
#pragma unroll
      for (int hh = 0; hh < NQF / 2; ++hh) {
        f32x4 s[2][4];
#pragma unroll
        for (int f2 = 0; f2 < 2; ++f2)
#pragma unroll
          for (int f = 0; f < 4; ++f) { const float nm = -mrun[2 * hh + f2]; s[f2][f] = (f32x4){nm, nm, nm, nm}; }
#pragma unroll
        for (int ks = 0; ks < 3; ++ks)
#pragma unroll
          for (int f = 0; f < 4; ++f) {
            const bf16x8 kf = lds_r16(cur + koff[f] + ks * 64);
            s[0][f] = __builtin_amdgcn_mfma_f32_16x16x32_bf16(kf, qf[2 * hh][ks], s[0][f], 0, 0, 0);
            s[1][f] = __builtin_amdgcn_mfma_f32_16x16x32_bf16(kf, qf[2 * hh + 1][ks], s[1][f], 0, 0, 0);
          }
        bf16x8 pf[2][2];
        float mx[2];
#pragma unroll
        for (int f2 = 0; f2 < 2; ++f2) {
          float m_ = s[f2][0][0];
#pragma unroll
          for (int f = 0; f < 4; ++f)
#pragma unroll
            for (int r = 0; r < 4; ++r) m_ = fmaxf(m_, s[f2][f][r]);
          mx[f2] = m_;
        }
        if (!__all(fmaxf(mx[0], mx[1]) <= 6.0f)) {
#pragma unroll
          for (int f2 = 0; f2 < 2; ++f2) {
            const int q = 2 * hh + f2;
            float m_ = mx[f2];
            m_ = fmaxf(m_, __shfl_xor(m_, 16)); m_ = fmaxf(m_, __shfl_xor(m_, 32));
            const float d = fmaxf(m_, 0.f);
            const float alpha = __builtin_amdgcn_exp2f(-d);
            mrun[q] += d; lrun[q] *= alpha;
#pragma unroll
            for (int a = 0; a < 4; ++a) o[a][q] = o[a][q] * alpha;
#pragma unroll
            for (int f = 0; f < 4; ++f) s[f2][f] = s[f2][f] - d;
          }
        }
#pragma unroll
        for (int f2 = 0; f2 < 2; ++f2) {
          const int q = 2 * hh + f2;
          float rsum = 0.f;
#pragma unroll
          for (int f = 0; f < 4; ++f)
#pragma unroll
            for (int r = 0; r < 4; ++r) { const float e = __builtin_amdgcn_exp2f(s[f2][f][r]); s[f2][f][r] = e; rsum += e; }
          lrun[q] += rsum;
#pragma unroll
          for (int g = 0; g < 2; ++g) {
            union { bf16x8 v; unsigned u[4]; } cv;
            cv.u[0] = pk2(s[f2][2 * g][0], s[f2][2 * g][1]); cv.u[1] = pk2(s[f2][2 * g][2], s[f2][2 * g][3]);
            cv.u[2] = pk2(s[f2][2 * g + 1][0], s[f2][2 * g + 1][1]); cv.u[3] = pk2(s[f2][2 * g + 1][2], s[f2][2 * g + 1][3]);
            pf[f2][g] = cv.v;
          }
        }
#pragma unroll
        for (int g = 0; g < 2; ++g)
#pragma unroll
          for (int a = 0; a < 4; ++a) {
            const bf16x8 vf = lds_r16(cur + voff[g] + a * 2048);
            o[a][2 * hh] = __builtin_amdgcn_mfma_f32_16x16x32_bf16(vf, pf[0][g], o[a][2 * hh], 0, 0, 0);
            o[a][2 * hh + 1] = __builtin_amdgcn_mfma_f32_16x16x32_bf16(vf, pf[1][g], o[a][2 * hh + 1], 0, 0, 0);
          }
        __builtin_amdgcn_sched_barrier(0);
      }
      st = (st + 1) & 3;
    }
    __syncthreads();
    const int b = bh >> 3, h = bh & 7;
#pragma unroll
    for (int f2 = 0; f2 < NQF; ++f2) {
      float lt = lrun[f2]; lt += __shfl_xor(lt, 16); lt += __shfl_xor(lt, 32);
      const float inv = 1.0f / lt;
      const size_t row = (size_t)b * SEQ + qb * QU + wave * QW + f2 * 16 + li;
      store_row4(OCAT + row * D + 512 + h * 64, o[0][f2] * inv, o[1][f2] * inv, o[2][f2] * inv, o[3][f2] * inv, q4);
    }
  }
#undef ATT_ISSUE
}

__device__ __forceinline__ void outproj_panel(const Params& p, int L, lptr lds, int mt) {
  const int tid_ = opaque((int)threadIdx.x);
  const bf16_t* A = (const bf16_t*)(p.ws + (L == 0 ? B_OCAT : B_S)); const bf16_t* W = (const bf16_t*)(p.ws + (L == 0 ? WS_WOUT0 : WS_WOUT1));
  const float* mod = (const float*)(p.ws + WS_MOD) + (size_t)L * 9 * 6144;
  StrideLoader al, bl;
  al.p0 = A + (size_t)(mt * 128 + ROW8(0)) * D + CO8; al.ld64 = 64 * D;
  bl.p0 = W + (size_t)ROW8(0) * D + CO8; bl.ld64 = 64 * D;
  int st = 0;
  gemm_pre_at<4>(al, bl, st, lds);
#pragma unroll 1
  for (int nt = 0; nt < 4; ++nt) {
    f32x4 acc[4][4]; zero_acc(acc);
    StrideLoader bln = bl; bln.p0 += (size_t)256 * D;
    gemm_chain<true, 4>(acc, al, bl, 16, lds, st, nt < 3, al, bln);
    bl = bln;
    const int te = opaque(tid_), le = te & 63, we = te >> 6, wm = we >> 2, wn = we & 3, q4 = le >> 4;
#pragma unroll
    for (int mi = 0; mi < 4; ++mi) {
      const int row = mt * 128 + wm * 64 + mi * 16 + (le & 15), b = (mt * 128) >> 12;
      bf16_t* hrow = HROW(row) + nt * 256 + wn * 64;
      f32x4 xv[4];
      if (L == 0) {
#pragma unroll
        for (int n4 = 0; n4 < 4; ++n4) xv[n4] = *(const f32x4*)(p.in[I_X] + (size_t)row * D + nt * 256 + wn * 64 + n4 * 16 + q4 * 4);
      } else {
        const u32x4 t0 = ((const u32x4*)(hrow + q4 * 16))[0], t1 = ((const u32x4*)(hrow + q4 * 16))[1];
        uint2 ha = make_uint2(t0[0], t0[1]), hb = make_uint2(t0[2], t0[3]), hc = make_uint2(t1[0], t1[1]), hd = make_uint2(t1[2], t1[3]);
        tr4x4(ha.x, hb.x, hc.x, hd.x); tr4x4(ha.y, hb.y, hc.y, hd.y);
        xv[0] = unpack4(ha); xv[1] = unpack4(hb); xv[2] = unpack4(hc); xv[3] = unpack4(hd);
      }
#pragma unroll
      for (int n4 = 0; n4 < 4; ++n4) {
        const f32x4 g1 = *(const f32x4*)(mod + (size_t)b * 6144 + 2048 + nt * 256 + wn * 64 + n4 * 16 + q4 * 4);
        xv[n4] = xv[n4] + g1 * acc[mi][n4];
      }
      store_row4(hrow, xv[0], xv[1], xv[2], xv[3], q4);
    }
  }
  __syncthreads();
}

__device__ __forceinline__ void expert_unit(const Params& p, int L, const bf16_t* Wgu, const bf16_t* Wd, const int* list, int nvalid, int m0, lptr lds, int dry = 0) {
  const int tid = opaque((int)threadIdx.x), tid_ = tid;
  const bf16_t* AF = (const bf16_t*)(p.ws + WS_AF8);
  unsigned char* ACT = p.ws + WS_ACT + (size_t)blockIdx.x * 128 * 256;
  LAS int* info = (LAS int*)(lds + XLDS + 512);
  LAS float* wrow = (LAS float*)(lds + XLDS);
  __syncthreads();
  if (tid < 128) {
    const int inf = list ? ((tid < nvalid) ? list[tid] : -1) : ((m0 + tid) * 8 + 7);
    info[tid] = inf;
    wrow[tid] = (inf >= 0 && (inf & 7) != 7) ? ((const float*)(p.ws + WS_WTS))[inf] : 1.0f;
  }
  __syncthreads();
  {
    RowLoader2 al; StrideLoader bl;
#pragma unroll
    for (int i = 0; i < 2; ++i) { const int inf = info[ROW8(i)]; al.p[i] = AF + (size_t)((inf >= 0) ? (inf >> 3) : 0) * 512 + CO8; }
    bl.p0 = Wgu + (size_t)ROW8(0) * 512 + CO8; bl.ld64 = 64 * 512;
    int st = 0;
    gemm_pre_at<4>(al, bl, st, lds);
#pragma unroll 1
    for (int nt = 0; nt < 2; ++nt) {
      f32x4 acc[4][4]; zero_acc(acc);
      StrideLoader bln = bl; bln.p0 += (size_t)256 * 512;
      gemm_chain8<4>(acc, al, bl, 8, lds, st, nt == 0, al, bln);
      bl = bln;
      {
        const int te = opaque(tid), le = te & 63, we = te >> 6, wm = we >> 2, wn = we & 3, q4 = le >> 4;
#pragma unroll
        for (int mi = 0; mi < 4; ++mi)
          {
            unsigned x[2];
#pragma unroll
            for (int j2 = 0; j2 < 2; ++j2) {
              const f32x4 g = acc[mi][2 * j2], u = acc[mi][2 * j2 + 1]; f32x4 v;
#pragma unroll
              for (int r = 0; r < 4; ++r) { const float gg = g[r] * F8_INV; v[r] = gg * sigmoid_fast(gg) * u[r] * (F8_INV * F8_SACT); }
              x[j2] = pack4_fp8c(v);
            }
            { auto r = __builtin_amdgcn_permlane16_swap(x[0], x[1], false, false); x[0] = r[0]; x[1] = r[1]; }
            *(uint2*)(ACT + (size_t)(wm * 64 + mi * 16 + (le & 15)) * 256 + nt * 128 + wn * 32 + (q4 & 1) * 16 + (q4 >> 1) * 8) = make_uint2(x[0], x[1]);
          }
      }
    }
  }
  asm volatile("s_waitcnt vmcnt(0)" ::: "memory");
  __syncthreads();
  const bool shared_u = (list == nullptr);
  unsigned char* CONTRIB = p.ws + B_CONTRIB; unsigned char* SHC = p.ws + B_SHC;
  {
    StrideLoader al, bl;
    al.p0 = (const bf16_t*)ACT + (size_t)ROW8(0) * 128 + CO8; al.ld64 = 64 * 128;
    bl.p0 = Wd + (size_t)ROW8(0) * 128 + CO8; bl.ld64 = 64 * 128;
    int st = 0;
    gemm_pre_at<4>(al, bl, st, lds);
#pragma unroll 1
    for (int nt = 0; nt < 4; ++nt) {
      f32x4 acc[4][4]; zero_acc(acc);
      StrideLoader bln = bl; bln.p0 += (size_t)256 * 128;
      gemm_chain8<4>(acc, al, bl, 2, lds, st, nt < 3, al, bln);
      bl = bln;
      {
        const int te = opaque(tid), le = te & 63, we = te >> 6, wm = we >> 2, wn = we & 3, q4 = le >> 4;
#pragma unroll
        for (int mi = 0; mi < 4; ++mi) {
          const int rl = wm * 64 + mi * 16 + (le & 15);
          const int inf = info[rl];
          const int tok = inf >> 3, k = inf & 7;
          const float w = wrow[rl] * F8_INV;
          {
            unsigned x0 = pack4_fp8c(acc[mi][0] * w), x1 = pack4_fp8c(acc[mi][1] * w), x2 = pack4_fp8c(acc[mi][2] * w), x3 = pack4_fp8c(acc[mi][3] * w);
            tr4x4(x0, x1, x2, x3);
            unsigned char* dstrow = shared_u ? SHC + (size_t)tok * D : CONTRIB + ((size_t)tok * 6 + k) * D;
            if (inf >= 0 && !dry) *(u32x4*)(dstrow + nt * 256 + wn * 64 + q4 * 16) = (u32x4){x0, x1, x2, x3};
          }
        }
      }
    }
  }
  __syncthreads();
}

__device__ __forceinline__ void router_gemm(f32x4 (&acc)[4][2], const bf16_t* ph, const bf16_t* pl, const bf16_t* pb, lptr lds) {
  constexpr int STG = 32768, B_OFF = 16384, NKT = 32;
  const int tid = opaque((int)threadIdx.x), lane = tid & 63, wave = __builtin_amdgcn_readfirstlane(tid >> 6), wm = wave >> 2, wn = wave & 3;
  int aoff[2], boff[2];
#pragma unroll
  for (int ks = 0; ks < 2; ++ks) {
    const int sw = (((ks * 4 + (lane >> 4)) ^ (lane & 7)) << 4);
    aoff[ks] = (wm * 64 + (lane & 15)) * 128 + sw;
    boff[ks] = B_OFF + (wn * 32 + (lane & 15)) * 128 + sw;
  }
  const int wbase = wave * 1024;
#define RG_ISSUE(t_) do { const int t__ = (t_); const lptr sb_ = lds + (t__ & 3) * STG + wbase; \
    const bf16_t* ap_ = ((t__ < 16) ? ph : pl) + (t__ & 15) * 64; const bf16_t* bp_ = pb + t__ * 64; \
    glds16(ap_, sb_); glds16(ap_ + (size_t)64 * D, sb_ + 8192); glds16(bp_, sb_ + B_OFF); glds16(bp_ + (size_t)64 * 2048, sb_ + B_OFF + 8192); } while (0)
  RG_ISSUE(0); RG_ISSUE(1); RG_ISSUE(2);
#pragma unroll 1
  for (int kt = 0; kt < NKT; ++kt) {
    if (kt + 2 < NKT) WAIT_VM(8); else if (kt + 1 < NKT) WAIT_VM(4); else WAIT_VM(0);
    asm volatile("s_waitcnt lgkmcnt(0)" ::: "memory");
    __builtin_amdgcn_s_barrier();
    asm volatile("" ::: "memory");
    const lptr base = lds + (kt & 3) * STG;
#pragma unroll
    for (int ks = 0; ks < 2; ++ks) {
      bf16x8 af[4], bfr[2];
#pragma unroll
      for (int i = 0; i < 4; ++i) af[i] = lds_r16(base + aoff[ks] + i * 2048);
#pragma unroll
      for (int j = 0; j < 2; ++j) bfr[j] = lds_r16(base + boff[ks] + j * 2048);
      if (ks == 1 && kt + 3 < NKT) RG_ISSUE(kt + 3);
#pragma unroll
      for (int i = 0; i < 4; ++i)
#pragma unroll
        for (int j = 0; j < 2; ++j) acc[i][j] = __builtin_amdgcn_mfma_f32_16x16x32_bf16(bfr[j], af[i], acc[i][j], 0, 0, 0);
    }
  }
#undef RG_ISSUE
  __syncthreads();
}

struct RouterA {
  static constexpr bool DIRECT = true;
  typedef uint4 Raw; const bf16_t* ph; const bf16_t* pl;
  __device__ __forceinline__ const bf16_t* gp(int i, int kt) const { return ((kt >= 16 && kt < 32) ? pl + (kt - 16) * 64 : ph + (kt & 15) * 64) + (size_t)i * 64 * D; }
  __device__ __forceinline__ void pre(int) {}
  __device__ __forceinline__ Raw ld(int, int) const { return make_uint4(0, 0, 0, 0); }
  __device__ __forceinline__ uint4 cvt(const Raw& r, int) const { return r; }
};

__device__ __forceinline__ void router_tile(const Params& p, int L, lptr lds, int mt) {
  const int tid_ = opaque((int)threadIdx.x);
  const bool dry = false;
  const int tid = tid_, lane = tid & 63, wave = tid >> 6, wm = wave >> 2, wn = wave & 3, q4 = lane >> 4;
  unsigned char* ws = p.ws;
  const bf16_t* AF = (const bf16_t*)(ws + WS_AF); const bf16_t* FLO = (const bf16_t*)(ws + B_FLO);
  const bf16_t* WR = (const bf16_t*)(ws + WS_WR) + (size_t)L * 128 * 2048;
  int* counts = (int*)(ws + WS_CNT) + L * NE; int* lists = (int*)(ws + WS_LISTS); float* wts = (float*)(ws + WS_WTS);
  const float* rbias = opq(p.in[I_RB] + L * NE);
  {
    {
      f32x4 acc[4][2]; zero_acc(acc);
      router_gemm(acc, AF + (size_t)(mt * 128 + ROW8(0)) * D + CO8, FLO + (size_t)(mt * 128 + ROW8(0)) * D + CO8, WR + (size_t)ROW8(0) * 2048 + CO8, lds);
      LAS float* lg = (LAS float*)lds;
      LAS float* sg = (LAS float*)(lds + 33280);
      LAS int* lcnt = (LAS int*)(lds + XLDS + 1280);
#pragma unroll
      for (int mi = 0; mi < 4; ++mi)
#pragma unroll
        for (int r = 0; r < 4; ++r) lg[(wm * 64 + mi * 16 + (lane & 15)) * 65 + wn * 16 + q4 * 4 + r] = acc[mi][0][r] + acc[mi][1][r];
      if (tid < 64) lcnt[tid] = 0;
      __syncthreads();
      int eidx[TOPK]; int lslot[TOPK]; float wk[TOPK];
      const int tokl = tid >> 2, part = tid & 3;
      {
        const LAS float* lr = lg + tokl * 65 + part * 16;
        float sc[16], v[16];
#pragma unroll
        for (int j = 0; j < 16; ++j) { sc[j] = sigmoidf_(lr[j]); v[j] = sc[j] + rbias[part * 16 + j]; }
        float gs[2];
#pragma unroll
        for (int g = 0; g < 2; ++g) {
          float m1 = -INFINITY, m2 = -INFINITY;
#pragma unroll
          for (int j = 0; j < 8; ++j) { const float x = v[g * 8 + j]; if (x > m1) { m2 = m1; m1 = x; } else if (x > m2) m2 = x; }
          gs[g] = m1 + m2;
        }
        int rank0 = (gs[1] > gs[0]) ? 1 : 0, rank1 = (gs[0] >= gs[1]) ? 1 : 0;
#pragma unroll
        for (int m = 1; m < 4; ++m) {
          const float o0 = __shfl_xor(gs[0], m), o1 = __shfl_xor(gs[1], m);
          const bool lower = (part ^ m) < part;
          rank0 += ((o0 > gs[0]) || (o0 == gs[0] && lower)) ? 1 : 0; rank0 += ((o1 > gs[0]) || (o1 == gs[0] && lower)) ? 1 : 0;
          rank1 += ((o0 > gs[1]) || (o0 == gs[1] && lower)) ? 1 : 0; rank1 += ((o1 > gs[1]) || (o1 == gs[1] && lower)) ? 1 : 0;
        }
#pragma unroll
        for (int j = 0; j < 16; ++j) if ((j < 8 ? rank0 : rank1) >= 4) v[j] = -INFINITY;
        float ssum = 0.f;
#pragma unroll
        for (int k = 0; k < TOPK; ++k) {
          float best = v[0], bsc = sc[0]; int bi = 0;
#pragma unroll
          for (int j = 1; j < 16; ++j) if (v[j] > best) { best = v[j]; bsc = sc[j]; bi = j; }
          int gi = part * 16 + bi;
#pragma unroll
          for (int m = 1; m < 4; m <<= 1) {
            const float ob = __shfl_xor(best, m), os = __shfl_xor(bsc, m); const int oi = __shfl_xor(gi, m);
            if (ob > best || (ob == best && oi < gi)) { best = ob; bsc = os; gi = oi; }
          }
          eidx[k] = gi; wk[k] = bsc; ssum += bsc;
#pragma unroll
          for (int j = 0; j < 16; ++j) if (part * 16 + j == gi) v[j] = -INFINITY;
        }
        const float inv = 2.5f / ssum;
#pragma unroll
        for (int k = 0; k < TOPK; ++k) { wk[k] *= inv; lslot[k] = ((k & 3) == part && !dry) ? atomicAdd((int*)(lcnt + eidx[k]), 1) : 0; }
      }
      __syncthreads();
      if (tid < 64 && !dry) { const int c = lcnt[tid]; lcnt[64 + tid] = c ? atomicAdd(&counts[tid], c) : 0; }
      __syncthreads();
      if (!dry) {
        const int tok = mt * 128 + tokl;
#pragma unroll
        for (int k = 0; k < TOPK; ++k) if ((k & 3) == part) {
          lists[(size_t)eidx[k] * T + lcnt[64 + eidx[k]] + lslot[k]] = tok * 8 + k;
          wts[tok * 8 + k] = wk[k];
        }
      }
      __syncthreads();
    }
  }
}

__device__ __forceinline__ void shared_unit(const Params& p, int L, lptr lds, int mt) {
  const bf16_t* wg = (const bf16_t*)(p.ws + WS_WSGU + (size_t)L * 512 * 1024); const bf16_t* wd = (const bf16_t*)(p.ws + WS_WSD + (size_t)L * 1024 * 256); const int* nolist = nullptr;
  asm volatile("" : "+s"(wg), "+s"(wd), "+s"(nolist));
  expert_unit(p, L, wg, wd, nolist, 128, mt * 128, lds, 0);
}

__device__ __forceinline__ void phase_experts(const Params& p, int L, lptr lds, int vb, int nblocks, int dry = 0) {
  const int tid = threadIdx.x;
  int* counts = (int*)(p.ws + WS_CNT) + L * NE; const int* lists = (const int*)(p.ws + WS_LISTS);
  LAS int* cnt = (LAS int*)(lds + XLDS + 1024);
  __syncthreads();
  if (tid < 64) cnt[tid] = __hip_atomic_load(&counts[tid], __ATOMIC_RELAXED, __HIP_MEMORY_SCOPE_AGENT);
  __syncthreads();
  int e = 0, base = 0;
  for (int u = vb;; u += nblocks) {
    while (e < NE && u >= base + ((cnt[e] + 127) >> 7)) { base += (cnt[e] + 127) >> 7; ++e; }
    if (e >= NE) break;
    const int rb = u - base, c = cnt[e];
    int nv = c - rb * 128; if (nv > 128) nv = 128;
    expert_unit(p, L, (const bf16_t*)(p.ws + WS_WEGU + (size_t)e * 512 * 1024), (const bf16_t*)(p.ws + WS_WED + (size_t)e * 1024 * 256),
                      lists + (size_t)e * T + rb * 128, nv, 0, lds, dry);
  }
}

__device__ __forceinline__ void combine_panel(const Params& p, int L, int mt) {
  const int lane = threadIdx.x & 63, wave = threadIdx.x >> 6;
  const float* mod = opq((const float*)(p.ws + WS_MOD)); const float* nmix1 = opq(p.in[I_NMIX] + D); const float* fnw = opq(p.in[I_FNW]);
  const unsigned char* CONTRIB = p.ws + B_CONTRIB;
  bf16_t* AF = (bf16_t*)(p.ws + WS_AF);
#pragma unroll 2
  for (int r = mt * 128 + wave; r < mt * 128 + 128; r += NWAVES) {
    const int b = r >> 12;
    float4 v[4];
#pragma unroll
    for (int j = 0; j < 4; ++j) {
      const int c = lane + 64 * j;
      const f32x4 ht = unpack4(((const uint2*)HROW(r))[c]); float4 h = make_float4(ht[0], ht[1], ht[2], ht[3]);
      float s0 = 0.f, s1 = 0.f, s2 = 0.f, s3 = 0.f;
#pragma unroll
      for (int k = 0; k < 6; ++k) {
        const int u = (int)((const unsigned*)(CONTRIB + ((size_t)r * 6 + k) * D))[c];
        const f32x2 lo = __builtin_amdgcn_cvt_pk_f32_fp8(u, false), hi = __builtin_amdgcn_cvt_pk_f32_fp8(u, true);
        s0 += lo[0]; s1 += lo[1]; s2 += hi[0]; s3 += hi[1];
      }
      {
        const int u = (int)((const unsigned*)(p.ws + B_SHC + (size_t)r * D))[c];
        const f32x2 lo = __builtin_amdgcn_cvt_pk_f32_fp8(u, false), hi = __builtin_amdgcn_cvt_pk_f32_fp8(u, true);
        s0 += lo[0]; s1 += lo[1]; s2 += hi[0]; s3 += hi[1];
      }
      const float4 g2 = ((const float4*)(mod + (size_t)(L * 9 + b) * 6144 + 5120))[c];
      h.x += g2.x * s0; h.y += g2.y * s1; h.z += g2.z * s2; h.w += g2.w * s3;
      v[j] = h;
    }
    if (L == 0) {
#pragma unroll
      for (int j = 0; j < 4; ++j) ((uint2*)HROW(r))[lane + 64 * j] = pack4((f32x4){v[j].x, v[j].y, v[j].z, v[j].w});
      const float* m1 = mod + (size_t)(9 + b) * 6144;
      norm_mod_row(v, nmix1, m1 + 1024, m1, nullptr, nullptr, lane, p.ws + WS_AF8 + (size_t)r * D);
    } else {
      float ss = 0.f;
#pragma unroll
      for (int j = 0; j < 4; ++j) ss += (v[j].x * v[j].x + v[j].y * v[j].y) + (v[j].z * v[j].z + v[j].w * v[j].w);
      ss = wave_sum(ss);
      const float rstd = 1.0f / sqrtf(ss * (1.0f / 1024.0f) + EPS);
#pragma unroll
      for (int j = 0; j < 4; ++j) {
        const float4 w = ((const float4*)fnw)[lane + 64 * j];
        float4 o; o.x = v[j].x * rstd * w.x; o.y = v[j].y * rstd * w.y; o.z = v[j].z * rstd * w.z; o.w = v[j].w * rstd * w.w;
        ((float4*)(p.out + (size_t)r * D))[lane + 64 * j] = o;
      }
    }
  }
}

__device__ __forceinline__ void convert_experts(const Params& p, int L, lptr lds, int vb, int nblocks, int first = 0, int last = NE * 384) {
  const int lane = threadIdx.x & 63, wave = threadIdx.x >> 6;
  LAS float* scr = (LAS float*)(lds + wave * 8448);
  __syncthreads();
  for (int it = first + vb * NWAVES + wave; it < last; it += nblocks * NWAVES) expert_item(p, L, it, scr, lane);
  __syncthreads();
}
constexpr int CONV_EARLY = 10240;

__device__ __forceinline__ void inproj1_panel(const Params& p, lptr lds, int mt) {
  const int tid_ = opaque((int)threadIdx.x);
  const bf16_t* AF = (const bf16_t*)(p.ws + WS_AF8); const bf16_t* W = (const bf16_t*)(p.ws + WS_WIN1);
  bf16_t* PB = (bf16_t*)(p.ws + B_P); bf16_t* BB = (bf16_t*)(p.ws + B_B);
  StrideLoader al, bl;
  al.p0 = AF + (size_t)(mt * 128 + ROW8(0)) * 512 + CO8; al.ld64 = 64 * 512;
  bl.p0 = W + (size_t)ROW8(0) * 512 + CO8; bl.ld64 = 64 * 512;
  int st = 0;
  gemm_pre_at<4>(al, bl, st, lds);
#pragma unroll 1
  for (int nt = 0; nt < 12; ++nt) {
    f32x4 acc[4][4]; zero_acc(acc);
    StrideLoader bln = bl; bln.p0 += (size_t)256 * 512;
    gemm_chain8<4>(acc, al, bl, 8, lds, st, nt < 11, al, bln);
    bl = bln;
    const int te = opaque(tid_), le = te & 63, we = te >> 6, wm = we >> 2, wn = we & 3, q4 = le >> 4;
    const size_t row0 = (size_t)mt * 128 + wm * 64 + (le & 15);
    if (nt < 8) {
#pragma unroll
      for (int mi = 0; mi < 4; ++mi) store_row2(PB + (row0 + mi * 16) * D + nt * 128 + wn * 32, acc[mi][0] * acc[mi][1] * (F8_INV * F8_INV), acc[mi][2] * acc[mi][3] * (F8_INV * F8_INV), q4);
    } else {
#pragma unroll
      for (int mi = 0; mi < 4; ++mi) store_row4(BB + (row0 + mi * 16) * D + (nt - 8) * 256 + wn * 64, acc[mi][0] * F8_INV, acc[mi][1] * F8_INV, acc[mi][2] * F8_INV, acc[mi][3] * F8_INV, q4);
    }
  }
  __syncthreads();
}

__device__ __forceinline__ void conv3_panel(const Params& p, int mt) {
  const int lane = threadIdx.x & 63, wave = threadIdx.x >> 6;
  const bf16_t* PB = (const bf16_t*)(p.ws + B_P); const bf16_t* BB = (const bf16_t*)(p.ws + B_B); bf16_t* SB = (bf16_t*)(p.ws + B_S);
  const float* cw = opq(p.in[I_ODCW]);
  float w0[16], w1[16], w2[16];
#pragma unroll
  for (int h = 0; h < 2; ++h)
#pragma unroll
    for (int q = 0; q < 2; ++q) {
      const int c = h * 512 + lane * 8 + q * 4;
      const float4 a = *(const float4*)(cw + c), b = *(const float4*)(cw + 1024 + c), d = *(const float4*)(cw + 2048 + c);
      const int o = h * 8 + q * 4;
      w0[o] = a.x; w0[o + 1] = a.y; w0[o + 2] = a.z; w0[o + 3] = a.w; w1[o] = b.x; w1[o + 1] = b.y; w1[o + 2] = b.z; w1[o + 3] = b.w; w2[o] = d.x; w2[o + 1] = d.y; w2[o + 2] = d.z; w2[o + 3] = d.w;
    }
#pragma unroll 2
  for (int r = mt * 128 + wave; r < mt * 128 + 128; r += NWAVES) {
    const int tokb = r & 4095;
    const float fm = tokb > 0 ? 1.f : 0.f, fp = tokb < SEQ - 1 ? 1.f : 0.f;
#pragma unroll
    for (int h = 0; h < 2; ++h) {
      const size_t o = (size_t)r * D + h * 512 + lane * 8;
      const uint4 bq = *(const uint4*)(BB + o), pc = *(const uint4*)(PB + o);
      const uint4 pm = *(const uint4*)(PB + o - (tokb > 0 ? D : 0)), pn = *(const uint4*)(PB + o + (tokb < SEQ - 1 ? D : 0));
      const unsigned bb[4] = {bq.x, bq.y, bq.z, bq.w}, m[4] = {pm.x, pm.y, pm.z, pm.w}, c[4] = {pc.x, pc.y, pc.z, pc.w}, n[4] = {pn.x, pn.y, pn.z, pn.w};
      unsigned ov[4];
#pragma unroll
      for (int q = 0; q < 4; ++q) {
        const int e = h * 8 + 2 * q;
        const float lo = bflo(bb[q]) * (fm * w0[e] * bflo(m[q]) + w1[e] * bflo(c[q]) + fp * w2[e] * bflo(n[q]));
        const float hi = bfhi(bb[q]) * (fm * w0[e + 1] * bfhi(m[q]) + w1[e + 1] * bfhi(c[q]) + fp * w2[e + 1] * bfhi(n[q]));
        ov[q] = pk2(lo, hi);
      }
      *(uint4*)(SB + o) = make_uint4(ov[0], ov[1], ov[2], ov[3]);
    }
  }
}

#define XB_TMO      128
#define XB_XCNT(j)  (256  + 64 * (j))
#define XB_XSUB(j)  (1280 + 64 * (j))
#define XB_XGEN(j)  (2304 + 64 * (j))
#define XB_TOP      3328
#define XB_TOPGEN   3392
#define XCD_BAR_WORDS 3456
#define XB_SPIN_CAP (1u << 22)
__device__ __forceinline__ unsigned xb_ld(unsigned* p) { return __hip_atomic_load(p, __ATOMIC_RELAXED, __HIP_MEMORY_SCOPE_AGENT); }
__device__ __forceinline__ unsigned xb_add(unsigned* p, unsigned v) { return __hip_atomic_fetch_add(p, v, __ATOMIC_RELAXED, __HIP_MEMORY_SCOPE_AGENT); }
__device__ __forceinline__ unsigned xb_xcc_id() { return (unsigned)__builtin_amdgcn_s_getreg((3 << 11) | 20) & 0xFu; }
#define XB_SPIN(cond, bar) do { unsigned _sp = 0; while (cond) { __builtin_amdgcn_s_sleep(1); \
    if ((++_sp & 255u) == 0u) { if (xb_ld(&(bar)[XB_TMO])) break; if (_sp > XB_SPIN_CAP) { atomicAdd(&(bar)[XB_TMO], 1u); break; } } } } while (0)
struct XcdBarrier { unsigned* bar; unsigned x; volatile LAS unsigned* st; };
__device__ __forceinline__ XcdBarrier xcd_barrier_post(unsigned* bar, volatile LAS unsigned* st) {
  XcdBarrier b; b.bar = bar; b.x = xb_xcc_id(); b.st = st;
  if (threadIdx.x == 0) (void)xb_add(&bar[XB_XCNT(b.x)], 1u);
  return b;
}
__device__ __forceinline__ void xcd_barrier_complete(unsigned* bar, unsigned x, unsigned& nloc, unsigned& nx) {
  const unsigned G = gridDim.x * gridDim.y * gridDim.z;
  unsigned sum, cnt, mine, sp = 0u;
  for (;;) {
    sum = 0u; cnt = 0u; mine = 0u;
#pragma unroll
    for (unsigned j = 0; j < 16; ++j) { const unsigned c = xb_ld(&bar[XB_XCNT(j)]); sum += c; cnt += (c > 0u) ? 1u : 0u; mine = (j == x) ? c : mine; }
    if (sum == G) break;
    __builtin_amdgcn_s_sleep(1);
    if ((++sp & 255u) == 0u) { if (xb_ld(&bar[XB_TMO])) break; if (sp > XB_SPIN_CAP) { atomicAdd(&bar[XB_TMO], 1u); break; } }
  }
  nloc = mine > 0u ? mine : 1u; nx = cnt > 0u ? cnt : 1u;
}
__device__ __forceinline__ void xcd_barrier(unsigned* bar_, lptr lds) {
  asm volatile("s_waitcnt vmcnt(0)" ::: "memory");
  __syncthreads();
  if (threadIdx.x == 0) {
    XcdBarrier b; b.bar = bar_; b.x = xb_xcc_id(); b.st = (volatile LAS unsigned*)(lds + LDS_BYTES - 16);
    unsigned* bar = b.bar;
    __builtin_amdgcn_s_waitcnt(0);
    unsigned nloc = b.st[0], nx = b.st[1];
    if (nloc == 0u) { xcd_barrier_complete(bar, b.x, nloc, nx); b.st[0] = nloc; b.st[1] = nx; }
    const unsigned old = xb_add(&bar[XB_XSUB(b.x)], 1u);
    const unsigned gen = old / nloc;
    if (old + 1u == (gen + 1u) * nloc) {
      __builtin_amdgcn_fence(__ATOMIC_RELEASE, "agent");
      asm volatile("s_waitcnt vmcnt(0)" ::: "memory");
      const unsigned og = xb_add(&bar[XB_TOP], 1u);
      const unsigned tg = og / nx;
      if (og + 1u == (tg + 1u) * nx) xb_add(&bar[XB_TOPGEN], 1u);
      else XB_SPIN(xb_ld(&bar[XB_TOPGEN]) == tg, bar);
      __builtin_amdgcn_fence(__ATOMIC_ACQUIRE, "agent");
      xb_add(&bar[XB_XGEN(b.x)], 1u);
      asm volatile("s_waitcnt vmcnt(0)" ::: "memory");
    } else {
      XB_SPIN(xb_ld(&bar[XB_XGEN(b.x)]) == gen, bar);
      __builtin_amdgcn_fence(__ATOMIC_ACQUIRE, "agent");
      asm volatile("s_waitcnt vmcnt(0)" ::: "memory");
    }
  }
  __syncthreads();
}

__global__ void __launch_bounds__(NTHREADS, 2) fwd_kernel(Params p) {
  extern __shared__ __attribute__((aligned(16))) unsigned char smem[];
  lptr lds = (lptr)smem;
  const int nblocks = gridDim.x;
  const int bx = blockIdx.x;
  const int vb = ((nblocks & 7) == 0) ? (bx & 7) * (nblocks >> 3) + (bx >> 3) : bx;
  cg::grid_group grid = cg::this_grid();
  volatile LAS unsigned* bst = (volatile LAS unsigned*)(lds + LDS_BYTES - 16);
  if (threadIdx.x == 0) { bst[0] = 0u; bst[1] = 0u; }
  __syncthreads();
  if (p.ph_hi - p.ph_lo > 2) (void)xcd_barrier_post((unsigned*)(p.ws + WS_BAR), bst);
  const int lo = p.ph_lo, hi = p.ph_hi;
#ifdef ONLY_PHASE
#define IN(k) ((k) == ONLY_PHASE && lo <= (k) && (k) < hi)
#else
#define IN(k) (lo <= (k) && (k) < hi)
#endif
#ifndef PROBE_DOUBLE
#define PROBE_DOUBLE -1
#endif
#define SEAM(k) do { if (lo <= (k) && (k) + 1 < hi) { if ((k) == lo) grid.sync(); else xcd_barrier((unsigned*)(p.ws + WS_BAR), lds); } } while (0)
#define PANEL_SYNC() do { asm volatile("s_waitcnt vmcnt(0)" ::: "memory"); __syncthreads(); } while (0)
  if (IN(0)) phase0(p, lds, vb, nblocks);
  SEAM(0);
  if (IN(1)) {
    for (int pan = vb; pan < 272; pan += nblocks) {
      a0_panel(p, pan); PANEL_SYNC();
      inproj0_panel(p, lds, pan); PANEL_SYNC();
      upproj_panel(p, lds, pan);
    }
    if (nblocks == 256 && vb >= 16) convert_experts(p, 0, lds, vb - 16, 240, 0, CONV_EARLY);
  }
  SEAM(1);
  if (IN(2)) {
    const bool early = (blockIdx.x & 1) == 0;
    const int cfirst = (nblocks == 256) ? CONV_EARLY : 0;
    if (early) convert_experts(p, 0, lds, vb, nblocks, cfirst);
    phase4(p, lds, vb, nblocks); conv_units(p, lds, vb, nblocks);
    if (!early) convert_experts(p, 0, lds, vb, nblocks, cfirst);
  }
  SEAM(2);
  if (IN(3)) {
    for (int mt = vb; mt < 256; mt += nblocks) {
      outproj_panel(p, 0, lds, mt);
      ffnprep_panel(p, 0, mt); PANEL_SYNC();
      router_tile(p, 0, lds, mt);
      shared_unit(p, 0, lds, mt);
    }
  }
  SEAM(3);
  if (IN(4)) phase_experts(p, 0, lds, vb, nblocks);
  SEAM(4);
  if (IN(5)) {
    const bool early = (blockIdx.x & 1) == 0;
    if (early) convert_experts(p, 1, lds, vb, nblocks);
    for (int mt = vb; mt < 256; mt += nblocks) {
      combine_panel(p, 0, mt); PANEL_SYNC();
      inproj1_panel(p, lds, mt);
    }
    if (!early) convert_experts(p, 1, lds, vb, nblocks);
  }
  SEAM(5);
  if (IN(6)) {
    for (int mt = vb; mt < 256; mt += nblocks) {
      conv3_panel(p, mt); PANEL_SYNC();
      outproj_panel(p, 1, lds, mt);
      ffnprep_panel(p, 1, mt); PANEL_SYNC();
      router_tile(p, 1, lds, mt);
      shared_unit(p, 1, lds, mt);
    }
  }
  SEAM(6);
  if (IN(7)) phase_experts(p, 1, lds, vb, nblocks);
  SEAM(7);
  if (IN(8)) { for (int mt = vb; mt < 256; mt += nblocks) combine_panel(p, 1, mt); }
}

extern "C" void kernel_launch(void* const* d_in, const int* in_sizes, int n_in, void* d_out, int out_size,
                              void* d_ws, size_t ws_size, hipStream_t stream) {
  static int grid_blocks = 0;
  if (!grid_blocks) {
    int dev = 0, cus = 0, per_cu = 0;
    (void)hipGetDevice(&dev);
    (void)hipDeviceGetAttribute(&cus, hipDeviceAttributeMultiprocessorCount, dev);
    if (hipFuncSetAttribute((const void*)fwd_kernel, hipFuncAttributeMaxDynamicSharedMemorySize, LDS_BYTES) != hipSuccess) fprintf(stderr, "hipFuncSetAttribute failed\n");
    if (hipOccupancyMaxActiveBlocksPerMultiprocessor(&per_cu, fwd_kernel, NTHREADS, LDS_BYTES) != hipSuccess) per_cu = 0;
    fprintf(stderr, "kernel_launch: cus %d per_cu %d ws %zu n_in %d\n", cus, per_cu, ws_size, n_in);
    if (per_cu > 1) per_cu = 1;
    if (per_cu < 1) per_cu = 1;
    grid_blocks = cus * per_cu; if (grid_blocks > 256) grid_blocks = 256;
    if (ws_size < WS_END || n_in != N_IN) { fprintf(stderr, "kernel_launch: bad ws/n_in\n"); grid_blocks = -1; }
  }
  if (grid_blocks < 0) return;
  (void)hipMemsetAsync(d_ws, 0, 64 * 1024, stream);
  Params p{};
  for (int i = 0; i < N_IN; ++i) p.in[i] = (const float*)d_in[i];
  p.out = (float*)d_out; p.ws = (unsigned char*)d_ws;
#if MK_MULTI
  for (int ph = 0; ph < NPHASE; ++ph) {
    p.ph_lo = ph; p.ph_hi = ph + 1;
    hipLaunchKernelGGL(fwd_kernel, dim3(grid_blocks), dim3(NTHREADS), LDS_BYTES, stream, p);
  }
#else
  p.ph_lo = 0; p.ph_hi = NPHASE;
  void* args[] = {&p};
  hipError_t e = hipLaunchCooperativeKernel((void*)fwd_kernel, dim3(grid_blocks), dim3(NTHREADS), args, LDS_BYTES, stream);
  if (e != hipSuccess) fprintf(stderr, "cooperative launch failed: %s (grid %d)\n", hipGetErrorString(e), grid_blocks);
#endif
}
```

```cpp
#include <hip/hip_runtime.h>
#include <hip/hip_cooperative_groups.h>
#include <cstdio>
#include <cstdint>
namespace cg = cooperative_groups;

#ifndef MK_MULTI
#define MK_MULTI 0
#endif

#define LAS __attribute__((address_space(3)))
typedef unsigned short bf16_t;
typedef short bf16x8 __attribute__((ext_vector_type(8)));
typedef float f32x4 __attribute__((ext_vector_type(4)));
typedef LAS unsigned char* lptr;
typedef unsigned u32x4 __attribute__((ext_vector_type(4)));
typedef unsigned u32x2 __attribute__((ext_vector_type(2)));
typedef float f32x2 __attribute__((ext_vector_type(2)));
typedef int i32x4 __attribute__((ext_vector_type(4)));
typedef int i32x8 __attribute__((ext_vector_type(8)));
constexpr float F8_SA = 4.0f, F8_SW1 = 256.0f, F8_SACT = 8.0f, F8_SW2 = 128.0f, F8_INV = 1.0f / 1024.0f;

constexpr int D = 1024, NB = 8, SEQ = 4096, T = NB * SEQ, CL = 256, TC = NB * CL, TT = T + TC, NKEY = SEQ + CL;
constexpr int NH = 8, DQK = 96, DV = 64;
constexpr int NE = 64, TOPK = 6;
constexpr float EPS = 1e-6f;
constexpr int NPHASE = 9;
constexpr int NTHREADS = 512, NWAVES = 8;
constexpr int RING_BYTES = 147456;
constexpr int XLDS = RING_BYTES;
constexpr int LDS_BYTES = RING_BYTES + 2048;

enum { I_X = 0, I_C, I_CTX, I_CCTX, I_ADAW, I_ADAB, I_NMIX, I_NFFN, I_EVWIN, I_EVCW, I_EVCB, I_EVLNW, I_EVLNB, I_QNW, I_KVNW,
       I_WUQ, I_WUKV, I_EVWOUT, I_ODWIN, I_ODCW, I_ODWOUT, I_RW, I_RB, I_EG, I_EU, I_ED, I_SG, I_SU, I_SD, I_FNW, N_IN };

struct Params {
  const float* in[N_IN];
  float* out;
  unsigned char* ws;
  int ph_lo, ph_hi;
};

constexpr size_t MiB = 1u << 20;
constexpr size_t WS_CNT = 0;
constexpr size_t WS_BAR = 16 * 1024;
constexpr size_t WS_MOD = 64 * 1024;
constexpr size_t WS_ROPE = WS_MOD + 512 * 1024;
constexpr size_t WS_CW1 = WS_ROPE + 8 * 1024;
constexpr size_t WS_WTS = 1 * MiB;
constexpr size_t WS_LISTS = 2 * MiB;
constexpr size_t WS_ACT = 10 * MiB;
constexpr size_t WS_WRB = 18 * MiB;
constexpr size_t WS_RC = 22 * MiB;
constexpr size_t WS_WIN0 = 26 * MiB;
constexpr size_t WS_WUQ = 29 * MiB;
constexpr size_t WS_WUKV = WS_WUQ + 512 * 1024;
constexpr size_t WS_WOUT0 = 30 * MiB;
constexpr size_t WS_WIN1 = 32 * MiB;
constexpr size_t WS_WOUT1 = 38 * MiB;
constexpr size_t WS_WR = 40 * MiB;
constexpr size_t WS_WSGU = 42 * MiB;
constexpr size_t WS_WSD = 44 * MiB;
constexpr size_t WS_WEGU = 46 * MiB;
constexpr size_t WS_AF8 = 78 * MiB;
constexpr size_t WS_WED = 110 * MiB;
constexpr size_t WS_WED1 = 126 * MiB;
constexpr size_t WS_WEGU1 = 210 * MiB + 352 * MiB;
constexpr size_t WS_AF = 142 * MiB;
constexpr size_t WS_BIG = 210 * MiB;
constexpr size_t WS_END = 594 * MiB;
constexpr size_t B_GLU = WS_BIG + 0 * MiB;
constexpr size_t B_CQ = WS_BIG + 32 * MiB;
constexpr size_t B_CKV = WS_BIG + 48 * MiB;
constexpr size_t B_KR = WS_BIG + 57 * MiB;
constexpr size_t B_Q = WS_BIG + 60 * MiB;
constexpr size_t B_K = WS_BIG + 108 * MiB;
constexpr size_t B_VT = WS_BIG + 159 * MiB;
constexpr size_t B_OCAT = WS_BIG + 193 * MiB;
constexpr size_t B_FLO = WS_BIG + 64 * MiB;
constexpr size_t B_CONTRIB = WS_BIG;
constexpr size_t B_P = WS_BIG + 192 * MiB;
constexpr size_t B_B = WS_BIG + 256 * MiB;
constexpr size_t B_SHC = WS_BIG + 320 * MiB;
constexpr size_t B_S = WS_BIG;

typedef __bf16 bf16v2_t __attribute__((ext_vector_type(2)));
__device__ __forceinline__ unsigned pk2(float lo, float hi) {
  bf16v2_t v; v[0] = (__bf16)lo; v[1] = (__bf16)hi; return __builtin_bit_cast(unsigned, v);
}
__device__ __forceinline__ float bflo(unsigned u) { return __uint_as_float(u << 16); }
__device__ __forceinline__ float bfhi(unsigned u) { return __uint_as_float(u & 0xffff0000u); }
__device__ __forceinline__ unsigned pack4_fp8(f32x4 v) {
  int u = __builtin_amdgcn_cvt_pk_fp8_f32(v[0], v[1], 0, false);
  u = __builtin_amdgcn_cvt_pk_fp8_f32(v[2], v[3], u, true);
  return (unsigned)u;
}
__device__ __forceinline__ unsigned pack4_fp8c(f32x4 v) {
#pragma unroll
  for (int r = 0; r < 4; ++r) v[r] = fminf(fmaxf(v[r], -448.0f), 448.0f);
  return pack4_fp8(v);
}
__device__ __forceinline__ uint2 pack4(f32x4 v) { uint2 r; r.x = pk2(v[0], v[1]); r.y = pk2(v[2], v[3]); return r; }
__device__ __forceinline__ f32x4 unpack4(uint2 u) { return (f32x4){bflo(u.x), bfhi(u.x), bflo(u.y), bfhi(u.y)}; }
#define HROW(r) ((bf16_t*)(p.out + (size_t)(r) * D))
__device__ __forceinline__ void tr4x4(unsigned& x0, unsigned& x1, unsigned& x2, unsigned& x3) {
  { auto r = __builtin_amdgcn_permlane32_swap(x0, x2, false, false); x0 = r[0]; x2 = r[1]; }
  { auto r = __builtin_amdgcn_permlane32_swap(x1, x3, false, false); x1 = r[0]; x3 = r[1]; }
  { auto r = __builtin_amdgcn_permlane16_swap(x0, x1, false, false); x0 = r[0]; x1 = r[1]; }
  { auto r = __builtin_amdgcn_permlane16_swap(x2, x3, false, false); x2 = r[0]; x3 = r[1]; }
}
__device__ __forceinline__ void store_row4(bf16_t* rowp, f32x4 v0, f32x4 v1, f32x4 v2, f32x4 v3, int q4) {
  uint2 a = pack4(v0), b = pack4(v1), c = pack4(v2), d = pack4(v3);
  tr4x4(a.x, b.x, c.x, d.x); tr4x4(a.y, b.y, c.y, d.y);
  u32x4* o = (u32x4*)(rowp + q4 * 16);
  o[0] = (u32x4){a.x, a.y, b.x, b.y}; o[1] = (u32x4){c.x, c.y, d.x, d.y};
}
__device__ __forceinline__ void store_group4(bf16_t* gp, f32x4 v0, f32x4 v1, f32x4 v2, f32x4 v3) {
  uint2 a = pack4(v0), b = pack4(v1), c = pack4(v2), d = pack4(v3);
  tr4x4(a.x, b.x, c.x, d.x); tr4x4(a.y, b.y, c.y, d.y);
  u32x4* o = (u32x4*)gp;
  o[0] = (u32x4){a.x, a.y, b.x, b.y}; o[1] = (u32x4){c.x, c.y, d.x, d.y};
}
__device__ __forceinline__ void store_row2(bf16_t* rowp, f32x4 v0, f32x4 v1, int q4) {
  uint2 a = pack4(v0), b = pack4(v1);
  { auto r = __builtin_amdgcn_permlane16_swap(a.x, b.x, false, false); a.x = r[0]; b.x = r[1]; }
  { auto r = __builtin_amdgcn_permlane16_swap(a.y, b.y, false, false); a.y = r[0]; b.y = r[1]; }
  *(u32x4*)(rowp + (q4 & 1) * 16 + (q4 >> 1) * 8) = (u32x4){a.x, a.y, b.x, b.y};
}
__device__ __forceinline__ float wave_sum(float v) {
#pragma unroll
  for (int o = 1; o < 64; o <<= 1) v += __shfl_xor(v, o);
  return v;
}
__device__ __forceinline__ void lds_w16(lptr p, uint4 v) { *(LAS u32x4*)p = (u32x4){v.x, v.y, v.z, v.w}; }
__device__ __forceinline__ bf16x8 lds_r16(lptr p) { return *(LAS bf16x8*)p; }
__device__ __forceinline__ i32x4 lds_r16i(lptr p) { return *(LAS i32x4*)p; }
__device__ __forceinline__ float sigmoidf_(float x) { return 1.0f / (1.0f + __expf(-x)); }
__device__ __forceinline__ float sigmoid_fast(float x) { return __builtin_amdgcn_rcpf(1.0f + __expf(-x)); }


#define GAS __attribute__((address_space(1)))
__device__ __forceinline__ void glds16(const bf16_t* g, lptr l) {
  __builtin_amdgcn_global_load_lds((const GAS unsigned*)g, (LAS unsigned*)l, 16, 0, 0);
}
__device__ __forceinline__ int opaque(int x) { asm volatile("" : "+v"(x)); return x; }
template <class TP> __device__ __forceinline__ TP* opq(TP* x) { asm volatile("" : "+s"(x)); return x; }
#define CO8 ((((tid_ & 7) ^ ((tid_ >> 3) & 7))) << 3)
#define ROW8(i) ((i) * 64 + (tid_ >> 6) * 8 + ((tid_ & 63) >> 3))
#define WAIT_VM(n) asm volatile("s_waitcnt vmcnt(" #n ")" ::: "memory")
struct StrideLoader {
  static constexpr bool DIRECT = true;
  typedef uint4 Raw;
  const bf16_t* p0; int ld64;
  __device__ __forceinline__ const bf16_t* gp(int i, int kt) const { return p0 + (size_t)i * ld64 + kt * 64; }
  __device__ __forceinline__ void pre(int) {}
  __device__ __forceinline__ Raw ld(int, int) const { return make_uint4(0, 0, 0, 0); }
  __device__ __forceinline__ uint4 cvt(const Raw& r, int) const { return r; }
};
struct RowLoader2 {
  static constexpr bool DIRECT = true;
  typedef uint4 Raw;
  const bf16_t* p[2];
  __device__ __forceinline__ const bf16_t* gp(int i, int kt) const { return p[i] + kt * 64; }
  __device__ __forceinline__ void pre(int) {}
  __device__ __forceinline__ Raw ld(int, int) const { return make_uint4(0, 0, 0, 0); }
  __device__ __forceinline__ uint4 cvt(const Raw& r, int) const { return r; }
};

template <int NW, class AL, class BL>
__device__ __forceinline__ void gemm_pre(AL& al, BL& bl, int nk, lptr lds) {
  static_assert(AL::DIRECT && BL::DIRECT, "gemm_pre: LDS-DMA loaders only");
  const int wbase = __builtin_amdgcn_readfirstlane(opaque((int)threadIdx.x) >> 6) * 1024;
#pragma unroll
  for (int t = 0; t < 2; ++t) {
    if (t < nk) {
#pragma unroll
      for (int i = 0; i < 2; ++i) glds16(al.gp(i, t), lds + t * 49152 + i * 8192 + wbase);
#pragma unroll
      for (int i = 0; i < NW; ++i) glds16(bl.gp(i, t), lds + t * 49152 + 16384 + i * 8192 + wbase);
    }
  }
}
template <bool SWAP, int NW, bool PRE = false, class AL, class BL>
__device__ __forceinline__ void gemm_core(f32x4 (&acc)[4][NW], AL& al, BL& bl, int nk, lptr lds) {
  static_assert(BL::DIRECT, "B operand is always staged by LDS-DMA");
  static_assert(NW == 4 || NW == 1, "NW");
  constexpr int BS = NW;
  constexpr int STAGE = 49152, B_OFF = 16384;
  const int tid = opaque((int)threadIdx.x), lane = tid & 63, wave = __builtin_amdgcn_readfirstlane(tid >> 6), wm = wave >> 2, wn = wave & 3;
  int aoff[2], boff[2];
#pragma unroll
  for (int ks = 0; ks < 2; ++ks) {
    const int sw = (((ks * 4 + (lane >> 4)) ^ (lane & 7)) << 4);
    aoff[ks] = (wm * 64 + (lane & 15)) * 128 + sw;
    boff[ks] = B_OFF + (wn * 16 * NW + (lane & 15)) * 128 + sw;
  }
  const int wbase = wave * 1024;
  const int woff = (wave * 8 + (lane >> 3)) * 128 + (((lane & 7) ^ ((lane >> 3) & 7)) << 4);
  typename AL::Raw ra[2];
#pragma unroll
  for (int t = 0; t < 2; ++t) {
    if (!PRE && t < nk) {
      if constexpr (AL::DIRECT) {
#pragma unroll
        for (int i = 0; i < 2; ++i) glds16(al.gp(i, t), lds + t * STAGE + i * 8192 + wbase);
      } else {
        al.pre(t);
#pragma unroll
        for (int i = 0; i < 2; ++i) ra[i] = al.ld(i, t);
#pragma unroll
        for (int i = 0; i < 2; ++i) lds_w16(lds + t * STAGE + woff + i * 8192, al.cvt(ra[i], i));
      }
#pragma unroll
      for (int i = 0; i < BS; ++i) glds16(bl.gp(i, t), lds + t * STAGE + B_OFF + i * 8192 + wbase);
    }
  }
  int st = 0;
  for (int kt = 0; kt < nk; ++kt) {
    if constexpr (AL::DIRECT) {
      if (kt > 0 && kt + 1 < nk) { if constexpr (NW == 4) WAIT_VM(6); else WAIT_VM(3); } else WAIT_VM(0);
    } else WAIT_VM(0);
    asm volatile("s_waitcnt lgkmcnt(0)" ::: "memory");
    __builtin_amdgcn_s_barrier();
    asm volatile("" ::: "memory");
    const int s2 = (st == 0) ? 2 : st - 1;
    const bool more = (kt + 2 < nk);
    if (more) {
      if constexpr (AL::DIRECT) {
#pragma unroll
        for (int i = 0; i < 2; ++i) glds16(al.gp(i, kt + 2), lds + s2 * STAGE + i * 8192 + wbase);
      } else {
        al.pre(kt + 2);
#pragma unroll
        for (int i = 0; i < 2; ++i) ra[i] = al.ld(i, kt + 2);
      }
#pragma unroll
      for (int i = 0; i < BS; ++i) glds16(bl.gp(i, kt + 2), lds + s2 * STAGE + B_OFF + i * 8192 + wbase);
    }
    const lptr base = lds + st * STAGE;
#pragma unroll
    for (int ks = 0; ks < 2; ++ks) {
      bf16x8 af[4], bfr[NW];
#pragma unroll
      for (int i = 0; i < 4; ++i) af[i] = lds_r16(base + aoff[ks] + i * 2048);
#pragma unroll
      for (int j = 0; j < NW; ++j) bfr[j] = lds_r16(base + boff[ks] + j * 2048);
      __builtin_amdgcn_s_setprio(1);
#pragma unroll
      for (int i = 0; i < 4; ++i)
#pragma unroll
        for (int j = 0; j < NW; ++j)
          acc[i][j] = SWAP ? __builtin_amdgcn_mfma_f32_16x16x32_bf16(bfr[j], af[i], acc[i][j], 0, 0, 0)
                           : __builtin_amdgcn_mfma_f32_16x16x32_bf16(af[i], bfr[j], acc[i][j], 0, 0, 0);
      __builtin_amdgcn_s_setprio(0);
    }
    if constexpr (!AL::DIRECT) {
      if (more) {
#pragma unroll
        for (int i = 0; i < 2; ++i) lds_w16(lds + s2 * STAGE + woff + i * 8192, al.cvt(ra[i], i));
      }
    }
    st = (st == 2) ? 0 : st + 1;
  }
  __syncthreads();
}

template <int NW>
__device__ __forceinline__ void zero_acc(f32x4 (&acc)[4][NW]) {
#pragma unroll
  for (int i = 0; i < 4; ++i)
#pragma unroll
    for (int j = 0; j < NW; ++j) acc[i][j] = (f32x4){0.f, 0.f, 0.f, 0.f};
}


template <int NW, bool ARES = false, class AL, class BL>
__device__ __forceinline__ void gemm_pre_at(AL& al, BL& bl, int st, lptr lds) {
  const int wbase = __builtin_amdgcn_readfirstlane(opaque((int)threadIdx.x) >> 6) * 1024;
#pragma unroll
  for (int t = 0; t < 2; ++t) {
    const int sg = (st + t) % 3;
#pragma unroll
    for (int i = 0; i < 2; ++i) if constexpr (!ARES) glds16(al.gp(i, t), lds + sg * 49152 + i * 8192 + wbase);
#pragma unroll
    for (int i = 0; i < NW; ++i) glds16(bl.gp(i, t), lds + sg * 49152 + 16384 + i * 8192 + wbase);
  }
}
#define GC_READ_ALL(stg) do { const lptr base_ = lds + (stg) * STAGE; \
    _Pragma("unroll") for (int i = 0; i < 4; ++i) a0[i] = lds_r16(base_ + aoff[0] + i * 2048); \
    _Pragma("unroll") for (int j = 0; j < NW; ++j) b0[j] = lds_r16(base_ + boff[0] + j * 2048); \
    _Pragma("unroll") for (int i = 0; i < 4; ++i) a1[i] = lds_r16(base_ + aoff[1] + i * 2048); \
    _Pragma("unroll") for (int j = 0; j < NW; ++j) b1[j] = lds_r16(base_ + boff[1] + j * 2048); } while (0)
#define GC_DMA(t2_, s2_) do { const int t2 = (t2_); const int s2 = (s2_); \
    if (t2 < nk) { \
      _Pragma("unroll") for (int i = 0; i < 2; ++i) glds16(al.gp(i, t2), lds + s2 * STAGE + i * 8192 + wbase); \
      _Pragma("unroll") for (int i = 0; i < NW; ++i) glds16(bl.gp(i, t2), lds + s2 * STAGE + B_OFF + i * 8192 + wbase); \
    } else if (has_next) { \
      _Pragma("unroll") for (int i = 0; i < 2; ++i) glds16(aln.gp(i, t2 - nk), lds + s2 * STAGE + i * 8192 + wbase); \
      _Pragma("unroll") for (int i = 0; i < NW; ++i) glds16(bln.gp(i, t2 - nk), lds + s2 * STAGE + B_OFF + i * 8192 + wbase); \
    } } while (0)
#define GC_MM(A_, B_) do { \
    _Pragma("unroll") for (int i = 0; i < 4; ++i) \
      _Pragma("unroll") for (int j = 0; j < NW; ++j) \
        acc[i][j] = SWAP ? __builtin_amdgcn_mfma_f32_16x16x32_bf16(B_[j], A_[i], acc[i][j], 0, 0, 0) \
                         : __builtin_amdgcn_mfma_f32_16x16x32_bf16(A_[i], B_[j], acc[i][j], 0, 0, 0); \
    } while (0)
template <bool SWAP, int NW, class AL, class BL, class ALN, class BLN>
__device__ __forceinline__ void gemm_chain(f32x4 (&acc)[4][NW], AL& al, BL& bl, int nk, lptr lds, int& st_io, bool has_next, ALN& aln, BLN& bln) {
  constexpr int STAGE = 49152, B_OFF = 16384;
  const int tid = opaque((int)threadIdx.x), lane = tid & 63, wave = __builtin_amdgcn_readfirstlane(tid >> 6), wm = wave >> 2, wn = wave & 3;
  int aoff[2], boff[2];
#pragma unroll
  for (int ks = 0; ks < 2; ++ks) {
    const int sw = (((ks * 4 + (lane >> 4)) ^ (lane & 7)) << 4);
    aoff[ks] = (wm * 64 + (lane & 15)) * 128 + sw;
    boff[ks] = B_OFF + (wn * 16 * NW + (lane & 15)) * 128 + sw;
  }
  const int wbase = wave * 1024;
  int st = st_io;
  WAIT_VM(0);
  asm volatile("s_waitcnt lgkmcnt(0)" ::: "memory");
  __builtin_amdgcn_s_barrier();
  asm volatile("" ::: "memory");
  bf16x8 a0[4], b0[NW], a1[4], b1[NW];
  GC_READ_ALL(st);
  GC_DMA(2, (st == 0) ? 2 : st - 1);
  GC_MM(a0, b0);
  for (int kt = 1; kt < nk; ++kt) {
    const int stn = (st == 2) ? 0 : st + 1;
    bf16x8 pa[4], pb[NW];
#pragma unroll
    for (int i = 0; i < 4; ++i) pa[i] = a1[i];
#pragma unroll
    for (int j = 0; j < NW; ++j) pb[j] = b1[j];
    if (kt + 1 < nk || has_next) { if constexpr (NW == 4) WAIT_VM(6); else WAIT_VM(3); } else WAIT_VM(0);
    asm volatile("s_waitcnt lgkmcnt(0)" ::: "memory");
    __builtin_amdgcn_s_barrier();
    asm volatile("" ::: "memory");
    GC_READ_ALL(stn);
    GC_MM(pa, pb);
    GC_DMA(kt + 2, st);
    GC_MM(a0, b0);
    st = stn;
  }
  GC_MM(a1, b1);
  st = (st == 2) ? 0 : st + 1;
  st_io = st;
}
template <int NW, bool ARES = false, class AL, class BL, class ALN, class BLN>
__device__ __forceinline__ void gemm_chain8(f32x4 (&acc)[4][NW], AL& al, BL& bl, int nk, lptr lds, int& st_io, bool has_next, ALN& aln, BLN& bln) {
  constexpr int STAGE = 49152, B_OFF = 16384;
  const int tid = opaque((int)threadIdx.x), lane = tid & 63, wave = __builtin_amdgcn_readfirstlane(tid >> 6), wm = wave >> 2, wn = wave & 3;
  int aoff[2], boff[2];
#pragma unroll
  for (int ks = 0; ks < 2; ++ks) {
    const int sw = (((ks * 4 + (lane >> 4)) ^ (lane & 7)) << 4);
    aoff[ks] = (wm * 64 + (lane & 15)) * 128 + sw;
    boff[ks] = B_OFF + (wn * 16 * NW + (lane & 15)) * 128 + sw;
  }
  const int wbase = wave * 1024;
  int st = st_io;
  asm volatile("" : "+s"(nk));
#pragma unroll 1
  for (int kt = 0; kt < nk; ++kt) {
    if (kt > 0 && (kt + 1 < nk || has_next)) { if constexpr (ARES) WAIT_VM(4); else if constexpr (NW == 4) WAIT_VM(6); else WAIT_VM(3); } else WAIT_VM(0);
    asm volatile("s_waitcnt lgkmcnt(0)" ::: "memory");
    __builtin_amdgcn_s_barrier();
    asm volatile("" ::: "memory");
    const lptr base = lds + st * STAGE;
    i32x8 af[4], bfr[NW];
#pragma unroll
    for (int j = 0; j < NW; ++j) bfr[j] = __builtin_shufflevector(lds_r16i(base + boff[0] + j * 2048), lds_r16i(base + boff[1] + j * 2048), 0, 1, 2, 3, 4, 5, 6, 7);
#pragma unroll
    for (int i = 0; i < 4; ++i) { const lptr ab = ARES ? lds + (kt & 1) * STAGE : base; af[i] = __builtin_shufflevector(lds_r16i(ab + aoff[0] + i * 2048), lds_r16i(ab + aoff[1] + i * 2048), 0, 1, 2, 3, 4, 5, 6, 7); }
    {
      const int s2 = (st == 0) ? 2 : st - 1;
      const int t2 = kt + 2;
      if (t2 < nk) {
  #pragma unroll
        for (int i = 0; i < 2; ++i) if constexpr (!ARES) glds16(al.gp(i, t2), lds + s2 * STAGE + i * 8192 + wbase);
  #pragma unroll
        for (int i = 0; i < NW; ++i) glds16(bl.gp(i, t2), lds + s2 * STAGE + B_OFF + i * 8192 + wbase);
      } else if (has_next) {
  #pragma unroll
        for (int i = 0; i < 2; ++i) if constexpr (!ARES) glds16(aln.gp(i, t2 - nk), lds + s2 * STAGE + i * 8192 + wbase);
  #pragma unroll
        for (int i = 0; i < NW; ++i) glds16(bln.gp(i, t2 - nk), lds + s2 * STAGE + B_OFF + i * 8192 + wbase);
      }
    }
#pragma unroll
    for (int i = 0; i < 4; ++i)
#pragma unroll
      for (int j = 0; j < NW; ++j)
        acc[i][j] = __builtin_amdgcn_mfma_scale_f32_16x16x128_f8f6f4(bfr[j], af[i], acc[i][j], 0, 0, 0, 0x7f7f7f7f, 0, 0x7f7f7f7f);
    st = (st == 2) ? 0 : st + 1;
  }
  st_io = st;
}

constexpr int EP_PITCH = 1040;
constexpr int EP_BASE = 98304;
constexpr int EPT_PITCH = 528;
template <int NW>
struct PutPlain {
  const f32x4 (&acc)[4][NW];
  template <class W> __device__ __forceinline__ void operator()(int band, int tid, W w) const {
    const int lane = tid & 63, wave = tid >> 6, wm = wave >> 2, wn = wave & 3;
    if (wm != (band >> 1)) return;
#pragma unroll
    for (int m2 = 0; m2 < 2; ++m2)
#pragma unroll
      for (int nj = 0; nj < NW; ++nj) w(m2 * 16 + (lane & 15), wn * 16 * NW + nj * 16 + (lane >> 4) * 4, acc[2 * (band & 1) + m2][nj]);
  }
};
template <class OP>
struct PutPair {
  const f32x4 (&acc)[4][4]; OP op;
  template <class W> __device__ __forceinline__ void operator()(int band, int tid, W w) const {
    const int lane = tid & 63, wave = tid >> 6, wm = wave >> 2, wn = wave & 3;
    if (wm != (band >> 1)) return;
#pragma unroll
    for (int m2 = 0; m2 < 2; ++m2)
#pragma unroll
      for (int j2 = 0; j2 < 2; ++j2) {
        const f32x4 x = acc[2 * (band & 1) + m2][2 * j2], y = acc[2 * (band & 1) + m2][2 * j2 + 1]; f32x4 v;
#pragma unroll
        for (int r = 0; r < 4; ++r) v[r] = op(x[r], y[r]);
        w(m2 * 16 + (lane & 15), wn * 32 + j2 * 16 + (lane >> 4) * 4, v);
      }
  }
};
template <int NC, int UNR = 4, class PUT, class F>
__device__ __forceinline__ void ep_banded(lptr lds, const PUT& put, F f) {
  constexpr int CPR = NC / 4;
  const int tid = opaque((int)threadIdx.x);
#pragma unroll
  for (int band = 0; band < 4; ++band) {
    put(band, tid, [&](int rb, int col, f32x4 v) { *(LAS f32x4*)(lds + EP_BASE + rb * EP_PITCH + col * 4) = v; });
    __syncthreads();
    static_assert((32 * CPR) % NTHREADS == 0, "ep_banded: whole passes");
#pragma unroll
    for (int it = 0; it < (32 * CPR) / NTHREADS; ++it) {
      const int idx = tid + it * NTHREADS;
      const int rb = idx / CPR, c4 = idx - rb * CPR;
      const f32x4 v = *(const LAS f32x4*)(lds + EP_BASE + rb * EP_PITCH + c4 * 16);
      f(band * 32 + rb, c4 * 4, v);
    }
    __syncthreads();
    __builtin_amdgcn_sched_barrier(0);
  }
}

enum { M_ID = 0, M_WIN0, M_WUQ, M_WUKV, M_WIN1, M_GATE, M_UP };
__device__ __forceinline__ int map_col(int mode, int n) {
  switch (mode) {
    case M_WIN0:
      if (n < 512) return ((n >> 4) << 5) + (n & 15);
      if (n < 1024) { const int c = n - 512; return ((c >> 4) << 5) + 16 + (c & 15); }
      if (n < 1408) return n;
      { const int i = n - 1408; return 1408 + (i & 16) + ((i & 7) << 1) + ((i >> 3) & 1); }
    case M_WUQ: { const int h = n / 96, d = n - h * 96; if (d < 64) return n; const int i = d - 64; return h * 96 + 64 + (i & 16) + ((i & 7) << 1) + ((i >> 3) & 1); }
    case M_WUKV: { const int h = n >> 7, d = n & 127; return d < 64 ? h * 64 + d : 512 + h * 64 + (d - 64); }
    case M_WIN1:
      if (n < 1024) return 2048 + n;
      if (n < 2048) { const int c = n - 1024; return ((c >> 4) << 5) + (c & 15); }
      { const int c = n - 2048; return ((c >> 4) << 5) + 16 + (c & 15); }
    case M_GATE: return ((n >> 4) << 5) + (n & 15);
    case M_UP: return ((n >> 4) << 5) + 16 + (n & 15);
    default: return n;
  }
}
#define WAVE_LDS_SYNC() do { asm volatile("s_waitcnt lgkmcnt(0)" ::: "memory"); __builtin_amdgcn_wave_barrier(); asm volatile("" ::: "memory"); } while (0)
__device__ __forceinline__ void transpose_item(const float* W, int K, int N, bf16_t* dst, int ldd, int mode, const float* kscale, int item, LAS float* scr, int lane) {
  const int nblk = N >> 5, kb = item / nblk, nb = item - kb * nblk, k0 = kb * 64, n0 = nb * 32;
  float4 tv[8];
#pragma unroll
  for (int i = 0; i < 8; ++i) tv[i] = *(const float4*)(W + (size_t)(k0 + 8 * i + (lane >> 3)) * N + n0 + (lane & 7) * 4);
#pragma unroll
  for (int i = 0; i < 8; ++i) {
    const int kk = 8 * i + (lane >> 3);
    const float ks = kscale ? kscale[k0 + kk] : 1.0f;
    LAS float* d = scr + kk * 33 + (lane & 7) * 4;
    d[0] = tv[i].x * ks; d[1] = tv[i].y * ks; d[2] = tv[i].z * ks; d[3] = tv[i].w * ks;
  }
  WAVE_LDS_SYNC();
  const int c = lane & 7;
#pragma unroll
  for (int j = 0; j < 4; ++j) {
    const int n = (lane >> 3) + 8 * j; const LAS float* s = scr + (8 * c) * 33 + n;
    uint4 o; o.x = pk2(s[0], s[33]); o.y = pk2(s[66], s[99]); o.z = pk2(s[132], s[165]); o.w = pk2(s[198], s[231]);
    *(uint4*)(dst + (size_t)map_col(mode, n0 + n) * ldd + k0 + 8 * c) = o;
  }
  WAVE_LDS_SYNC();
}
__device__ __forceinline__ void transpose_item8(const float* W, int K, int N, unsigned char* dst, int ldd, int mode, float scale, int item, LAS float* scr, int lane) {
  const int nblk = N >> 5, kb = item / nblk, nb = item - kb * nblk, k0 = kb * 64, n0 = nb * 32;
  float4 tv[8];
#pragma unroll
  for (int i = 0; i < 8; ++i) tv[i] = *(const float4*)(W + (size_t)(k0 + 8 * i + (lane >> 3)) * N + n0 + (lane & 7) * 4);
#pragma unroll
  for (int i = 0; i < 8; ++i) {
    LAS float* d = scr + (8 * i + (lane >> 3)) * 33 + (lane & 7) * 4;
    d[0] = tv[i].x * scale; d[1] = tv[i].y * scale; d[2] = tv[i].z * scale; d[3] = tv[i].w * scale;
  }
  WAVE_LDS_SYNC();
  const int c = lane & 7;
#pragma unroll
  for (int j = 0; j < 4; ++j) {
    const int n = (lane >> 3) + 8 * j; const LAS float* s = scr + (8 * c) * 33 + n;
    uint2 o;
    o.x = pack4_fp8c((f32x4){s[0], s[33], s[66], s[99]}); o.y = pack4_fp8c((f32x4){s[132], s[165], s[198], s[231]});
    *(uint2*)(dst + (size_t)map_col(mode, n0 + n) * ldd + k0 + 8 * c) = o;
  }
  WAVE_LDS_SYNC();
}
__device__ __forceinline__ void router_item(const float* W, bf16_t* dst, int item, LAS float* scr, int lane) {
  const int kb = item >> 1, nb = item & 1, k0 = kb * 64, n0 = nb * 32;
#pragma unroll 8
  for (int i = 0; i < 32; ++i) { const int kk = 2 * i + (lane >> 5); scr[kk * 33 + (lane & 31)] = W[(size_t)(k0 + kk) * 64 + n0 + (lane & 31)]; }
  WAVE_LDS_SYNC();
  const int c = lane & 7;
#pragma unroll
  for (int j = 0; j < 4; ++j) {
    const int n = (lane >> 3) + 8 * j; const LAS float* s = scr + (8 * c) * 33 + n;
    float v[8]; unsigned hb[4], lb[4];
#pragma unroll
    for (int q = 0; q < 8; ++q) v[q] = s[q * 33];
#pragma unroll
    for (int q = 0; q < 4; ++q) { hb[q] = pk2(v[2 * q], v[2 * q + 1]); lb[q] = pk2(v[2 * q] - bflo(hb[q]), v[2 * q + 1] - bfhi(hb[q])); }
    const int e = n0 + n;
    bf16_t* dh = dst + (size_t)((e >> 4) * 32 + (e & 15)) * 2048 + k0 + 8 * c;
    *(uint4*)(dh) = make_uint4(hb[0], hb[1], hb[2], hb[3]);
    *(uint4*)(dh + 1024) = make_uint4(hb[0], hb[1], hb[2], hb[3]);
    *(uint4*)(dh + 16 * 2048) = make_uint4(lb[0], lb[1], lb[2], lb[3]);
    *(uint4*)(dh + 16 * 2048 + 1024) = make_uint4(lb[0], lb[1], lb[2], lb[3]);
  }
  WAVE_LDS_SYNC();
}
__device__ __forceinline__ void expert_item(const Params& p, int L, int item, LAS float* scr, int lane) {
  const int e = item / 384, r = item - e * 384;
  const size_t eo = (size_t)(L * NE + e);
  unsigned char* gu = p.ws + (L ? WS_WEGU1 : WS_WEGU) + (size_t)e * 512 * 1024;
  unsigned char* dn = p.ws + (L ? WS_WED1 : WS_WED) + (size_t)e * 1024 * 256;
  if (r < 128) transpose_item8(p.in[I_EG] + eo * 1024 * 256, 1024, 256, gu, 1024, M_GATE, F8_SW1, r, scr, lane);
  else if (r < 256) transpose_item8(p.in[I_EU] + eo * 1024 * 256, 1024, 256, gu, 1024, M_UP, F8_SW1, r - 128, scr, lane);
  else transpose_item8(p.in[I_ED] + eo * 256 * 1024, 256, 1024, dn, 256, M_ID, F8_SW2, r - 256, scr, lane);
}

__device__ __forceinline__ void phase0(const Params& p, lptr lds, int vb, int nblocks) {
  const int tid = threadIdx.x, lane = tid & 63, wave = tid >> 6;
  unsigned char* ws = p.ws;
  if (vb == 0) {
    if (tid < 128) ((int*)(ws + WS_CNT))[tid] = 0;
  }
  if (vb == 2 || nblocks == 1) {
    for (int i = tid; i < 3 * 512; i += NTHREADS) { const float2 v = *(const float2*)(p.in[I_ODCW] + 2 * i); ((unsigned*)(ws + WS_CW1))[i] = pk2(v.x, v.y); }
  }
  if (vb == 1 || nblocks == 1) {
    for (int t = tid; t < 512; t += NTHREADS) {
      const int pos = t >> 3, j = t & 7;
      const float inv = 1.0f / powf(10000.0f, (float)(2 * j) / 16.0f);
      const float ang = (float)pos * inv;
      ((float2*)(ws + WS_ROPE))[t] = make_float2(cosf(ang), sinf(ang));
    }
  }
  {
    LAS float* sc = (LAS float*)lds;
    LAS float* red = (LAS float*)(lds + 36864);
    bool have = false;
    for (int it = vb; it < 384; it += nblocks) {
      if (!have) {
        float cv[18];
#pragma unroll
        for (int q = 0; q < 18; ++q) { const int i = tid + q * NTHREADS, r = i >> 10, k = i & 1023; cv[q] = (r < 8) ? p.in[I_C][r * 1024 + k] : p.in[I_CCTX][k]; }
#pragma unroll
        for (int q = 0; q < 18; ++q) sc[tid + q * NTHREADS] = cv[q] / (1.0f + __expf(-cv[q]));
        have = true;
      }
      __syncthreads();
      const int L = it / 192, n0 = (it - L * 192) * 32;
      const int col = n0 + (tid & 31), kp = tid >> 5;
      const float* w = p.in[I_ADAW] + (size_t)L * 1024 * 6144 + (size_t)(kp * 64) * 6144 + col;
      float a[9];
#pragma unroll
      for (int r = 0; r < 9; ++r) a[r] = 0.f;
      float wv[64];
#pragma unroll
      for (int k = 0; k < 64; ++k) wv[k] = w[(size_t)k * 6144];
#pragma unroll
      for (int k = 0; k < 64; ++k) {
#pragma unroll
        for (int r = 0; r < 9; ++r) a[r] += sc[r * 1024 + kp * 64 + k] * wv[k];
      }
#pragma unroll
      for (int r = 0; r < 9; ++r) red[(kp * 9 + r) * 32 + (tid & 31)] = a[r];
      __syncthreads();
      for (int o = tid; o < 288; o += NTHREADS) {
        const int r = o >> 5, cc = o & 31;
        float s = 0.f;
#pragma unroll
        for (int q = 0; q < 16; ++q) s += red[(q * 9 + r) * 32 + cc];
        ((float*)(ws + WS_MOD))[(size_t)(L * 9 + r) * 6144 + n0 + cc] = s + p.in[I_ADAB][L * 6144 + n0 + cc];
      }
    }
    __syncthreads();
  }
  LAS float* scr = (LAS float*)(lds + wave * 8448);
  const int gw = (nblocks - 1 - vb) * NWAVES + wave, NGW = nblocks * NWAVES;
  constexpr int J0 = 720, J1 = 96, J2 = 64, J3 = 512, J4 = 1536, J5 = 512, JS = 384, JR = 32, JE = NE * 384;
  constexpr int NIT = J0 + J1 + J2 + J3 + J4 + J5 + 2 * JS;
  for (int it0 = gw; it0 < NIT; it0 += NGW) {
    int it = it0;
    if (it < J0) { transpose_item(p.in[I_EVWIN], 1024, 1440, (bf16_t*)(ws + WS_WIN0), 1024, M_WIN0, nullptr, it, scr, lane); continue; } it -= J0;
    if (it < J1) { transpose_item(p.in[I_WUQ], 256, 768, (bf16_t*)(ws + WS_WUQ), 256, M_WUQ, p.in[I_QNW], it, scr, lane); continue; } it -= J1;
    if (it < J2) { transpose_item(p.in[I_WUKV], 128, 1024, (bf16_t*)(ws + WS_WUKV), 128, M_WUKV, p.in[I_KVNW], it, scr, lane); continue; } it -= J2;
    if (it < J3) { transpose_item(p.in[I_EVWOUT], 1024, 1024, (bf16_t*)(ws + WS_WOUT0), 1024, M_ID, nullptr, it, scr, lane); continue; } it -= J3;
    if (it < J4) { transpose_item8(p.in[I_ODWIN], 1024, 3072, ws + WS_WIN1, 1024, M_WIN1, F8_SW1, it, scr, lane); continue; } it -= J4;
    if (it < J5) { transpose_item(p.in[I_ODWOUT], 1024, 1024, (bf16_t*)(ws + WS_WOUT1), 1024, M_ID, nullptr, it, scr, lane); continue; } it -= J5;
    if (it < 2 * JS) {
      const int L = it / JS, r = it - L * JS;
      unsigned char* gu = ws + WS_WSGU + (size_t)L * 512 * 1024; unsigned char* dn = ws + WS_WSD + (size_t)L * 1024 * 256;
      if (r < 128) transpose_item8(p.in[I_SG] + (size_t)L * 1024 * 256, 1024, 256, gu, 1024, M_GATE, F8_SW1, r, scr, lane);
      else if (r < 256) transpose_item8(p.in[I_SU] + (size_t)L * 1024 * 256, 1024, 256, gu, 1024, M_UP, F8_SW1, r - 128, scr, lane);
      else transpose_item8(p.in[I_SD] + (size_t)L * 256 * 1024, 256, 1024, dn, 256, M_ID, F8_SW2, r - 256, scr, lane);
      continue;
    }
    it -= 2 * JS;
  }
}

__device__ __forceinline__ float norm_mod_row(const float4 (&v)[4], const float* nw, const float* sc, const float* sh, bf16_t* dhi, bf16_t* dlo, int lane, unsigned char* d8 = nullptr) {
  float ss = 0.f;
#pragma unroll
  for (int j = 0; j < 4; ++j) ss += (v[j].x * v[j].x + v[j].y * v[j].y) + (v[j].z * v[j].z + v[j].w * v[j].w);
  ss = wave_sum(ss);
  const float rstd = 1.0f / sqrtf(ss * (1.0f / 1024.0f) + EPS);
#pragma unroll
  for (int j = 0; j < 4; ++j) {
    const int c = lane + 64 * j;
    const float4 w = ((const float4*)nw)[c], s = ((const float4*)sc)[c], h = ((const float4*)sh)[c];
    const float y0 = v[j].x * rstd * w.x * (1.f + s.x) + h.x, y1 = v[j].y * rstd * w.y * (1.f + s.y) + h.y;
    const float y2 = v[j].z * rstd * w.z * (1.f + s.z) + h.z, y3 = v[j].w * rstd * w.w * (1.f + s.w) + h.w;
    uint2 hi; hi.x = pk2(y0, y1); hi.y = pk2(y2, y3);
    if (dhi) ((uint2*)dhi)[c] = hi;
    if (d8) ((unsigned*)d8)[c] = pack4_fp8c((f32x4){y0, y1, y2, y3} * F8_SA);
    if (dlo) { uint2 lo; lo.x = pk2(y0 - bflo(hi.x), y1 - bfhi(hi.x)); lo.y = pk2(y2 - bflo(hi.y), y3 - bfhi(hi.y)); ((uint2*)dlo)[c] = lo; }
  }
  return rstd;
}

__device__ __forceinline__ void a0_panel(const Params& p, int pan) {
  const int lane = threadIdx.x & 63, wave = threadIdx.x >> 6, c0 = lane * 16;
  const int b = (pan < 256) ? ((pan * 128) >> 12) : 8;
  const float* mod = opq((const float*)(p.ws + WS_MOD)) + (size_t)b * 6144; const float* nmix = opq(p.in[I_NMIX]);
  bf16_t* AF = (bf16_t*)(p.ws + WS_AF);
  float wa[16], sa[16];
#pragma unroll
  for (int i = 0; i < 16; ++i) { wa[i] = nmix[c0 + i] * (1.0f + mod[1024 + c0 + i]); sa[i] = mod[c0 + i]; }
#pragma unroll 1
  for (int i0 = 0; i0 < 16; i0 += 4) {
    float4 x[4][4];
#pragma unroll
    for (int u = 0; u < 4; ++u) {
      const int r = pan * 128 + wave + 8 * (i0 + u);
      const float* src = (r < T) ? p.in[I_X] + (size_t)r * D : p.in[I_CTX] + (size_t)(r - T) * D;
#pragma unroll
      for (int w = 0; w < 4; ++w) x[u][w] = ((const float4*)(src + c0))[w];
    }
#pragma unroll
    for (int u = 0; u < 4; ++u) {
      const int r = pan * 128 + wave + 8 * (i0 + u);
      float ss = 0.f;
#pragma unroll
      for (int w = 0; w < 4; ++w) ss += (x[u][w].x * x[u][w].x + x[u][w].y * x[u][w].y) + (x[u][w].z * x[u][w].z + x[u][w].w * x[u][w].w);
      ss = wave_sum(ss);
      const float rs = 1.0f / sqrtf(ss * (1.0f / 1024.0f) + EPS);
      u32x4 o[2];
#pragma unroll
      for (int w = 0; w < 4; ++w) {
        const float y0 = x[u][w].x * rs * wa[4 * w] + sa[4 * w], y1 = x[u][w].y * rs * wa[4 * w + 1] + sa[4 * w + 1];
        const float y2 = x[u][w].z * rs * wa[4 * w + 2] + sa[4 * w + 2], y3 = x[u][w].w * rs * wa[4 * w + 3] + sa[4 * w + 3];
        o[w >> 1][(w & 1) * 2] = pk2(y0, y1); o[w >> 1][(w & 1) * 2 + 1] = pk2(y2, y3);
      }
      ((u32x4*)(AF + (size_t)r * D + c0))[0] = o[0]; ((u32x4*)(AF + (size_t)r * D + c0))[1] = o[1];
    }
  }
}

__device__ __forceinline__ void ffnprep_panel(const Params& p, int L, int mt, lptr lds) {
  const int lane = threadIdx.x & 63, wave = threadIdx.x >> 6, c0 = lane * 16;
  const float* mod = opq((const float*)(p.ws + WS_MOD) + (size_t)L * 9 * 6144) + (size_t)((mt * 128) >> 12) * 6144; const float* nffn = opq(p.in[I_NFFN] + L * D);
  LAS float* rstd_t = (LAS float*)(lds + XLDS);
  asm volatile("s_waitcnt vmcnt(0)" ::: "memory");
  __syncthreads();
  float wa[16], sa[16];
#pragma unroll
  for (int i = 0; i < 16; ++i) { wa[i] = nffn[c0 + i] * (1.0f + mod[4096 + c0 + i]); sa[i] = mod[3072 + c0 + i]; }
#pragma unroll 1
  for (int i0 = 0; i0 < 16; i0 += 8) {
    u32x4 h[8][2];
#pragma unroll
    for (int u = 0; u < 8; ++u) {
      const int r = mt * 128 + wave + 8 * (i0 + u);
      h[u][0] = ((const u32x4*)(HROW(r) + c0))[0]; h[u][1] = ((const u32x4*)(HROW(r) + c0))[1];
    }
#pragma unroll
    for (int u = 0; u < 8; ++u) {
      const int r = mt * 128 + wave + 8 * (i0 + u);
      float v[16];
#pragma unroll
      for (int w = 0; w < 4; ++w) { v[2 * w] = bflo(h[u][0][w]); v[2 * w + 1] = bfhi(h[u][0][w]); v[8 + 2 * w] = bflo(h[u][1][w]); v[8 + 2 * w + 1] = bfhi(h[u][1][w]); }
      float ss = 0.f;
#pragma unroll
      for (int i = 0; i < 16; i += 4) ss += (v[i] * v[i] + v[i + 1] * v[i + 1]) + (v[i + 2] * v[i + 2] + v[i + 3] * v[i + 3]);
      ss = wave_sum(ss);
      const float rs = 1.0f / sqrtf(ss * (1.0f / 1024.0f) + EPS);
      u32x4 a8;
#pragma unroll
      for (int w = 0; w < 4; ++w) {
        f32x4 y;
#pragma unroll
        for (int e = 0; e < 4; ++e) y[e] = (v[4 * w + e] * rs * wa[4 * w + e] + sa[4 * w + e]) * F8_SA;
        a8[w] = pack4_fp8c(y);
      }
      *(u32x4*)(p.ws + WS_AF8 + (size_t)r * D + c0) = a8;
      if (lane == 0) rstd_t[wave + 8 * (i0 + u)] = rs;
    }
  }
}

__device__ __forceinline__ void inproj0_panel(const Params& p, lptr lds, int pan) {
  const int tid_ = opaque((int)threadIdx.x);
  const bf16_t* AF = (const bf16_t*)(p.ws + WS_AF); const bf16_t* W = (const bf16_t*)(p.ws + WS_WIN0);
  bf16_t* GLU = (bf16_t*)(p.ws + B_GLU); bf16_t* CQ = (bf16_t*)(p.ws + B_CQ); bf16_t* CKV = (bf16_t*)(p.ws + B_CKV); bf16_t* KR = (bf16_t*)(p.ws + B_KR);
  const int mt = pan, nj = (pan < 256) ? 6 : 1, nt0 = (pan < 256) ? 0 : 5;
  StrideLoader al, bl;
  al.p0 = AF + (size_t)(mt * 128 + ROW8(0)) * D + CO8; al.ld64 = 64 * D;
  bl.p0 = W + (size_t)(nt0 * 256 + ROW8(0)) * D + CO8; bl.ld64 = 64 * D;
  int st = 0;
  gemm_pre_at<4>(al, bl, st, lds);
#pragma unroll 1
  for (int j = 0; j < nj; ++j) {
    const int nt = nt0 + j;
    f32x4 acc[4][4]; zero_acc(acc);
    StrideLoader bln = bl; bln.p0 += (size_t)256 * D;
    gemm_chain<true, 4>(acc, al, bl, 16, lds, st, j + 1 < nj, al, bln);
    bl = bln;
    const int te = opaque(tid_), le = te & 63, we = te >> 6, wm = we >> 2, wn = we & 3, q4 = le >> 4;
    const size_t row0 = (size_t)mt * 128 + wm * 64 + (le & 15);
    if (nt < 4) {
#pragma unroll
      for (int mi = 0; mi < 4; ++mi) {
        f32x4 v[2];
#pragma unroll
        for (int j2 = 0; j2 < 2; ++j2) {
          const f32x4 a = acc[mi][2 * j2], g = acc[mi][2 * j2 + 1];
#pragma unroll
          for (int r = 0; r < 4; ++r) v[j2][r] = a[r] * sigmoid_fast(g[r]);
        }
        store_row2(GLU + (row0 + mi * 16) * 512 + nt * 128 + wn * 32, v[0], v[1], q4);
      }
    } else if (nt == 4) {
#pragma unroll
      for (int mi = 0; mi < 4; ++mi) store_row4(CQ + (row0 + mi * 16) * 256 + wn * 64, acc[mi][0], acc[mi][1], acc[mi][2], acc[mi][3], q4);
    } else if (wn < 2) {
#pragma unroll
      for (int mi = 0; mi < 4; ++mi) store_row4(CKV + (row0 + mi * 16) * 128 + wn * 64, acc[mi][0], acc[mi][1], acc[mi][2], acc[mi][3], q4);
    } else if (wn == 2) {
#pragma unroll
      for (int mi = 0; mi < 4; ++mi) store_row2(KR + (row0 + mi * 16) * 32, acc[mi][0], acc[mi][1], q4);
    }
  }
  __syncthreads();
}

constexpr float QSCALE = 0.14724445f;

__device__ __forceinline__ void rstd_rows(const bf16_t* A, int lda, int klen, float extra, lptr lds) {
  const int tid = threadIdx.x, r = tid >> 2, qd = tid & 3;
  const bf16_t* ptr = A + (size_t)r * lda + qd * (klen >> 2);
  float ss = 0.f;
  for (int c = 0; c < (klen >> 5); ++c) {
    const uint4 u = *(const uint4*)(ptr + c * 8);
    const unsigned w[4] = {u.x, u.y, u.z, u.w};
#pragma unroll
    for (int q = 0; q < 4; ++q) { const float a = bflo(w[q]), b = bfhi(w[q]); ss += a * a + b * b; }
  }
  ss += __shfl_xor(ss, 1); ss += __shfl_xor(ss, 2);
  __syncthreads();
  if (qd == 0) ((LAS float*)(lds + XLDS))[r] = extra / sqrtf(ss / (float)klen + EPS);
}

__device__ __forceinline__ void upproj_panel(const Params& p, lptr lds, int pan) {
  const int tid_ = opaque((int)threadIdx.x);
  const int tid = tid_, lane = tid & 63, wave = tid >> 6, wm = wave >> 2, wn = wave & 3, q4 = lane >> 4;
  unsigned char* ws = p.ws;
  const float2* rope = opq((const float2*)(ws + WS_ROPE));
  const LAS float* rs = (const LAS float*)(lds + XLDS);
  bf16_t* Q = (bf16_t*)(ws + B_Q); bf16_t* KB = (bf16_t*)(ws + B_K); bf16_t* VT = (bf16_t*)(ws + B_VT);
  const int mt = pan;
  if (pan < 256) {
    const bf16_t* CQ = (const bf16_t*)(ws + B_CQ); const bf16_t* W = (const bf16_t*)(ws + WS_WUQ);
    rstd_rows(CQ + (size_t)mt * 128 * 256, 256, 256, QSCALE, lds);
    {
      StrideLoader al, bl;
      al.p0 = CQ + (size_t)(mt * 128 + ROW8(0)) * 256 + CO8; al.ld64 = 64 * 256;
      bl.p0 = W + (size_t)ROW8(0) * 256 + CO8; bl.ld64 = 64 * 256;
      __syncthreads();
      int st = 0;
      gemm_pre_at<4>(al, bl, st, lds);
#pragma unroll 1
      for (int nt = 0; nt < 3; ++nt) {
        f32x4 acc[4][4]; zero_acc(acc);
        StrideLoader bln = bl; bln.p0 += (size_t)256 * 256;
        gemm_chain<true, 4>(acc, al, bl, 4, lds, st, nt < 2, al, bln);
        bl = bln;
        const int te = opaque(tid_), le = te & 63, we = te >> 6, wm2 = we >> 2, wn2 = we & 3, q = le >> 4;
        const int fcq = nt * 256 + wn2 * 64 + q * 16, headq = fcq / 96, d0q = fcq - headq * 96;
#pragma unroll
        for (int mi = 0; mi < 4; ++mi) {
          const int rl = wm2 * 64 + mi * 16 + (le & 15), row = mt * 128 + rl, b = row >> 12, tokb = row & 4095;
          const float rsv = rs[rl];
          f32x4 v[4];
#pragma unroll
          for (int nj = 0; nj < 4; ++nj) {
            const int fc = nt * 256 + wn2 * 64 + nj * 16, head = fc / 96, d0 = fc - head * 96;
            f32x4 x = acc[mi][nj] * rsv;
            if (d0 >= 64) {
              const int pos = (d0 >= 80) ? (tokb & 63) : (tokb >> 6);
              const float2 c0 = rope[pos * 8 + q * 2], c1 = rope[pos * 8 + q * 2 + 1];
              f32x4 o;
              o[0] = x[0] * c0.x - x[1] * c0.y; o[1] = x[1] * c0.x + x[0] * c0.y;
              o[2] = x[2] * c1.x - x[3] * c1.y; o[3] = x[3] * c1.x + x[2] * c1.y;
              x = o;
            }
            v[nj] = x;
          }
          store_group4(Q + ((size_t)(b * NH + headq) * SEQ + tokb) * DQK + d0q, v[0], v[1], v[2], v[3]);
        }
      }
      __syncthreads();
    }
  }
  {
    const bf16_t* CKV = (const bf16_t*)(ws + B_CKV); const bf16_t* W = (const bf16_t*)(ws + WS_WUKV);
    rstd_rows(CKV + (size_t)mt * 128 * 128, 128, 128, 1.0f, lds);
#pragma unroll 1
    for (int nt = 0; nt < 4; ++nt) {
      StrideLoader al, bl;
      al.p0 = CKV + (size_t)(mt * 128 + ROW8(0)) * 128 + CO8; al.ld64 = 64 * 128;
      bl.p0 = W + (size_t)(nt * 256 + ROW8(0)) * 128 + CO8; bl.ld64 = 64 * 128;
      f32x4 acc[4][4]; zero_acc(acc);
      if (nt < 2) {
        gemm_core<true, 4>(acc, al, bl, 2, lds);
        ep_banded<256>(lds, PutPlain<4>{acc}, [&](int rl, int colt, f32x4 v) {
          const int r = mt * 128 + rl;
          int b, key; if (r < T) { b = r >> 12; key = CL + (r & 4095); } else { const int rc = r - T; b = rc >> 8; key = rc & 255; }
          const int col = nt * 256 + colt, h = col >> 6, d = col & 63;
          *(uint2*)(KB + ((size_t)(b * NH + h) * NKEY + key) * DQK + d) = pack4(v * rs[rl]);
        });
      } else {
        gemm_core<false, 4>(acc, al, bl, 2, lds);
#pragma unroll
        for (int mi = 0; mi < 4; ++mi)
#pragma unroll
          for (int nj = 0; nj < 4; ++nj)
            *(LAS f32x4*)(lds + (wn * 64 + nj * 16 + (lane & 15)) * EPT_PITCH + (wm * 64 + mi * 16 + q4 * 4) * 4) = acc[mi][nj];
        __syncthreads();
#pragma unroll 4
        for (int idx = tid; idx < 256 * 32; idx += NTHREADS) {
          const int cr = idx >> 5, t4 = (idx & 31) * 4;
          f32x4 v = *(const LAS f32x4*)(lds + cr * EPT_PITCH + t4 * 4);
          v[0] *= rs[t4]; v[1] *= rs[t4 + 1]; v[2] *= rs[t4 + 2]; v[3] *= rs[t4 + 3];
          const int r = mt * 128 + t4;
          int b, key; if (r < T) { b = r >> 12; key = CL + (r & 4095); } else { const int rc = r - T; b = rc >> 8; key = rc & 255; }
          const int n = (nt - 2) * 256 + cr, h = n >> 6, dv = n & 63;
          *(uint2*)(VT + ((size_t)(b * NH + h) * DV + dv) * NKEY + key) = pack4(v);
        }
        __syncthreads();
      }
    }
  }
  {
    const bf16_t* KR = (const bf16_t*)(ws + B_KR);
#pragma unroll
    for (int i = 0; i < 2; ++i) {
      const int idx = pan * 1024 + tid + NTHREADS * i;
      const int r = idx >> 3, pc = idx & 7;
      const uint2 u = *(const uint2*)(KR + (size_t)r * 32 + pc * 4);
      float v0 = bflo(u.x), v1 = bfhi(u.x), v2 = bflo(u.y), v3 = bfhi(u.y);
      int b, key;
      if (r < T) {
        b = r >> 12; const int tokb = r & 4095; key = CL + tokb;
        const int pos = (pc >= 4) ? (tokb & 63) : (tokb >> 6), jb = (pc & 3) * 2;
        const float2 c0 = rope[pos * 8 + jb], c1 = rope[pos * 8 + jb + 1];
        const float o0 = v0 * c0.x - v1 * c0.y, o1 = v1 * c0.x + v0 * c0.y, o2 = v2 * c1.x - v3 * c1.y, o3 = v3 * c1.x + v2 * c1.y;
        v0 = o0; v1 = o1; v2 = o2; v3 = o3;
      } else { const int rc = r - T; b = rc >> 8; key = rc & 255; }
      uint2 o; o.x = pk2(v0, v1); o.y = pk2(v2, v3);
#pragma unroll
      for (int h = 0; h < NH; ++h) *(uint2*)(KB + ((size_t)(b * NH + h) * NKEY + key) * DQK + 64 + pc * 4) = o;
    }
  }
}

__device__ __forceinline__ void conv_units(const Params& p, lptr lds, int vb, int nblocks) {
  const int tid = threadIdx.x, lane = tid & 63, wave = tid >> 6;
  unsigned char* ws = p.ws;
  {
    const bf16_t* GLU = (const bf16_t*)(ws + B_GLU); bf16_t* OCAT = (bf16_t*)(ws + B_OCAT);
    const float* cw = p.in[I_EVCW]; const float* cb = p.in[I_EVCB]; const float* lw = p.in[I_EVLNW]; const float* lb = p.in[I_EVLNB];
    const int cp = tid & 255, th = tid >> 8;
    const lptr outl = lds + 65536;
    for (int u = vb; u < NB * 128; u += nblocks) {
      const int b = u >> 7, t0 = (u & 127) * 32;
      __syncthreads();
      for (int c = tid; c < 62 * 64; c += NTHREADS) {
        const int ti = c >> 6, ch = c & 63, tok = t0 - 15 + ti;
        uint4 v = make_uint4(0, 0, 0, 0);
        if (tok >= 0 && tok < SEQ) v = *(const uint4*)(GLU + ((size_t)(b * SEQ + tok)) * 512 + ch * 8);
        lds_w16(lds + ti * 1024 + ch * 16, v);
      }
      __syncthreads();
      float a0[16], a1[16];
#pragma unroll
      for (int k = 0; k < 16; ++k) { a0[k] = 0.f; a1[k] = 0.f; }
      for (int tap = 0; tap < 31; ++tap) {
        const float2 w = *(const float2*)(cw + tap * 512 + 2 * cp);
#pragma unroll
        for (int k = 0; k < 16; ++k) {
          const unsigned x = *(const LAS unsigned*)(lds + (th * 16 + k + tap) * 1024 + cp * 4);
          a0[k] += w.x * bflo(x); a1[k] += w.y * bfhi(x);
        }
      }
      const float2 bias = *(const float2*)(cb + 2 * cp);
#pragma unroll
      for (int k = 0; k < 16; ++k) *(LAS f32x2*)(outl + ((th * 16 + k) * 512 + 2 * cp) * 4) = (f32x2){a0[k] + bias.x, a1[k] + bias.y};
      __syncthreads();
#pragma unroll 1
      for (int q = 0; q < 4; ++q) {
        const int tk = wave * 4 + q;
        const f32x4 x0 = *(const LAS f32x4*)(outl + (tk * 512 + lane * 8) * 4), x1 = *(const LAS f32x4*)(outl + (tk * 512 + lane * 8 + 4) * 4);
        float s = (x0.x + x0.y) + (x0.z + x0.w) + (x1.x + x1.y) + (x1.z + x1.w);
        s = wave_sum(s);
        const float mean = s * (1.0f / 512.0f);
        const float d[8] = {x0.x - mean, x0.y - mean, x0.z - mean, x0.w - mean, x1.x - mean, x1.y - mean, x1.z - mean, x1.w - mean};
        float ss = 0.f;
#pragma unroll
        for (int e = 0; e < 8; ++e) ss += d[e] * d[e];
        ss = wave_sum(ss);
        const float rstd = 1.0f / sqrtf(ss * (1.0f / 512.0f) + EPS);
        const float4 w0 = *(const float4*)(lw + lane * 8), w1 = *(const float4*)(lw + lane * 8 + 4), b0 = *(const float4*)(lb + lane * 8), b1 = *(const float4*)(lb + lane * 8 + 4);
        const float wv[8] = {w0.x, w0.y, w0.z, w0.w, w1.x, w1.y, w1.z, w1.w}, bv[8] = {b0.x, b0.y, b0.z, b0.w, b1.x, b1.y, b1.z, b1.w};
        float y[8];
#pragma unroll
        for (int e = 0; e < 8; ++e) { const float z = d[e] * rstd * wv[e] + bv[e]; y[e] = z * sigmoid_fast(z); }
        uint4 o; o.x = pk2(y[0], y[1]); o.y = pk2(y[2], y[3]); o.z = pk2(y[4], y[5]); o.w = pk2(y[6], y[7]);
        *(uint4*)(OCAT + ((size_t)(b * SEQ + t0 + tk)) * D + lane * 8) = o;
      }
    }
    __syncthreads();
  }
}

__device__ __forceinline__ void phase4(const Params& p, lptr lds, int vb, int nblocks) {
  const int tid = threadIdx.x, lane = tid & 63, wave = __builtin_amdgcn_readfirstlane(tid >> 6), q4 = lane >> 4, li = lane & 15;
  const bf16_t* Q = (const bf16_t*)(p.ws + B_Q); const bf16_t* KB = (const bf16_t*)(p.ws + B_K); const bf16_t* VT = (const bf16_t*)(p.ws + B_VT);
  bf16_t* OCAT = (bf16_t*)(p.ws + B_OCAT);
  constexpr int STG = 20480, NKT = NKEY / 64, NQF = 4, QW = 16 * NQF, QU = 8 * QW;
  int koff[4], voff[2];
#pragma unroll
  for (int f = 0; f < 4; ++f) {
    const int row = 32 * (f >> 1) + 8 * (li >> 2) + 4 * (f & 1) + (li & 3);
    koff[f] = row * 192 + ((q4 ^ ((row >> 2) & 3)) << 4);
  }
#pragma unroll
  for (int g = 0; g < 2; ++g) voff[g] = 12288 + li * 128 + ((((4 * g + q4) ^ (lane & 7))) << 4);
  int soff[3]; bool isk[3];
#pragma unroll
  for (int i = 0; i < 3; ++i) {
    const int pi = wave + 8 * i;
    if (pi < 12) { const int P = pi * 1024 + lane * 16, row = P / 192, rem = P - row * 192, ks = rem >> 6, pq = (rem & 63) >> 4; soff[i] = row * DQK + ks * 32 + ((pq ^ ((row >> 2) & 3)) << 3); isk[i] = true; }
    else { const int P = (pi - 12) * 1024 + lane * 16, dv = P >> 7, pc = (P & 127) >> 4; soff[i] = dv * NKEY + ((pc ^ (dv & 7)) << 3); isk[i] = false; }
  }
  const bool three = wave < 4;
  if (wave < 4) __builtin_amdgcn_s_setprio(2);
  constexpr int UPB = SEQ / QU;
  for (int unit = vb; unit < NB * NH * UPB; unit += nblocks) {
    const int qb = unit % UPB, bh = unit / UPB;
    const bf16_t* Qp = Q + ((size_t)bh * SEQ + qb * QU + wave * QW) * DQK;
    const bf16_t* Kp = KB + (size_t)bh * NKEY * DQK;
    const bf16_t* Vp = VT + (size_t)bh * DV * NKEY;
    bf16x8 qf[NQF][3];
#pragma unroll
    for (int f2 = 0; f2 < NQF; ++f2)
#pragma unroll
      for (int ks = 0; ks < 3; ++ks) qf[f2][ks] = *(const bf16x8*)(Qp + (f2 * 16 + li) * DQK + ks * 32 + q4 * 8);
    WAIT_VM(0);
#define ATT_ISSUE(kt_, stage_) do { \
      _Pragma("unroll") for (int i_ = 0; i_ < 3; ++i_) { if (i_ < 2 || three) { \
        const bf16_t* g_ = isk[i_] ? Kp + (size_t)(kt_) * 64 * DQK + soff[i_] : Vp + (kt_) * 64 + soff[i_]; \
        glds16(g_, lds + (stage_) * STG + (wave + 8 * i_) * 1024); } } } while (0)
#pragma unroll
    for (int t = 0; t < 3; ++t) ATT_ISSUE(t, t);
    f32x4 o[4][NQF];
    float mrun[NQF], lrun[NQF];
#pragma unroll
    for (int f2 = 0; f2 < NQF; ++f2) { mrun[f2] = -1000.f; lrun[f2] = 0.f;
#pragma unroll
      for (int a = 0; a < 4; ++a) o[a][f2] = (f32x4){0.f, 0.f, 0.f, 0.f}; }
    int st = 0;
    for (int kt = 0; kt < NKT; ++kt) {
      if (kt + 2 < NKT) { if (three) WAIT_VM(6); else WAIT_VM(4); }
      else if (kt + 1 < NKT) { if (three) WAIT_VM(3); else WAIT_VM(2); }
      else WAIT_VM(0);
      asm volatile("s_waitcnt lgkmcnt(0)" ::: "memory");
      __builtin_amdgcn_s_barrier();
      asm volatile("" ::: "memory");
      if (kt + 3 < NKT) ATT_ISSUE(kt + 3, (st + 3) & 3);
      const lptr cur = lds + st * STG;
#pragma unroll
      for (int hh = 0; hh < NQF / 2; ++hh) {
        f32x4 s[2][4];
#pragma unroll
        for (int f2 = 0; f2 < 2; ++f2)
#pragma unroll
          for (int f = 0; f < 4; ++f) { const float nm = -mrun[2 * hh + f2]; s[f2][f] = (f32x4){nm, nm, nm, nm}; }
#pragma unroll
        for (int ks = 0; ks < 3; ++ks)
#pragma unroll
          for (int f = 0; f < 4; ++f) {
            const bf16x8 kf = lds_r16(cur + koff[f] + ks * 64);
            s[0][f] = __builtin_amdgcn_mfma_f32_16x16x32_bf16(kf, qf[2 * hh][ks], s[0][f], 0, 0, 0);
            s[1][f] = __builtin_amdgcn_mfma_f32_16x16x32_bf16(kf, qf[2 * hh + 1][ks], s[1][f], 0, 0, 0);
          }
        bf16x8 pf[2][2];
        float mx[2];
#pragma unroll
        for (int f2 = 0; f2 < 2; ++f2) {
          float m_ = s[f2][0][0];
#pragma unroll
          for (int f = 0; f < 4; ++f)
#pragma unroll
            for (int r = 0; r < 4; ++r) m_ = fmaxf(m_, s[f2][f][r]);
          mx[f2] = m_;
        }
        if (!__all(fmaxf(mx[0], mx[1]) <= 6.0f)) {
#pragma unroll
          for (int f2 = 0; f2 < 2; ++f2) {
            const int q = 2 * hh + f2;
            float m_ = mx[f2];
            m_ = fmaxf(m_, __shfl_xor(m_, 16)); m_ = fmaxf(m_, __shfl_xor(m_, 32));
            const float d = fmaxf(m_, 0.f);
            const float alpha = __builtin_amdgcn_exp2f(-d);
            mrun[q] += d; lrun[q] *= alpha;
#pragma unroll
            for (int a = 0; a < 4; ++a) o[a][q] = o[a][q] * alpha;
#pragma unroll
            for (int f = 0; f < 4; ++f) s[f2][f] = s[f2][f] - d;
          }
        }
#pragma unroll
        for (int f2 = 0; f2 < 2; ++f2) {
          const int q = 2 * hh + f2;
          float rsum = 0.f;
#pragma unroll
          for (int f = 0; f < 4; ++f)
#pragma unroll
            for (int r = 0; r < 4; ++r) { const float e = __builtin_amdgcn_exp2f(s[f2][f][r]); s[f2][f][r] = e; rsum += e; }
          lrun[q] += rsum;
#pragma unroll
          for (int g = 0; g < 2; ++g) {
            union { bf16x8 v; unsigned u[4]; } cv;
            cv.u[0] = pk2(s[f2][2 * g][0], s[f2][2 * g][1]); cv.u[1] = pk2(s[f2][2 * g][2], s[f2][2 * g][3]);
            cv.u[2] = pk2(s[f2][2 * g + 1][0], s[f2][2 * g + 1][1]); cv.u[3] = pk2(s[f2][2 * g + 1][2], s[f2][2 * g + 1][3]);
            pf[f2][g] = cv.v;
          }
        }
#pragma unroll
        for (int g = 0; g < 2; ++g)
#pragma unroll
          for (int a = 0; a < 4; ++a) {
            const bf16x8 vf = lds_r16(cur + voff[g] + a * 2048);
            o[a][2 * hh] = __builtin_amdgcn_mfma_f32_16x16x32_bf16(vf, pf[0][g], o[a][2 * hh], 0, 0, 0);
            o[a][2 * hh + 1] = __builtin_amdgcn_mfma_f32_16x16x32_bf16(vf, pf[1][g], o[a][2 * hh + 1], 0, 0, 0);
          }
        __builtin_amdgcn_sched_barrier(0);
      }
      st = (st + 1) & 3;
    }
    __syncthreads();
    const int b = bh >> 3, h = bh & 7;
#pragma unroll
    for (int f2 = 0; f2 < NQF; ++f2) {
      float lt = lrun[f2]; lt += __shfl_xor(lt, 16); lt += __shfl_xor(lt, 32);
      const float inv = 1.0f / lt;
      const size_t row = (size_t)b * SEQ + qb * QU + wave * QW + f2 * 16 + li;
      store_row4(OCAT + row * D + 512 + h * 64, o[0][f2] * inv, o[1][f2] * inv, o[2][f2] * inv, o[3][f2] * inv, q4);
    }
  }
#undef ATT_ISSUE
  __builtin_amdgcn_s_setprio(0);
}

__device__ __forceinline__ void outproj_panel(const Params& p, int L, lptr lds, int mt) {
  const int tid_ = opaque((int)threadIdx.x);
  const bf16_t* A = (const bf16_t*)(p.ws + (L == 0 ? B_OCAT : B_S)); const bf16_t* W = (const bf16_t*)(p.ws + (L == 0 ? WS_WOUT0 : WS_WOUT1));
  const float* mod = (const float*)(p.ws + WS_MOD) + (size_t)L * 9 * 6144;
  StrideLoader al, bl;
  al.p0 = A + (size_t)(mt * 128 + ROW8(0)) * D + CO8; al.ld64 = 64 * D;
  bl.p0 = W + (size_t)ROW8(0) * D + CO8; bl.ld64 = 64 * D;
  int st = 0;
  gemm_pre_at<4>(al, bl, st, lds);
#pragma unroll 1
  for (int nt = 0; nt < 4; ++nt) {
    f32x4 acc[4][4]; zero_acc(acc);
    StrideLoader bln = bl; bln.p0 += (size_t)256 * D;
    gemm_chain<true, 4>(acc, al, bl, 16, lds, st, nt < 3, al, bln);
    bl = bln;
    const int te = opaque(tid_), le = te & 63, we = te >> 6, wm = we >> 2, wn = we & 3, q4 = le >> 4;
#pragma unroll
    for (int mi = 0; mi < 4; ++mi) {
      const int row = mt * 128 + wm * 64 + mi * 16 + (le & 15), b = (mt * 128) >> 12;
      bf16_t* hrow = HROW(row) + nt * 256 + wn * 64;
      f32x4 xv[4];
      if (L == 0) {
#pragma unroll
        for (int n4 = 0; n4 < 4; ++n4) xv[n4] = *(const f32x4*)(p.in[I_X] + (size_t)row * D + nt * 256 + wn * 64 + n4 * 16 + q4 * 4);
      } else {
        const u32x4 t0 = ((const u32x4*)(hrow + q4 * 16))[0], t1 = ((const u32x4*)(hrow + q4 * 16))[1];
        uint2 ha = make_uint2(t0[0], t0[1]), hb = make_uint2(t0[2], t0[3]), hc = make_uint2(t1[0], t1[1]), hd = make_uint2(t1[2], t1[3]);
        tr4x4(ha.x, hb.x, hc.x, hd.x); tr4x4(ha.y, hb.y, hc.y, hd.y);
        xv[0] = unpack4(ha); xv[1] = unpack4(hb); xv[2] = unpack4(hc); xv[3] = unpack4(hd);
      }
#pragma unroll
      for (int n4 = 0; n4 < 4; ++n4) {
        const f32x4 g1 = *(const f32x4*)(mod + (size_t)b * 6144 + 2048 + nt * 256 + wn * 64 + n4 * 16 + q4 * 4);
        xv[n4] = xv[n4] + g1 * acc[mi][n4];
      }
      store_row4(hrow, xv[0], xv[1], xv[2], xv[3], q4);
    }
  }
  __syncthreads();
}

__device__ __forceinline__ void expert_unit(const Params& p, int L, const bf16_t* Wgu, const bf16_t* Wd, const int* list, int nvalid, int m0, lptr lds, int dry = 0) {
  const int tid = opaque((int)threadIdx.x), tid_ = tid;
  const bf16_t* AF = (const bf16_t*)(p.ws + WS_AF8);
  LAS int* info = (LAS int*)(lds + XLDS + 512);
  LAS float* wrow = (LAS float*)(lds + XLDS);
  __syncthreads();
  if (tid < 128) {
    const int inf = list ? ((tid < nvalid) ? list[tid] : -1) : ((m0 + tid) * 8 + 7);
    info[tid] = inf;
    wrow[tid] = (inf >= 0 && (inf & 7) != 7) ? ((const float*)(p.ws + WS_WTS))[inf] : 1.0f;
  }
  __syncthreads();
  {
    RowLoader2 al; StrideLoader bl;
#pragma unroll
    for (int i = 0; i < 2; ++i) { const int inf = info[ROW8(i)]; al.p[i] = AF + (size_t)((inf >= 0) ? (inf >> 3) : 0) * 512 + CO8; }
    bl.p0 = Wgu + (size_t)ROW8(0) * 512 + CO8; bl.ld64 = 64 * 512;
    int st = 0;
    gemm_pre_at<4>(al, bl, st, lds);
    uint2 actr[2][4];
#define EU_STEP1_TILE(NT_) do { \
      f32x4 acc[4][4]; zero_acc(acc); \
      StrideLoader bln = bl; bln.p0 += (size_t)256 * 512; \
      gemm_chain8<4>(acc, al, bl, 8, lds, st, (NT_) == 0, al, bln); \
      bl = bln; \
      _Pragma("unroll") for (int mi = 0; mi < 4; ++mi) { \
        unsigned x[2]; \
        _Pragma("unroll") for (int j2 = 0; j2 < 2; ++j2) { \
          const f32x4 g = acc[mi][2 * j2], u = acc[mi][2 * j2 + 1]; f32x4 v; \
          _Pragma("unroll") for (int r = 0; r < 4; ++r) { const float gg = g[r] * F8_INV; v[r] = gg * sigmoid_fast(gg) * u[r] * (F8_INV * F8_SACT); } \
          x[j2] = pack4_fp8c(v); } \
        { auto r = __builtin_amdgcn_permlane16_swap(x[0], x[1], false, false); x[0] = r[0]; x[1] = r[1]; }     \
        actr[NT_][mi] = make_uint2(x[0], x[1]); } } while (0)
    EU_STEP1_TILE(0);
    EU_STEP1_TILE(1);
#undef EU_STEP1_TILE
    __syncthreads();
    {
      const int te = opaque(tid), le = te & 63, we = te >> 6, wm = we >> 2, wn = we & 3, q4 = le >> 4;
#pragma unroll
      for (int t = 0; t < 2; ++t)
#pragma unroll
        for (int mi = 0; mi < 4; ++mi) {
          const int r = wm * 64 + mi * 16 + (le & 15), c = wn * 2 + (q4 & 1);
          *(LAS u32x2*)(lds + t * 49152 + r * 128 + ((c ^ (r & 7)) << 4) + (q4 >> 1) * 8) = (u32x2){actr[t][mi].x, actr[t][mi].y};
        }
    }
  }
  const bool shared_u = (list == nullptr);
  unsigned char* CONTRIB = p.ws + B_CONTRIB; unsigned char* SHC = p.ws + B_SHC;
  {
    StrideLoader bl;
    bl.p0 = Wd + (size_t)ROW8(0) * 128 + CO8; bl.ld64 = 64 * 128;
    int st = 0;
    gemm_pre_at<4, true>(bl, bl, st, lds);
#pragma unroll 1
    for (int nt = 0; nt < 4; ++nt) {
      f32x4 acc[4][4]; zero_acc(acc);
      StrideLoader bln = bl; bln.p0 += (size_t)256 * 128;
      gemm_chain8<4, true>(acc, bl, bl, 2, lds, st, nt < 3, bl, bln);
      bl = bln;
      {
        const int te = opaque(tid), le = te & 63, we = te >> 6, wm = we >> 2, wn = we & 3, q4 = le >> 4;
#pragma unroll
        for (int mi = 0; mi < 4; ++mi) {
          const int rl = wm * 64 + mi * 16 + (le & 15);
          const int inf = info[rl];
          const int tok = inf >> 3, k = inf & 7;
          const float w = wrow[rl] * F8_INV;
          {
            unsigned x0 = pack4_fp8c(acc[mi][0] * w), x1 = pack4_fp8c(acc[mi][1] * w), x2 = pack4_fp8c(acc[mi][2] * w), x3 = pack4_fp8c(acc[mi][3] * w);
            tr4x4(x0, x1, x2, x3);
            unsigned char* dstrow = shared_u ? SHC + (size_t)tok * D : CONTRIB + ((size_t)tok * 6 + k) * D;
            if (inf >= 0 && !dry) __builtin_nontemporal_store((u32x4){x0, x1, x2, x3}, (u32x4*)(dstrow + nt * 256 + wn * 64 + q4 * 16));
          }
        }
      }
    }
  }
  __syncthreads();
}

__device__ __forceinline__ void router_fold(const Params& p, int L, int b, lptr lds) {
  const int tid = threadIdx.x;
  const float* W = p.in[I_RW] + (size_t)L * 1024 * 64; const float* nw = p.in[I_NFFN] + L * D;
  const float* sc = (const float*)(p.ws + WS_MOD) + (size_t)(L * 9 + b) * 6144 + 4096; const float* sh = (const float*)(p.ws + WS_MOD) + (size_t)(L * 9 + b) * 6144 + 3072;
  bf16_t* dst = (bf16_t*)(p.ws + WS_WRB) + (size_t)(L * 8 + b) * 128 * 1024;
  const int e = tid & 63;
  float cpart = 0.f;
  for (int kg = tid >> 6; kg < 128; kg += 8) {
    float v[8];
#pragma unroll
    for (int q = 0; q < 8; ++q) { const int k = kg * 8 + q; const float w = W[(size_t)k * 64 + e]; v[q] = w * nw[k] * (1.0f + sc[k]); cpart += sh[k] * w; }
    unsigned hb[4], lb[4];
#pragma unroll
    for (int q = 0; q < 4; ++q) { hb[q] = pk2(v[2 * q], v[2 * q + 1]); lb[q] = pk2(v[2 * q] - bflo(hb[q]), v[2 * q + 1] - bfhi(hb[q])); }
    bf16_t* dh = dst + (size_t)((e >> 4) * 32 + (e & 15)) * 1024 + kg * 8;
    *(uint4*)dh = make_uint4(hb[0], hb[1], hb[2], hb[3]);
    *(uint4*)(dh + 16 * 1024) = make_uint4(lb[0], lb[1], lb[2], lb[3]);
  }
  LAS float* red = (LAS float*)lds;
  __syncthreads();
  red[tid] = cpart;
  __syncthreads();
  if (tid < 64) { float s_ = 0.f; for (int q = 0; q < 8; ++q) s_ += red[q * 64 + tid]; ((float*)(p.ws + WS_RC))[(L * 8 + b) * 64 + tid] = s_; }
  __syncthreads();
}

__device__ __forceinline__ void router_gemm(f32x4 (&acc)[4][2], const bf16_t* ph, const bf16_t* pb, lptr lds) {
  constexpr int STG = 32768, B_OFF = 16384, NKT = 16;
  const int tid = opaque((int)threadIdx.x), lane = tid & 63, wave = __builtin_amdgcn_readfirstlane(tid >> 6), wm = wave >> 2, wn = wave & 3;
  int aoff[2], boff[2];
#pragma unroll
  for (int ks = 0; ks < 2; ++ks) {
    const int sw = (((ks * 4 + (lane >> 4)) ^ (lane & 7)) << 4);
    aoff[ks] = (wm * 64 + (lane & 15)) * 128 + sw;
    boff[ks] = B_OFF + (wn * 32 + (lane & 15)) * 128 + sw;
  }
  const int wbase = wave * 1024;
#define RG_ISSUE(t_) do { const int t__ = (t_); const lptr sb_ = lds + (t__ & 3) * STG + wbase; \
    const bf16_t* ap_ = ph + t__ * 64; const bf16_t* bp_ = pb + t__ * 64; \
    glds16(ap_, sb_); glds16(ap_ + (size_t)64 * 2048, sb_ + 8192); glds16(bp_, sb_ + B_OFF); glds16(bp_ + (size_t)64 * 1024, sb_ + B_OFF + 8192); } while (0)
  RG_ISSUE(0); RG_ISSUE(1); RG_ISSUE(2);
#pragma unroll 1
  for (int kt = 0; kt < NKT; ++kt) {
    if (kt + 2 < NKT) WAIT_VM(8); else if (kt + 1 < NKT) WAIT_VM(4); else WAIT_VM(0);
    asm volatile("s_waitcnt lgkmcnt(0)" ::: "memory");
    __builtin_amdgcn_s_barrier();
    asm volatile("" ::: "memory");
    const lptr base = lds + (kt & 3) * STG;
#pragma unroll
    for (int ks = 0; ks < 2; ++ks) {
      bf16x8 af[4], bfr[2];
#pragma unroll
      for (int i = 0; i < 4; ++i) af[i] = lds_r16(base + aoff[ks] + i * 2048);
#pragma unroll
      for (int j = 0; j < 2; ++j) bfr[j] = lds_r16(base + boff[ks] + j * 2048);
      if (ks == 1 && kt + 3 < NKT) RG_ISSUE(kt + 3);
#pragma unroll
      for (int i = 0; i < 4; ++i)
#pragma unroll
        for (int j = 0; j < 2; ++j) acc[i][j] = __builtin_amdgcn_mfma_f32_16x16x32_bf16(bfr[j], af[i], acc[i][j], 0, 0, 0);
    }
  }
#undef RG_ISSUE
  __syncthreads();
}

struct RouterA {
  static constexpr bool DIRECT = true;
  typedef uint4 Raw; const bf16_t* ph; const bf16_t* pl;
  __device__ __forceinline__ const bf16_t* gp(int i, int kt) const { return ((kt >= 16 && kt < 32) ? pl + (kt - 16) * 64 : ph + (kt & 15) * 64) + (size_t)i * 64 * D; }
  __device__ __forceinline__ void pre(int) {}
  __device__ __forceinline__ Raw ld(int, int) const { return make_uint4(0, 0, 0, 0); }
  __device__ __forceinline__ uint4 cvt(const Raw& r, int) const { return r; }
};

__device__ __forceinline__ void router_tile(const Params& p, int L, lptr lds, int mt) {
  const int tid_ = opaque((int)threadIdx.x);
  const bool dry = false;
  const int tid = tid_, lane = tid & 63, wave = tid >> 6, wm = wave >> 2, wn = wave & 3, q4 = lane >> 4;
  unsigned char* ws = p.ws;
  const int bb = (mt * 128) >> 12;
  const bf16_t* WR = (const bf16_t*)(ws + WS_WRB) + (size_t)(L * 8 + bb) * 128 * 1024;
  const float* rc = (const float*)(ws + WS_RC) + (L * 8 + bb) * 64;
  int* counts = (int*)(ws + WS_CNT) + L * NE; int* lists = (int*)(ws + WS_LISTS); float* wts = (float*)(ws + WS_WTS);
  const float* rbias = opq(p.in[I_RB] + L * NE);
  {
    {
      f32x4 acc[4][2]; zero_acc(acc);
      router_gemm(acc, HROW(mt * 128 + ROW8(0)) + CO8, WR + (size_t)ROW8(0) * 1024 + CO8, lds);
      LAS float* lg = (LAS float*)lds;
      LAS float* sg = (LAS float*)(lds + 33280);
      LAS int* lcnt = (LAS int*)(lds + XLDS + 1280);
      const LAS float* rstd_t = (const LAS float*)(lds + XLDS);
#pragma unroll
      for (int mi = 0; mi < 4; ++mi)
#pragma unroll
        for (int r = 0; r < 4; ++r) lg[(wm * 64 + mi * 16 + (lane & 15)) * 65 + wn * 16 + q4 * 4 + r] = (acc[mi][0][r] + acc[mi][1][r]) * rstd_t[wm * 64 + mi * 16 + (lane & 15)] + rc[wn * 16 + q4 * 4 + r];
      if (tid < 64) lcnt[tid] = 0;
      __syncthreads();
      int eidx[TOPK]; int lslot[TOPK]; float wk[TOPK];
      const int tokl = tid >> 2, part = tid & 3;
      {
        const LAS float* lr = lg + tokl * 65 + part * 16;
        float sc[16], v[16];
#pragma unroll
        for (int j = 0; j < 16; ++j) { sc[j] = sigmoidf_(lr[j]); v[j] = sc[j] + rbias[part * 16 + j]; }
        float gs[2];
#pragma unroll
        for (int g = 0; g < 2; ++g) {
          float m1 = -INFINITY, m2 = -INFINITY;
#pragma unroll
          for (int j = 0; j < 8; ++j) { const float x = v[g * 8 + j]; if (x > m1) { m2 = m1; m1 = x; } else if (x > m2) m2 = x; }
          gs[g] = m1 + m2;
        }
        int rank0 = (gs[1] > gs[0]) ? 1 : 0, rank1 = (gs[0] >= gs[1]) ? 1 : 0;
#pragma unroll
        for (int m = 1; m < 4; ++m) {
          const float o0 = __shfl_xor(gs[0], m), o1 = __shfl_xor(gs[1], m);
          const bool lower = (part ^ m) < part;
          rank0 += ((o0 > gs[0]) || (o0 == gs[0] && lower)) ? 1 : 0; rank0 += ((o1 > gs[0]) || (o1 == gs[0] && lower)) ? 1 : 0;
          rank1 += ((o0 > gs[1]) || (o0 == gs[1] && lower)) ? 1 : 0; rank1 += ((o1 > gs[1]) || (o1 == gs[1] && lower)) ? 1 : 0;
        }
#pragma unroll
        for (int j = 0; j < 16; ++j) if ((j < 8 ? rank0 : rank1) >= 4) v[j] = -INFINITY;
        float ssum = 0.f;
#pragma unroll
        for (int k = 0; k < TOPK; ++k) {
          float best = v[0], bsc = sc[0]; int bi = 0;
#pragma unroll
          for (int j = 1; j < 16; ++j) if (v[j] > best) { best = v[j]; bsc = sc[j]; bi = j; }
          int gi = part * 16 + bi;
#pragma unroll
          for (int m = 1; m < 4; m <<= 1) {
            const float ob = __shfl_xor(best, m), os = __shfl_xor(bsc, m); const int oi = __shfl_xor(gi, m);
            if (ob > best || (ob == best && oi < gi)) { best = ob; bsc = os; gi = oi; }
          }
          eidx[k] = gi; wk[k] = bsc; ssum += bsc;
#pragma unroll
          for (int j = 0; j < 16; ++j) if (part * 16 + j == gi) v[j] = -INFINITY;
        }
        const float inv = 2.5f / ssum;
#pragma unroll
        for (int k = 0; k < TOPK; ++k) { wk[k] *= inv; lslot[k] = ((k & 3) == part && !dry) ? atomicAdd((int*)(lcnt + eidx[k]), 1) : 0; }
      }
      __syncthreads();
      if (tid < 64 && !dry) { const int c = lcnt[tid]; lcnt[64 + tid] = c ? atomicAdd(&counts[tid], c) : 0; }
      __syncthreads();
      if (!dry) {
        const int tok = mt * 128 + tokl;
#pragma unroll
        for (int k = 0; k < TOPK; ++k) if ((k & 3) == part) {
          lists[(size_t)eidx[k] * T + lcnt[64 + eidx[k]] + lslot[k]] = tok * 8 + k;
          wts[tok * 8 + k] = wk[k];
        }
      }
      __syncthreads();
    }
  }
}

__device__ __forceinline__ void shared_unit(const Params& p, int L, lptr lds, int mt) {
  const bf16_t* wg = (const bf16_t*)(p.ws + WS_WSGU + (size_t)L * 512 * 1024); const bf16_t* wd = (const bf16_t*)(p.ws + WS_WSD + (size_t)L * 1024 * 256); const int* nolist = nullptr;
  asm volatile("" : "+s"(wg), "+s"(wd), "+s"(nolist));
  expert_unit(p, L, wg, wd, nolist, 128, mt * 128, lds, 0);
}

__device__ __forceinline__ void phase_experts(const Params& p, int L, lptr lds, int vb, int nblocks, int dry = 0) {
  const int tid = threadIdx.x;
  int* counts = (int*)(p.ws + WS_CNT) + L * NE; const int* lists = (const int*)(p.ws + WS_LISTS);
  LAS int* cnt = (LAS int*)(lds + XLDS + 1024);
  __syncthreads();
  if (tid < 64) cnt[tid] = __hip_atomic_load(&counts[tid], __ATOMIC_RELAXED, __HIP_MEMORY_SCOPE_AGENT);
  __syncthreads();
  int e = 0, base = 0;
  for (int u = vb;; u += nblocks) {
    while (e < NE && u >= base + ((cnt[e] + 127) >> 7)) { base += (cnt[e] + 127) >> 7; ++e; }
    if (e >= NE) break;
    const int rb = u - base, c = cnt[e];
    int nv = c - rb * 128; if (nv > 128) nv = 128;
    expert_unit(p, L, (const bf16_t*)(p.ws + (L ? WS_WEGU1 : WS_WEGU) + (size_t)e * 512 * 1024), (const bf16_t*)(p.ws + (L ? WS_WED1 : WS_WED) + (size_t)e * 1024 * 256),
                      lists + (size_t)e * T + rb * 128, nv, 0, lds, dry);
  }
}

__device__ __forceinline__ void combine_panel(const Params& p, int L, int mt) {
  const int lane = threadIdx.x & 63, wave = threadIdx.x >> 6, c0 = lane * 16;
  const int b = (mt * 128) >> 12;
  const float* mod = opq((const float*)(p.ws + WS_MOD));
  const unsigned char* CONTRIB = p.ws + B_CONTRIB; const unsigned char* SHC = p.ws + B_SHC;
  float g2[16], wa[16], sa[16];
  {
    const float* g2p = mod + (size_t)(L * 9 + b) * 6144 + 5120 + c0;
    const float* m1 = mod + (size_t)(9 + b) * 6144;
#pragma unroll
    for (int i = 0; i < 16; ++i) {
      g2[i] = g2p[i];
      if (L == 0) { wa[i] = p.in[I_NMIX][D + c0 + i] * (1.0f + m1[1024 + c0 + i]); sa[i] = m1[c0 + i]; }
      else { wa[i] = p.in[I_FNW][c0 + i]; sa[i] = 0.f; }
    }
  }
#pragma unroll 4
  for (int r = mt * 128 + wave; r < mt * 128 + 128; r += NWAVES) {
    u32x4 sl[7];
#pragma unroll
    for (int k = 0; k < 6; ++k) sl[k] = *(const u32x4*)(CONTRIB + ((size_t)r * 6 + k) * D + c0);
    sl[6] = *(const u32x4*)(SHC + (size_t)r * D + c0);
    const u32x4 h0 = ((const u32x4*)(HROW(r) + c0))[0], h1 = ((const u32x4*)(HROW(r) + c0))[1];
    float v[16];
#pragma unroll
    for (int w = 0; w < 4; ++w) { v[2 * w] = bflo(h0[w]); v[2 * w + 1] = bfhi(h0[w]); v[8 + 2 * w] = bflo(h1[w]); v[8 + 2 * w + 1] = bfhi(h1[w]); }
    float ss = 0.f;
#pragma unroll
    for (int w = 0; w < 4; ++w) {
      float s0 = 0.f, s1 = 0.f, s2 = 0.f, s3 = 0.f;
#pragma unroll
      for (int k = 0; k < 7; ++k) {
        const int u = (int)sl[k][w];
        const f32x2 lo = __builtin_amdgcn_cvt_pk_f32_fp8(u, false), hi = __builtin_amdgcn_cvt_pk_f32_fp8(u, true);
        s0 += lo[0]; s1 += lo[1]; s2 += hi[0]; s3 += hi[1];
      }
      v[4 * w] += g2[4 * w] * s0; v[4 * w + 1] += g2[4 * w + 1] * s1; v[4 * w + 2] += g2[4 * w + 2] * s2; v[4 * w + 3] += g2[4 * w + 3] * s3;
      ss += (v[4 * w] * v[4 * w] + v[4 * w + 1] * v[4 * w + 1]) + (v[4 * w + 2] * v[4 * w + 2] + v[4 * w + 3] * v[4 * w + 3]);
    }
    ss = wave_sum(ss);
    const float rstd = 1.0f / sqrtf(ss * (1.0f / 1024.0f) + EPS);
    if (L == 0) {
      u32x4 o0, o1, a8;
#pragma unroll
      for (int w = 0; w < 4; ++w) { o0[w] = pk2(v[2 * w], v[2 * w + 1]); o1[w] = pk2(v[8 + 2 * w], v[8 + 2 * w + 1]); }
      ((u32x4*)(HROW(r) + c0))[0] = o0; ((u32x4*)(HROW(r) + c0))[1] = o1;
#pragma unroll
      for (int w = 0; w < 4; ++w) {
        f32x4 y;
#pragma unroll
        for (int e = 0; e < 4; ++e) y[e] = (v[4 * w + e] * rstd * wa[4 * w + e] + sa[4 * w + e]) * F8_SA;
        a8[w] = pack4_fp8c(y);
      }
      *(u32x4*)(p.ws + WS_AF8 + (size_t)r * D + c0) = a8;
    } else {
#pragma unroll
      for (int w = 0; w < 4; ++w) {
        float4 o; o.x = v[4 * w] * rstd * wa[4 * w]; o.y = v[4 * w + 1] * rstd * wa[4 * w + 1]; o.z = v[4 * w + 2] * rstd * wa[4 * w + 2]; o.w = v[4 * w + 3] * rstd * wa[4 * w + 3];
        ((float4*)(p.out + (size_t)r * D + c0))[w] = o;
      }
    }
  }
}

__device__ __forceinline__ void convert_experts(const Params& p, int L, lptr lds, int vb, int nblocks, int first = 0, int last = NE * 384) {
  const int lane = threadIdx.x & 63, wave = threadIdx.x >> 6;
  LAS float* scr = (LAS float*)(lds + wave * 8448);
  __syncthreads();
  for (int it = first + vb * NWAVES + wave; it < last; it += nblocks * NWAVES) expert_item(p, L, it, scr, lane);
  __syncthreads();
}
constexpr int CONV_TAIL = 12288;
constexpr int CONV_P1 = 0;
constexpr int CONV_EARLY = 10240;

__device__ __forceinline__ void inproj1_panel(const Params& p, lptr lds, int mt) {
  const int tid_ = opaque((int)threadIdx.x);
  const bf16_t* AF = (const bf16_t*)(p.ws + WS_AF8); const bf16_t* W = (const bf16_t*)(p.ws + WS_WIN1);
  bf16_t* PB = (bf16_t*)(p.ws + B_P); bf16_t* BB = (bf16_t*)(p.ws + B_B);
  StrideLoader al, bl;
  al.p0 = AF + (size_t)(mt * 128 + ROW8(0)) * 512 + CO8; al.ld64 = 64 * 512;
  bl.p0 = W + (size_t)ROW8(0) * 512 + CO8; bl.ld64 = 64 * 512;
  int st = 0;
  gemm_pre_at<4>(al, bl, st, lds);
#pragma unroll 1
  for (int nt = 0; nt < 12; ++nt) {
    f32x4 acc[4][4]; zero_acc(acc);
    StrideLoader bln = bl; bln.p0 += (size_t)256 * 512;
    gemm_chain8<4>(acc, al, bl, 8, lds, st, nt < 11, al, bln);
    bl = bln;
    const int te = opaque(tid_), le = te & 63, we = te >> 6, wm = we >> 2, wn = we & 3, q4 = le >> 4;
    const size_t row0 = (size_t)mt * 128 + wm * 64 + (le & 15);
    if (nt < 8) {
#pragma unroll
      for (int mi = 0; mi < 4; ++mi) store_row2(PB + (row0 + mi * 16) * D + nt * 128 + wn * 32, acc[mi][0] * acc[mi][1] * (F8_INV * F8_INV), acc[mi][2] * acc[mi][3] * (F8_INV * F8_INV), q4);
    } else {
#pragma unroll
      for (int mi = 0; mi < 4; ++mi) store_row4(BB + (row0 + mi * 16) * D + (nt - 8) * 256 + wn * 64, acc[mi][0] * F8_INV, acc[mi][1] * F8_INV, acc[mi][2] * F8_INV, acc[mi][3] * F8_INV, q4);
    }
  }
  __syncthreads();
}

__device__ __forceinline__ void conv3_panel(const Params& p, int mt) {
  const int lane = threadIdx.x & 63, wave = threadIdx.x >> 6;
  const bf16_t* PB = (const bf16_t*)(p.ws + B_P); const bf16_t* BB = (const bf16_t*)(p.ws + B_B); bf16_t* SB = (bf16_t*)(p.ws + B_S);
  const float* cw = opq(p.in[I_ODCW]);
  float w0[16], w1[16], w2[16];
#pragma unroll
  for (int h = 0; h < 2; ++h)
#pragma unroll
    for (int q = 0; q < 2; ++q) {
      const int c = h * 512 + lane * 8 + q * 4;
      const float4 a = *(const float4*)(cw + c), b = *(const float4*)(cw + 1024 + c), d = *(const float4*)(cw + 2048 + c);
      const int o = h * 8 + q * 4;
      w0[o] = a.x; w0[o + 1] = a.y; w0[o + 2] = a.z; w0[o + 3] = a.w; w1[o] = b.x; w1[o + 1] = b.y; w1[o + 2] = b.z; w1[o + 3] = b.w; w2[o] = d.x; w2[o + 1] = d.y; w2[o + 2] = d.z; w2[o + 3] = d.w;
    }
#pragma unroll 2
  for (int r = mt * 128 + wave; r < mt * 128 + 128; r += NWAVES) {
    const int tokb = r & 4095;
    const float fm = tokb > 0 ? 1.f : 0.f, fp = tokb < SEQ - 1 ? 1.f : 0.f;
#pragma unroll
    for (int h = 0; h < 2; ++h) {
      const size_t o = (size_t)r * D + h * 512 + lane * 8;
      const uint4 bq = *(const uint4*)(BB + o), pc = *(const uint4*)(PB + o);
      const uint4 pm = *(const uint4*)(PB + o - (tokb > 0 ? D : 0)), pn = *(const uint4*)(PB + o + (tokb < SEQ - 1 ? D : 0));
      const unsigned bb[4] = {bq.x, bq.y, bq.z, bq.w}, m[4] = {pm.x, pm.y, pm.z, pm.w}, c[4] = {pc.x, pc.y, pc.z, pc.w}, n[4] = {pn.x, pn.y, pn.z, pn.w};
      unsigned ov[4];
#pragma unroll
      for (int q = 0; q < 4; ++q) {
        const int e = h * 8 + 2 * q;
        const float lo = bflo(bb[q]) * (fm * w0[e] * bflo(m[q]) + w1[e] * bflo(c[q]) + fp * w2[e] * bflo(n[q]));
        const float hi = bfhi(bb[q]) * (fm * w0[e + 1] * bfhi(m[q]) + w1[e + 1] * bfhi(c[q]) + fp * w2[e + 1] * bfhi(n[q]));
        ov[q] = pk2(lo, hi);
      }
      *(uint4*)(SB + o) = make_uint4(ov[0], ov[1], ov[2], ov[3]);
    }
  }
}

#define XB_TMO      128
#define XB_XCNT(j)  (256  + 64 * (j))
#define XB_XSUB(j)  (1280 + 64 * (j))
#define XB_XGEN(j)  (2304 + 64 * (j))
#define XB_TOP      3328
#define XB_TOPGEN   3392
#define XCD_BAR_WORDS 3456
#define XB_SPIN_CAP (1u << 22)
__device__ __forceinline__ unsigned xb_ld(unsigned* p) { return __hip_atomic_load(p, __ATOMIC_RELAXED, __HIP_MEMORY_SCOPE_AGENT); }
__device__ __forceinline__ unsigned xb_add(unsigned* p, unsigned v) { return __hip_atomic_fetch_add(p, v, __ATOMIC_RELAXED, __HIP_MEMORY_SCOPE_AGENT); }
__device__ __forceinline__ unsigned xb_xcc_id() { return (unsigned)__builtin_amdgcn_s_getreg((3 << 11) | 20) & 0xFu; }
#define XB_SPIN(cond, bar) do { unsigned _sp = 0; while (cond) { __builtin_amdgcn_s_sleep(1); \
    if ((++_sp & 255u) == 0u) { if (xb_ld(&(bar)[XB_TMO])) break; if (_sp > XB_SPIN_CAP) { atomicAdd(&(bar)[XB_TMO], 1u); break; } } } } while (0)
struct XcdBarrier { unsigned* bar; unsigned x; volatile LAS unsigned* st; };
__device__ __forceinline__ XcdBarrier xcd_barrier_post(unsigned* bar, volatile LAS unsigned* st) {
  XcdBarrier b; b.bar = bar; b.x = xb_xcc_id(); b.st = st;
  if (threadIdx.x == 0) (void)xb_add(&bar[XB_XCNT(b.x)], 1u);
  return b;
}
__device__ __forceinline__ void xcd_barrier_complete(unsigned* bar, unsigned x, unsigned& nloc, unsigned& nx) {
  const unsigned G = gridDim.x * gridDim.y * gridDim.z;
  unsigned sum, cnt, mine, sp = 0u;
  for (;;) {
    sum = 0u; cnt = 0u; mine = 0u;
#pragma unroll
    for (unsigned j = 0; j < 16; ++j) { const unsigned c = xb_ld(&bar[XB_XCNT(j)]); sum += c; cnt += (c > 0u) ? 1u : 0u; mine = (j == x) ? c : mine; }
    if (sum == G) break;
    __builtin_amdgcn_s_sleep(1);
    if ((++sp & 255u) == 0u) { if (xb_ld(&bar[XB_TMO])) break; if (sp > XB_SPIN_CAP) { atomicAdd(&bar[XB_TMO], 1u); break; } }
  }
  nloc = mine > 0u ? mine : 1u; nx = cnt > 0u ? cnt : 1u;
}
__device__ __forceinline__ void xcd_barrier(unsigned* bar_, lptr lds) {
  asm volatile("s_waitcnt vmcnt(0)" ::: "memory");
  __syncthreads();
  if (threadIdx.x == 0) {
    XcdBarrier b; b.bar = bar_; b.x = xb_xcc_id(); b.st = (volatile LAS unsigned*)(lds + LDS_BYTES - 16);
    unsigned* bar = b.bar;
    __builtin_amdgcn_s_waitcnt(0);
    unsigned nloc = b.st[0], nx = b.st[1];
    if (nloc == 0u) { xcd_barrier_complete(bar, b.x, nloc, nx); b.st[0] = nloc; b.st[1] = nx; }
    const unsigned old = xb_add(&bar[XB_XSUB(b.x)], 1u);
    const unsigned gen = old / nloc;
    if (old + 1u == (gen + 1u) * nloc) {
      __builtin_amdgcn_fence(__ATOMIC_RELEASE, "agent");
      asm volatile("s_waitcnt vmcnt(0)" ::: "memory");
      const unsigned og = xb_add(&bar[XB_TOP], 1u);
      const unsigned tg = og / nx;
      if (og + 1u == (tg + 1u) * nx) xb_add(&bar[XB_TOPGEN], 1u);
      else XB_SPIN(xb_ld(&bar[XB_TOPGEN]) == tg, bar);
      __builtin_amdgcn_fence(__ATOMIC_ACQUIRE, "agent");
      xb_add(&bar[XB_XGEN(b.x)], 1u);
      asm volatile("s_waitcnt vmcnt(0)" ::: "memory");
    } else {
      XB_SPIN(xb_ld(&bar[XB_XGEN(b.x)]) == gen, bar);
      __builtin_amdgcn_fence(__ATOMIC_ACQUIRE, "agent");
      asm volatile("s_waitcnt vmcnt(0)" ::: "memory");
    }
  }
  __syncthreads();
}

__global__ void __launch_bounds__(NTHREADS, 2) fwd_kernel(Params p) {
  extern __shared__ __attribute__((aligned(16))) unsigned char smem[];
  lptr lds = (lptr)smem;
  const int nblocks = gridDim.x;
  const int bx = blockIdx.x;
  const int vb = ((nblocks & 7) == 0) ? (bx & 7) * (nblocks >> 3) + (bx >> 3) : bx;
  cg::grid_group grid = cg::this_grid();
  volatile LAS unsigned* bst = (volatile LAS unsigned*)(lds + LDS_BYTES - 16);
  if (threadIdx.x == 0) { bst[0] = 0u; bst[1] = 0u; }
  __syncthreads();
  if (p.ph_hi - p.ph_lo > 2) (void)xcd_barrier_post((unsigned*)(p.ws + WS_BAR), bst);
  const int lo = p.ph_lo, hi = p.ph_hi;
#ifdef ONLY_PHASE
#define IN(k) ((k) == ONLY_PHASE && lo <= (k) && (k) < hi)
#else
#define IN(k) (lo <= (k) && (k) < hi)
#endif
#ifndef PROBE_DOUBLE
#define PROBE_DOUBLE -1
#endif
#define SEAM(k) do { if (lo <= (k) && (k) + 1 < hi) { if ((k) == lo) grid.sync(); else xcd_barrier((unsigned*)(p.ws + WS_BAR), lds); } } while (0)
#define PANEL_SYNC() do { asm volatile("s_waitcnt vmcnt(0)" ::: "memory"); __syncthreads(); } while (0)
  if (IN(0)) phase0(p, lds, vb, nblocks);
  SEAM(0);
  if (IN(1)) {
    if (nblocks == 256) {
      unsigned* cmain = (unsigned*)(p.ws + WS_BAR + 15360);
      a0_panel(p, vb); PANEL_SYNC();
      inproj0_panel(p, lds, vb); PANEL_SYNC();
      upproj_panel(p, lds, vb);
      asm volatile("s_waitcnt vmcnt(0)" ::: "memory");
      __syncthreads();
      if (threadIdx.x == 0) { __builtin_amdgcn_fence(__ATOMIC_RELEASE, "agent"); (void)__hip_atomic_fetch_add(cmain, 1u, __ATOMIC_RELAXED, __HIP_MEMORY_SCOPE_AGENT); }
      if (vb < 16) {
        const int pan = 256 + vb;
        a0_panel(p, pan); PANEL_SYNC();
        inproj0_panel(p, lds, pan); PANEL_SYNC();
        upproj_panel(p, lds, pan);
      } else {
        if (vb < 32) router_fold(p, (vb - 16) >> 3, (vb - 16) & 7, lds);
        convert_experts(p, 0, lds, vb - 16, 240, 0, CONV_P1);
        if (threadIdx.x == 0) {
          while (__hip_atomic_load(cmain, __ATOMIC_RELAXED, __HIP_MEMORY_SCOPE_AGENT) < 256u) __builtin_amdgcn_s_sleep(8);
          __builtin_amdgcn_fence(__ATOMIC_ACQUIRE, "agent");
        }
        __syncthreads();
        conv_units(p, lds, vb - 16, 240);
      }
    } else {
      for (int pan = vb; pan < 272; pan += nblocks) {
        a0_panel(p, pan); PANEL_SYNC();
        inproj0_panel(p, lds, pan); PANEL_SYNC();
        upproj_panel(p, lds, pan);
      }
      for (int it = vb; it < 16; it += nblocks) router_fold(p, it >> 3, it & 7, lds);
    }
  }
  SEAM(1);
  if (IN(2)) {
    if (nblocks == 256) {
      const bool early = (blockIdx.x & 1) == 0;
      if (early) convert_experts(p, 0, lds, vb, nblocks, CONV_P1);
      phase4(p, lds, vb, nblocks);
      if (!early) convert_experts(p, 0, lds, vb, nblocks, CONV_P1);
    } else {
      const bool early = (blockIdx.x & 1) == 0;
      if (early) convert_experts(p, 0, lds, vb, nblocks);
      phase4(p, lds, vb, nblocks); conv_units(p, lds, vb, nblocks);
      if (!early) convert_experts(p, 0, lds, vb, nblocks);
    }
  }
  SEAM(2);
  if (IN(3)) {
    for (int mt = vb; mt < 256; mt += nblocks) {
      outproj_panel(p, 0, lds, mt);
      ffnprep_panel(p, 0, mt, lds); PANEL_SYNC();
      router_tile(p, 0, lds, mt);
      shared_unit(p, 0, lds, mt);
    }
  }
  SEAM(3);
  if (IN(4)) {
    phase_experts(p, 0, lds, vb, nblocks);
    if (nblocks == 256) {
      LAS int* cnt = (LAS int*)(lds + XLDS + 1024);
      int tot = 0; for (int e2 = 0; e2 < NE; ++e2) tot += (cnt[e2] + 127) >> 7;
      const int nlast = tot & 255, nidle = 256 - nlast;
      if (nlast > 0 && vb >= nlast) convert_experts(p, 1, lds, vb - nlast, nidle, 0, CONV_TAIL);
      else if (nlast == 0) convert_experts(p, 1, lds, vb, nblocks, 0, CONV_TAIL);
    }
  }
  SEAM(4);
  if (IN(5)) {
    const bool early = (blockIdx.x & 1) == 0;
    const int c1first = (nblocks == 256) ? CONV_TAIL : 0;
    if (early) convert_experts(p, 1, lds, vb, nblocks, c1first);
    for (int mt = vb; mt < 256; mt += nblocks) {
      combine_panel(p, 0, mt); PANEL_SYNC();
      inproj1_panel(p, lds, mt);
    }
    if (!early) convert_experts(p, 1, lds, vb, nblocks, c1first);
  }
  SEAM(5);
  if (IN(6)) {
    for (int mt = vb; mt < 256; mt += nblocks) {
      conv3_panel(p, mt); PANEL_SYNC();
      outproj_panel(p, 1, lds, mt);
      ffnprep_panel(p, 1, mt, lds); PANEL_SYNC();
      router_tile(p, 1, lds, mt);
      shared_unit(p, 1, lds, mt);
    }
  }
  SEAM(6);
  if (IN(7)) phase_experts(p, 1, lds, vb, nblocks);
  SEAM(7);
  if (IN(8)) { for (int mt = vb; mt < 256; mt += nblocks) combine_panel(p, 1, mt); }
}

extern "C" void kernel_launch(void* const* d_in, const int* in_sizes, int n_in, void* d_out, int out_size,
                              void* d_ws, size_t ws_size, hipStream_t stream) {
  static int grid_blocks = 0;
  if (!grid_blocks) {
    int dev = 0, cus = 0, per_cu = 0;
    (void)hipGetDevice(&dev);
    (void)hipDeviceGetAttribute(&cus, hipDeviceAttributeMultiprocessorCount, dev);
    if (hipFuncSetAttribute((const void*)fwd_kernel, hipFuncAttributeMaxDynamicSharedMemorySize, LDS_BYTES) != hipSuccess) fprintf(stderr, "hipFuncSetAttribute failed\n");
    if (hipOccupancyMaxActiveBlocksPerMultiprocessor(&per_cu, fwd_kernel, NTHREADS, LDS_BYTES) != hipSuccess) per_cu = 0;
    fprintf(stderr, "kernel_launch: cus %d per_cu %d ws %zu n_in %d\n", cus, per_cu, ws_size, n_in);
    if (per_cu > 1) per_cu = 1;
    if (per_cu < 1) per_cu = 1;
    grid_blocks = cus * per_cu; if (grid_blocks > 256) grid_blocks = 256;
    if (ws_size < WS_END || n_in != N_IN) { fprintf(stderr, "kernel_launch: bad ws/n_in\n"); grid_blocks = -1; }
  }
  if (grid_blocks < 0) return;
  (void)hipMemsetAsync(d_ws, 0, 64 * 1024, stream);
  Params p{};
  for (int i = 0; i < N_IN; ++i) p.in[i] = (const float*)d_in[i];
  p.out = (float*)d_out; p.ws = (unsigned char*)d_ws;
#if MK_MULTI
  for (int ph = 0; ph < NPHASE; ++ph) {
    p.ph_lo = ph; p.ph_hi = ph + 1;
    hipLaunchKernelGGL(fwd_kernel, dim3(grid_blocks), dim3(NTHREADS), LDS_BYTES, stream, p);
  }
#else
  p.ph_lo = 0; p.ph_hi = NPHASE;
  void* args[] = {&p};
  hipError_t e = hipLaunchCooperativeKernel((void*)fwd_kernel, dim3(grid_blocks), dim3(NTHREADS), args, LDS_BYTES, stream);
  if (e != hipSuccess) fprintf(stderr, "cooperative launch failed: %s (grid %d)\n", hipGetErrorString(e), grid_blocks);
#endif
}
```
